# Optimizing an MI355X kernel written in HIP

```python
import math
import jax, jax.numpy as jnp
from jax import lax
import numpy as np

D_MODEL = 1024
BATCH = 16
SEQ = 2048
DEPTH = 4

N_MIXERS = 4
EPS = 1e-6
POOL_WINDOWS = (2, 4, 8, 16)
POOL_GROUP = D_MODEL // len(POOL_WINDOWS)
S5_GROUP = 16
S5_GROUPS = D_MODEL // S5_GROUP
S5_STATE = 64
S5_DT_MIN = 1e-3
S5_DT_MAX = 1e-1
LRU_WIDTH = D_MODEL
LRU_BLOCKS = 4
LRU_BLOCK = LRU_WIDTH // LRU_BLOCKS
LRU_CONV = 4
LRU_C = 8.0
SB_HEADS = 16
SB_HEAD_DIM = D_MODEL // SB_HEADS
SB_Q_BLOCK = 128
FFN_HIDDEN = 2816
FFN_CONV = 3

kernel_name = "interleaved_pool_s5_rglru_stickbreak_trunk"


def n_layers_of(m):
    return len(range(m, DEPTH, N_MIXERS))


def rms_norm(x, g):
    xf = x.astype(jnp.float32)
    y = xf * lax.rsqrt(jnp.mean(xf * xf, axis=-1, keepdims=True) + EPS)
    return (y * g.astype(jnp.float32)).astype(x.dtype)


def causal_depthwise_conv(x, w, b):
    k_width = w.shape[0]
    seq = x.shape[1]
    xp = jnp.pad(x, ((0, 0), (k_width - 1, 0), (0, 0)))
    y = b
    for k in range(k_width):
        y = y + w[k] * xp[:, k:k + seq]
    return y


def linear_scan_combine(left, right):
    a_l, b_l = left
    a_r, b_r = right
    return a_r * a_l, a_r * b_l + b_r


def pool_mixer(x, w, b, scale):
    bsz, seq, _ = x.shape
    xf = x.astype(jnp.float32)
    cs = jnp.pad(jnp.cumsum(xf, axis=1), ((0, 0), (1, 0), (0, 0)))
    pos = jnp.arange(seq)
    groups = []
    for gi, w_len in enumerate(POOL_WINDOWS):
        c = cs[..., gi * POOL_GROUP:(gi + 1) * POOL_GROUP]
        lo = jnp.maximum(pos + 1 - w_len, 0)
        window_sum = c[:, 1:] - jnp.take(c, lo, axis=1)
        count = (pos + 1 - lo).astype(jnp.float32)[:, None]
        groups.append(window_sum / count - xf[..., gi * POOL_GROUP:(gi + 1) * POOL_GROUP])
    d = jnp.stack(groups, axis=2)
    y = jnp.einsum('bsgc,gcd->bsgd', d, w.astype(jnp.float32)).reshape(bsz, seq, D_MODEL) + b
    return (scale * y).astype(x.dtype)


def s5_mixer(x, lam_re, lam_im, log_dt, b_re, b_im, c_re, c_im, d_skip, w_out, b_out):
    f32 = jnp.float32
    bsz, seq, _ = x.shape
    xf = x.astype(f32)
    u = xf.reshape(bsz, seq, S5_GROUPS, S5_GROUP)
    lam = lax.complex(jnp.minimum(lam_re.astype(f32), -1e-4), lam_im.astype(f32))
    dt = jnp.exp(log_dt.astype(f32))[:, None]
    lam_bar = jnp.exp(lam * dt)
    b_bar = ((lam_bar - 1.0) / lam)[..., None] * lax.complex(b_re.astype(f32), b_im.astype(f32))
    bu = lax.complex(jnp.einsum('bsgh,gph->bsgp', u, jnp.real(b_bar)),
                     jnp.einsum('bsgh,gph->bsgp', u, jnp.imag(b_bar)))
    a = jnp.broadcast_to(lam_bar, (seq,) + lam_bar.shape)[None]
    _, states = lax.associative_scan(linear_scan_combine, (a, bu), axis=1)
    y = (jnp.einsum('bsgp,ghp->bsgh', jnp.real(states), c_re.astype(f32))
         - jnp.einsum('bsgp,ghp->bsgh', jnp.imag(states), c_im.astype(f32)))
    y = y.reshape(bsz, seq, D_MODEL) + d_skip.astype(f32) * xf
    y = jax.nn.gelu(y).astype(x.dtype)
    val, gate = jnp.split(y @ w_out + b_out, 2, axis=-1)
    return val * jax.nn.sigmoid(gate)


def rglru_mixer(x, w_in, conv_w, conv_b, w_a, b_a, w_x, b_x, lam, w_out):
    f32 = jnp.float32
    bsz, seq, _ = x.shape
    gate_branch, rec = jnp.split(x @ w_in, 2, axis=-1)
    rec = causal_depthwise_conv(rec, conv_w, conv_b).astype(f32)
    rb = rec.reshape(bsz, seq, LRU_BLOCKS, LRU_BLOCK)
    r = jax.nn.sigmoid(jnp.einsum('bsnc,ncd->bsnd', rb, w_a.astype(f32)).reshape(bsz, seq, LRU_WIDTH) + b_a)
    i = jax.nn.sigmoid(jnp.einsum('bsnc,ncd->bsnd', rb, w_x.astype(f32)).reshape(bsz, seq, LRU_WIDTH) + b_x)
    log_a = -LRU_C * r * jax.nn.softplus(-lam.astype(f32))
    a = jnp.exp(log_a)
    mult = jnp.sqrt(-jnp.expm1(2.0 * log_a))
    _, h = lax.associative_scan(linear_scan_combine, (a, mult * (i * rec)), axis=1)
    y = jax.nn.gelu(gate_branch.astype(f32)) * h
    return y.astype(x.dtype) @ w_out


def stick_breaking_mixer(x, w_qkv, q_g, k_g, w_o):
    bsz, seq, _ = x.shape
    q, k, v = jnp.split(x @ w_qkv, 3, axis=-1)
    to_heads = lambda t: t.reshape(bsz, seq, SB_HEADS, SB_HEAD_DIM).transpose(0, 2, 1, 3)
    q = rms_norm(to_heads(q), q_g)
    k = rms_norm(to_heads(k), k_g)
    v = to_heads(v)
    scale = 1.0 / math.sqrt(SB_HEAD_DIM)
    outs = []
    for start in range(0, seq, SB_Q_BLOCK):
        end = start + SB_Q_BLOCK
        kb, vb = k[:, :, :end], v[:, :, :end]
        z = jnp.einsum('bhtd,bhsd->bhts', q[:, :, start:end], kb).astype(jnp.float32) * scale
        t_pos = start + jnp.arange(SB_Q_BLOCK)[:, None]
        s_pos = jnp.arange(end)[None, :]
        mask = s_pos < t_pos
        log_1m_beta = jnp.where(mask, jax.nn.log_sigmoid(-z), 0.0)
        rest = lax.cumsum(log_1m_beta, axis=3, reverse=True) - log_1m_beta
        att = jnp.where(mask, jnp.exp(jax.nn.log_sigmoid(z) + rest), 0.0)
        outs.append(jnp.einsum('bhts,bhsd->bhtd', att.astype(v.dtype), vb))
    o = jnp.concatenate(outs, axis=2).transpose(0, 2, 1, 3).reshape(bsz, seq, D_MODEL)
    return o @ w_o


def conv_ffn(x, w_in, conv_w, conv_b, w_out):
    h = causal_depthwise_conv(x @ w_in, conv_w, conv_b)
    val, gate = jnp.split(h, 2, axis=-1)
    return (jax.nn.silu(gate) * val) @ w_out


def setup_inputs(seed: int = 0) -> dict:
    key = jax.random.key(seed)
    ks = iter(jax.random.split(key, 40))
    nrm = lambda shape, std: jax.random.normal(next(ks), shape, jnp.float32) * std
    gain = lambda shape: 1.0 + nrm(shape, 0.02)
    nA, nB, nC, nD = (n_layers_of(m) for m in range(N_MIXERS))
    G, P, H = S5_GROUPS, S5_STATE, S5_GROUP
    a0 = jax.random.uniform(next(ks), (nC, LRU_WIDTH), jnp.float32, 0.9, 0.999)
    return {
        "x": nrm((BATCH, SEQ, D_MODEL), 1.0),
        "norm_mix_g": gain((DEPTH, D_MODEL)),
        "norm_ffn_g": gain((DEPTH, D_MODEL)),
        "pool_w": nrm((nA, len(POOL_WINDOWS), POOL_GROUP, POOL_GROUP), POOL_GROUP ** -0.5),
        "pool_b": nrm((nA, D_MODEL), 0.01),
        "pool_scale": 1.0 + nrm((nA, D_MODEL), 0.1),
        "s5_lam_re": -0.5 + nrm((nA * 0 + nB, G, P), 0.01),
        "s5_lam_im": math.pi * jnp.arange(P, dtype=jnp.float32) + nrm((nB, G, P), 0.01),
        "s5_log_dt": jax.random.uniform(next(ks), (nB, G), jnp.float32, math.log(S5_DT_MIN), math.log(S5_DT_MAX)),
        "s5_b_re": nrm((nB, G, P, H), (2 * H) ** -0.5),
        "s5_b_im": nrm((nB, G, P, H), (2 * H) ** -0.5),
        "s5_c_re": nrm((nB, G, H, P), P ** -0.5),
        "s5_c_im": nrm((nB, G, H, P), P ** -0.5),
        "s5_d": nrm((nB, D_MODEL), 1.0),
        "s5_w_out": nrm((nB, D_MODEL, 2 * D_MODEL), D_MODEL ** -0.5),
        "s5_b_out": nrm((nB, 2 * D_MODEL), 0.01),
        "lru_w_in": nrm((nC, D_MODEL, 2 * LRU_WIDTH), D_MODEL ** -0.5),
        "lru_conv_w": nrm((nC, LRU_CONV, LRU_WIDTH), LRU_CONV ** -0.5),
        "lru_conv_b": nrm((nC, LRU_WIDTH), 0.01),
        "lru_w_a": nrm((nC, LRU_BLOCKS, LRU_BLOCK, LRU_BLOCK), LRU_BLOCK ** -0.5),
        "lru_b_a": nrm((nC, LRU_WIDTH), 0.01),
        "lru_w_x": nrm((nC, LRU_BLOCKS, LRU_BLOCK, LRU_BLOCK), LRU_BLOCK ** -0.5),
        "lru_b_x": nrm((nC, LRU_WIDTH), 0.01),
        "lru_lam": jnp.log(a0) - jnp.log1p(-a0),
        "lru_w_out": nrm((nC, LRU_WIDTH, D_MODEL), LRU_WIDTH ** -0.5),
        "sb_w_qkv": nrm((nD, D_MODEL, 3 * D_MODEL), D_MODEL ** -0.5),
        "sb_q_g": gain((nD, SB_HEAD_DIM)),
        "sb_k_g": gain((nD, SB_HEAD_DIM)),
        "sb_w_o": nrm((nD, D_MODEL, D_MODEL), D_MODEL ** -0.5),
        "ffn_w_in": nrm((DEPTH, D_MODEL, 2 * FFN_HIDDEN), D_MODEL ** -0.5),
        "ffn_conv_w": nrm((DEPTH, FFN_CONV, 2 * FFN_HIDDEN), FFN_CONV ** -0.5),
        "ffn_conv_b": nrm((DEPTH, 2 * FFN_HIDDEN), 0.01),
        "ffn_w_out": nrm((DEPTH, FFN_HIDDEN, D_MODEL), FFN_HIDDEN ** -0.5),
    }


def reference(x, norm_mix_g, norm_ffn_g,
              pool_w, pool_b, pool_scale,
              s5_lam_re, s5_lam_im, s5_log_dt, s5_b_re, s5_b_im, s5_c_re, s5_c_im, s5_d, s5_w_out, s5_b_out,
              lru_w_in, lru_conv_w, lru_conv_b, lru_w_a, lru_b_a, lru_w_x, lru_b_x, lru_lam, lru_w_out,
              sb_w_qkv, sb_q_g, sb_k_g, sb_w_o,
              ffn_w_in, ffn_conv_w, ffn_conv_b, ffn_w_out):
    for layer in range(DEPTH):
        m, j = layer % N_MIXERS, layer // N_MIXERS
        h = rms_norm(x, norm_mix_g[layer])
        if m == 0:
            y = pool_mixer(h, pool_w[j], pool_b[j], pool_scale[j])
        elif m == 1:
            y = s5_mixer(h, s5_lam_re[j], s5_lam_im[j], s5_log_dt[j], s5_b_re[j], s5_b_im[j],
                         s5_c_re[j], s5_c_im[j], s5_d[j], s5_w_out[j], s5_b_out[j])
        elif m == 2:
            y = rglru_mixer(h, lru_w_in[j], lru_conv_w[j], lru_conv_b[j], lru_w_a[j], lru_b_a[j],
                            lru_w_x[j], lru_b_x[j], lru_lam[j], lru_w_out[j])
        else:
            y = stick_breaking_mixer(h, sb_w_qkv[j], sb_q_g[j], sb_k_g[j], sb_w_o[j])
        x = x + y.astype(x.dtype)
        f = conv_ffn(rms_norm(x, norm_ffn_g[layer]), ffn_w_in[layer], ffn_conv_w[layer], ffn_conv_b[layer], ffn_w_out[layer])
        x = x + f.astype(x.dtype)
    return x
```

```cpp
#include <hip/hip_runtime.h>
#include <hip/hip_cooperative_groups.h>
#include <cstdio>
#include <cstring>
namespace cg = cooperative_groups;

#define LAS __attribute__((address_space(3)))
typedef unsigned short bf16_t;
typedef short bf16x8 __attribute__((ext_vector_type(8)));
typedef short bf16x4 __attribute__((ext_vector_type(4)));
typedef float f32x4 __attribute__((ext_vector_type(4)));
typedef float f32x16 __attribute__((ext_vector_type(16)));
typedef unsigned u32x4 __attribute__((ext_vector_type(4)));
typedef unsigned u32x2 __attribute__((ext_vector_type(2)));

constexpr int T = 32768, D = 1024, SEQ = 2048, FH = 2816, F2 = 5632;
constexpr int NTHREADS = 512;
constexpr int LDS_BYTES = 147456;
constexpr int XCH_OFF = 131072, MISC_OFF = 131072 + 8192;
constexpr size_t MiB = 1u << 20;
constexpr size_t WS_WPOOL = 1 * MiB, WS_WS5 = 2 * MiB, WS_WLIN = 6 * MiB, WS_WGATE = 10 * MiB, WS_WLOUT = 11 * MiB,
                 WS_WQKV = 13 * MiB, WS_WWO = 19 * MiB, WS_WF1 = 21 * MiB, WS_WF2 = 65 * MiB,
                 WS_HN = 96 * MiB, WS_BIG = 160 * MiB, WS_RAW = 480 * MiB, WS_END = 492 * MiB;
constexpr size_t ACT = 64 * MiB;

typedef __bf16 bf16v2_t __attribute__((ext_vector_type(2)));
__device__ __forceinline__ unsigned cvt_pk_bf16(float lo, float hi) { const bf16v2_t v = {(__bf16)lo, (__bf16)hi}; return __builtin_bit_cast(unsigned, v); }
__device__ __forceinline__ float bf2f(unsigned short b) { return __uint_as_float(((unsigned)b) << 16); }
__device__ __forceinline__ float bflo(unsigned w) { return __uint_as_float(w << 16); }
__device__ __forceinline__ float bfhi(unsigned w) { return __uint_as_float(w & 0xffff0000u); }
__device__ __forceinline__ float sigmoidf_(float x) { return __builtin_amdgcn_rcpf(1.0f + __expf(-x)); }
__device__ __forceinline__ float gelu_tanh(float x) { const float k = 1.5957691216f * (x + 0.044715f * x * x * x); return x * __builtin_amdgcn_rcpf(1.0f + __expf(-k)); }
__device__ __forceinline__ float wave_sum(float v) {
#pragma unroll
    for (int o = 1; o < 64; o <<= 1) v += __shfl_xor(v, o);
    return v;
}
__device__ __forceinline__ int otid() { int t = threadIdx.x; asm volatile("" : "+v"(t)); return t; }
template <int CTRL> __device__ __forceinline__ float dpp_upd(float old, float src) {
    return __int_as_float(__builtin_amdgcn_update_dpp(__float_as_int(old), __float_as_int(src), CTRL, 0xf, 0xf, false));
}
template <int CTRL> __device__ __forceinline__ float dpp0(float src) { return __int_as_float(__builtin_amdgcn_update_dpp(0, __float_as_int(src), CTRL, 0xf, 0xf, true)); }
__device__ __forceinline__ void conv_taps(float& h, float cur, float prev, float w1, float w0, float w1m, float w0m) {
    asm("s_nop 1\n\t"
        "v_fmac_f32_dpp %0, %1, %3 row_shr:1 row_mask:0xf bank_mask:0xf bound_ctrl:1\n\t"
        "v_fmac_f32_dpp %0, %1, %4 row_shr:2 row_mask:0xf bank_mask:0xf bound_ctrl:1\n\t"
        "v_fmac_f32_dpp %0, %2, %5 row_ror:1 row_mask:0xf bank_mask:0xf\n\t"
        "v_fmac_f32_dpp %0, %2, %6 row_ror:2 row_mask:0xf bank_mask:0xf"
        : "+v"(h) : "v"(cur), "v"(prev), "v"(w1), "v"(w0), "v"(w1m), "v"(w0m));
}
__device__ __forceinline__ float prev1(float prev, float cur) { const float t = dpp_upd<0x121>(0.f, prev); return dpp_upd<0x111>(t, cur); }
__device__ __forceinline__ float prev2(float prev, float cur) { const float t = dpp_upd<0x122>(0.f, prev); return dpp_upd<0x112>(t, cur); }

namespace pg8 {
constexpr int BM = 256, BK = 64, HALF = 128, HTB = HALF * BK * 2, STAGE_BYTES = 8 * HTB, NXCD = 8, WGM = 8;
__host__ __device__ __forceinline__ int lds_byte(int r, int c) { const int st = (r >> 4) * 2 + (c >> 5), rr = r & 15, cc = c & 31, ob = rr * 64 + cc * 2; return st * 1024 + (ob ^ (((ob >> 9) & 1) << 5)); }
__host__ __device__ __forceinline__ void stage_rc(int b, int& R, int& C) { const int st = b / 1024, sb = b % 1024, swz = sb ^ (((sb >> 9) & 1) << 5); R = (st >> 1) * 16 + swz / 64; C = (st & 1) * 32 + (swz % 64) / 2; }
__host__ __device__ __forceinline__ int perm32(int rho) { const int n = rho >> 4, i = rho & 15; return 8 * (i >> 2) + 4 * n + (i & 3); }
struct Unit { int pm, pn; };
struct Gemm { const bf16_t* A; const bf16_t* Bt; int M, N, K, lda, ldb, a_shift, a_step; };
struct StaticOrder {
    int nM, nN, nwg, G, c;
    __device__ __forceinline__ void init(int M, int N, int G_, int c_) { nM = M / BM; nN = N / BM; nwg = nM * nN; G = G_; c = c_; }
    __device__ __forceinline__ bool next(int i, Unit& u) const {
        const long L = (long)i * G + c; if (L >= nwg) return false;
        int wgid = (int)L; { const int q = nwg / NXCD, r = nwg % NXCD, xcd = wgid % NXCD, off = wgid / NXCD; wgid = (xcd < r ? xcd * (q + 1) : r * (q + 1) + (xcd - r) * q) + off; }
        const int nig = WGM * nN, gid = wgid / nig, fm = gid * WGM, gsz = (nM - fm) < WGM ? (nM - fm) : WGM;
        u.pm = fm + ((wgid % nig) % gsz); u.pn = (wgid % nig) / gsz; return true;
    }
};
template <class Epi>
__device__ __forceinline__ void gemm_phase(LAS unsigned char* lds, const Gemm g, const StaticOrder& S, const Epi& E) {
    int tid_ = threadIdx.x; asm volatile("" : "+v"(tid_));
    const int tid = tid_, wid = __builtin_amdgcn_readfirstlane(tid >> 6), lane = tid & 63, wr = wid >> 2, wc = wid & 3, fr = lane & 15, fq = lane >> 4;
    const int K = g.K, nt = K / BK;
    unsigned voffA[2], voffB[2];
#pragma unroll
    for (int i = 0; i < 2; ++i) { int R, C; stage_rc(tid * 16 + i * 8192, R, C); const int Rb = Epi::PERM ? ((R & ~31) + perm32(R & 31)) : R;
        voffA[i] = (unsigned)(R * g.lda + C) * 2u; voffB[i] = (unsigned)(Rb * g.ldb + C) * 2u; }
    const size_t kstep = (size_t)(BK * 2);
    const size_t hstepA = (size_t)HALF * g.lda * 2, hstepB = (size_t)HALF * g.ldb * 2;
    const size_t tstepA = 2 * hstepA, tstepB = 2 * hstepB;
    const unsigned ldsw = (unsigned)wid * 1024u;
    const int aoff = lds_byte(wr * 64 + fr, fq * 8), boff = lds_byte(wc * 32 + fr, fq * 8);
#define PG8_SA(b, h) (((b) * 2 + (h)) * HTB)
#define PG8_SB(b, h) ((4 + (b) * 2 + (h)) * HTB)
#define PG8_STAGE(bufoff, gbase, voff) do { _Pragma("unroll") for (int _i = 0; _i < 2; ++_i) \
        __builtin_amdgcn_global_load_lds((const unsigned*)((const char*)(gbase) + (voff)[_i]), (LAS unsigned*)(lds + (bufoff) + ldsw + _i * 8192), 16, 0, 0); } while (0)
#define PG8_LDA(dst, b, h) do { _Pragma("unroll") for (int m = 0; m < 4; ++m) _Pragma("unroll") for (int k = 0; k < 2; ++k) dst[m][k] = *(const LAS bf16x8*)(lds + PG8_SA(b, h) + aoff + m * 2048 + k * 1024); } while (0)
#define PG8_LDB(dst, b, h) do { _Pragma("unroll") for (int n = 0; n < 2; ++n) _Pragma("unroll") for (int k = 0; k < 2; ++k) dst[n][k] = *(const LAS bf16x8*)(lds + PG8_SB(b, h) + boff + n * 2048 + k * 1024); } while (0)
#define PG8_MMA(ai, bj, At, Bt) do { __builtin_amdgcn_s_setprio(1); _Pragma("unroll") for (int m = 0; m < 4; ++m) _Pragma("unroll") for (int n = 0; n < 2; ++n) _Pragma("unroll") for (int k = 0; k < 2; ++k) \
        acc[ai][bj][m][n] = __builtin_amdgcn_mfma_f32_16x16x32_bf16(Bt[n][k], At[m][k], acc[ai][bj][m][n], 0, 0, 0); __builtin_amdgcn_s_setprio(0); } while (0)
#define PG8_WAIT_V(n) asm volatile("s_waitcnt vmcnt(" #n ")" ::: "memory")
#define PG8_WAIT_L(n) asm volatile("s_waitcnt lgkmcnt(" #n ")" ::: "memory")
#define PG8_BAR __builtin_amdgcn_s_barrier()
#define PG8_SCHED __builtin_amdgcn_sched_barrier(0)
    Unit cur, nxt; int ui = 0;
    if (!S.next(0, cur)) return;
    f32x4 acc[2][2][4][2];
#pragma unroll
    for (int a = 0; a < 2; ++a)
#pragma unroll
        for (int b = 0; b < 2; ++b)
#pragma unroll
            for (int m = 0; m < 4; ++m)
#pragma unroll
                for (int n = 0; n < 2; ++n) acc[a][b][m][n] = (f32x4){0.f, 0.f, 0.f, 0.f};
    bf16x8 At[4][2], B0[2][2], B1[2][2];
    const char* cA = (const char*)g.A + (size_t)cur.pm * tstepA + (size_t)(cur.pn >> g.a_shift) * g.a_step; const char* cB = (const char*)g.Bt + (size_t)cur.pn * tstepB;
    PG8_STAGE(PG8_SB(0, 0), cB, voffB); PG8_STAGE(PG8_SA(0, 0), cA, voffA); PG8_STAGE(PG8_SB(0, 1), cB + hstepB, voffB); PG8_STAGE(PG8_SA(0, 1), cA + hstepA, voffA);
    if (wr == 1) PG8_BAR;
    PG8_WAIT_V(4); PG8_BAR;
    PG8_STAGE(PG8_SB(1, 0), cB + kstep, voffB); PG8_STAGE(PG8_SA(1, 0), cA + kstep, voffA); PG8_STAGE(PG8_SB(1, 1), cB + hstepB + kstep, voffB);
    PG8_WAIT_V(6); PG8_BAR;
    for (;;) {
        const bool has_next = S.next(ui + 1, nxt);
        const char* nA = has_next ? (const char*)g.A + (size_t)nxt.pm * tstepA + (size_t)(nxt.pn >> g.a_shift) * g.a_step : cA; const char* nB = has_next ? (const char*)g.Bt + (size_t)nxt.pn * tstepB : cB;
        for (int t = 0; t < nt; t += 2) {
            const bool last = (t == nt - 2);
            const char* a1 = cA + (size_t)(t + 1) * kstep;
            const char* a2 = last ? nA : cA + (size_t)(t + 2) * kstep; const char* b2 = last ? nB : cB + (size_t)(t + 2) * kstep;
            const char* a3 = a2 + kstep; const char* b3 = b2 + kstep;
            PG8_LDB(B0, 0, 0); PG8_SCHED; PG8_LDA(At, 0, 0); PG8_STAGE(PG8_SA(1, 1), a1 + hstepA, voffA);
            PG8_WAIT_L(8); PG8_BAR; PG8_WAIT_L(0); PG8_MMA(0, 0, At, B0); PG8_BAR; PG8_SCHED;
            PG8_LDB(B1, 0, 1); PG8_STAGE(PG8_SB(0, 0), b2, voffB);
            PG8_BAR; PG8_WAIT_L(0); PG8_MMA(0, 1, At, B1); PG8_BAR;
            PG8_LDA(At, 0, 1); PG8_STAGE(PG8_SA(0, 0), a2, voffA);
            PG8_BAR; PG8_WAIT_L(0); PG8_MMA(1, 0, At, B0); PG8_BAR; PG8_SCHED;
            PG8_STAGE(PG8_SB(0, 1), b2 + hstepB, voffB);
            PG8_WAIT_V(6); PG8_BAR; PG8_MMA(1, 1, At, B1); PG8_BAR;
            PG8_LDB(B0, 1, 0); PG8_SCHED; PG8_LDA(At, 1, 0); PG8_STAGE(PG8_SA(0, 1), a2 + hstepA, voffA);
            PG8_WAIT_L(8); PG8_BAR; PG8_WAIT_L(0); PG8_MMA(0, 0, At, B0); PG8_BAR; PG8_SCHED;
            PG8_LDB(B1, 1, 1); PG8_STAGE(PG8_SB(1, 0), b3, voffB);
            PG8_BAR; PG8_WAIT_L(0); PG8_MMA(0, 1, At, B1); PG8_BAR;
            PG8_LDA(At, 1, 1); PG8_STAGE(PG8_SA(1, 0), a3, voffA);
            PG8_BAR; PG8_WAIT_L(0); PG8_MMA(1, 0, At, B0); PG8_BAR; PG8_SCHED;
            PG8_STAGE(PG8_SB(1, 1), b3 + hstepB, voffB);
            PG8_WAIT_V(6); PG8_BAR; PG8_MMA(1, 1, At, B1); PG8_BAR;
        }
        E(acc, cur, wr, wc, fr, fq);
        if (!has_next) break;
#pragma unroll
        for (int a = 0; a < 2; ++a)
#pragma unroll
            for (int b = 0; b < 2; ++b)
#pragma unroll
                for (int m = 0; m < 4; ++m)
#pragma unroll
                    for (int n = 0; n < 2; ++n) acc[a][b][m][n] = (f32x4){0.f, 0.f, 0.f, 0.f};
        cur = nxt; cA = nA; cB = nB; ++ui;
    }
    PG8_WAIT_V(0);
    if (wr == 0) PG8_BAR;
    PG8_BAR;
#undef PG8_SA
#undef PG8_SB
#undef PG8_STAGE
#undef PG8_LDA
#undef PG8_LDB
#undef PG8_MMA
#undef PG8_WAIT_V
#undef PG8_WAIT_L
#undef PG8_BAR
#undef PG8_SCHED
}
}
using pg8::Unit;
typedef const f32x4 (&AccRef)[2][2][4][2];

struct EpiRes {
    static constexpr bool PERM = false;
    const float* base; float* out; const float* scale; const float* bias;
    __device__ __forceinline__ void operator()(AccRef acc, const Unit& u, int wr, int wc, int fr, int fq) const {
        const int row0 = u.pm * 256 + wr * 64 + fr, col0 = u.pn * 256 + wc * 32 + 4 * fq;
        f32x4 sv[2][2], bv[2][2];
#pragma unroll
        for (int bj = 0; bj < 2; ++bj)
#pragma unroll
            for (int n = 0; n < 2; ++n) {
                sv[bj][n] = scale ? *(const f32x4*)(scale + col0 + bj * 128 + n * 16) : (f32x4){1.f, 1.f, 1.f, 1.f};
                bv[bj][n] = bias ? *(const f32x4*)(bias + col0 + bj * 128 + n * 16) : (f32x4){0.f, 0.f, 0.f, 0.f}; }
#pragma unroll
        for (int ai = 0; ai < 2; ++ai)
#pragma unroll
            for (int m = 0; m < 4; ++m) { const size_t off = (size_t)(row0 + ai * 128 + m * 16) * D + col0;
#pragma unroll
                for (int bj = 0; bj < 2; ++bj)
#pragma unroll
                    for (int n = 0; n < 2; ++n) { const f32x4 b = *(const f32x4*)(base + off + bj * 128 + n * 16);
                        *(f32x4*)(out + off + bj * 128 + n * 16) = b + sv[bj][n] * (acc[ai][bj][m][n] + bv[bj][n]); }
                asm volatile("" ::: "memory"); }
    }
};
struct EpiGateRes {
    static constexpr bool PERM = true;
    float* x; const float* bias;
    __device__ __forceinline__ void operator()(AccRef acc, const Unit& u, int wr, int wc, int fr, int fq) const {
        const int row0 = u.pm * 256 + wr * 64 + fr, col0 = u.pn * 128 + wc * 32 + 8 * fq;
        f32x4 bv[2], bg[2];
#pragma unroll
        for (int n = 0; n < 2; ++n) { bv[n] = *(const f32x4*)(bias + col0 + 4 * n); bg[n] = *(const f32x4*)(bias + D + col0 + 4 * n); }
#pragma unroll
        for (int ai = 0; ai < 2; ++ai)
#pragma unroll
            for (int m = 0; m < 4; ++m) { float* xp = x + (size_t)(row0 + ai * 128 + m * 16) * D + col0;
#pragma unroll
                for (int n = 0; n < 2; ++n) { f32x4 xv = *(const f32x4*)(xp + 4 * n); const f32x4 v = acc[ai][0][m][n] + bv[n], gt = acc[ai][1][m][n] + bg[n];
#pragma unroll
                    for (int j = 0; j < 4; ++j) xv[j] += v[j] * sigmoidf_(gt[j]);
                    *(f32x4*)(xp + 4 * n) = xv; }
                asm volatile("" ::: "memory"); }
    }
};
struct EpiLruIn {
    static constexpr bool PERM = true;
    bf16_t* GG; bf16_t* RP;
    __device__ __forceinline__ void operator()(AccRef acc, const Unit& u, int wr, int wc, int fr, int fq) const {
        const int row0 = u.pm * 256 + wr * 64 + fr; const bool isg = u.pn < 4;
        bf16_t* dst = isg ? GG : RP; const int col0 = (u.pn & 3) * 256 + wc * 32 + 8 * fq;
#pragma unroll
        for (int ai = 0; ai < 2; ++ai)
#pragma unroll
            for (int m = 0; m < 4; ++m) { bf16_t* rp = dst + (size_t)(row0 + ai * 128 + m * 16) * D + col0;
#pragma unroll
                for (int bj = 0; bj < 2; ++bj) { f32x4 v0 = acc[ai][bj][m][0], v1 = acc[ai][bj][m][1];
                    if (isg) {
#pragma unroll
                        for (int j = 0; j < 4; ++j) { v0[j] = gelu_tanh(v0[j]); v1[j] = gelu_tanh(v1[j]); } }
                    u32x4 w; w.x = cvt_pk_bf16(v0[0], v0[1]); w.y = cvt_pk_bf16(v0[2], v0[3]); w.z = cvt_pk_bf16(v1[0], v1[1]); w.w = cvt_pk_bf16(v1[2], v1[3]);
                    *(u32x4*)(rp + bj * 128) = w; } }
    }
};
struct EpiGates {
    static constexpr bool PERM = true;
    const bf16_t* REC; bf16_t* LA; bf16_t* BV; const float* b_a; const float* b_x; const float* lam;
    __device__ __forceinline__ void operator()(AccRef acc, const Unit& u, int wr, int wc, int fr, int fq) const {
        const int row0 = u.pm * 256 + wr * 64 + fr, col0 = u.pn * 128 + wc * 32 + 8 * fq;
#pragma unroll
        for (int n = 0; n < 2; ++n) {
            const f32x4 ba = *(const f32x4*)(b_a + col0 + 4 * n), bx = *(const f32x4*)(b_x + col0 + 4 * n), l = *(const f32x4*)(lam + col0 + 4 * n);
            f32x4 k8;
#pragma unroll
            for (int j = 0; j < 4; ++j) k8[j] = -8.0f * __logf(1.0f + __expf(-l[j]));
#pragma unroll
            for (int ai = 0; ai < 2; ++ai)
#pragma unroll
                for (int m = 0; m < 4; ++m) { const size_t off = (size_t)(row0 + ai * 128 + m * 16) * D + col0 + 4 * n;
                    const u32x2 rw = *(const u32x2*)(REC + off); float lo[4], bo[4];
#pragma unroll
                    for (int j = 0; j < 4; ++j) { const unsigned w = rw[j >> 1]; const float rec = (j & 1) ? bfhi(w) : bflo(w);
                        const float r = sigmoidf_(acc[ai][0][m][n][j] + ba[j]), ig = sigmoidf_(acc[ai][1][m][n][j] + bx[j]);
                        const float la = k8[j] * r; const float mult = __builtin_sqrtf(1.0f - __expf(2.0f * la));
                        lo[j] = la; bo[j] = mult * ig * rec; }
                    *(u32x2*)(LA + off) = (u32x2){cvt_pk_bf16(lo[0], lo[1]), cvt_pk_bf16(lo[2], lo[3])}; *(u32x2*)(BV + off) = (u32x2){cvt_pk_bf16(bo[0], bo[1]), cvt_pk_bf16(bo[2], bo[3])};
                    asm volatile("" ::: "memory"); }
        }
    }
};
struct EpiQKV {
    static constexpr bool PERM = true;
    bf16_t* QKV; const float* qg; const float* kg;
    __device__ __forceinline__ void operator()(AccRef acc, const Unit& u, int wr, int wc, int fr, int fq) const {
        const int which = u.pn >> 2, row0 = u.pm * 256 + wr * 64 + fr, col0 = (u.pn & 3) * 256 + wc * 64 + 8 * fq;
        bf16_t* dst = QKV + (size_t)which * ((size_t)T * D);
        f32x4 gv[2][2];
#pragma unroll
        for (int bj = 0; bj < 2; ++bj)
#pragma unroll
            for (int n = 0; n < 2; ++n) { const f32x4 a = *(const f32x4*)(qg + 32 * bj + 8 * fq + 4 * n), b = *(const f32x4*)(kg + 32 * bj + 8 * fq + 4 * n);
                gv[bj][n] = which == 0 ? a : (which == 1 ? b : (f32x4){1.f, 1.f, 1.f, 1.f}); }
#pragma unroll
        for (int ai = 0; ai < 2; ++ai)
#pragma unroll
            for (int m = 0; m < 4; ++m) {
                float sc = 1.0f;
                if (which < 2) { float ss = 0.f;
#pragma unroll
                    for (int bj = 0; bj < 2; ++bj)
#pragma unroll
                        for (int n = 0; n < 2; ++n) { const f32x4 v = acc[ai][bj][m][n]; ss += (v[0] * v[0] + v[1] * v[1]) + (v[2] * v[2] + v[3] * v[3]); }
                    ss += __shfl_xor(ss, 16); ss += __shfl_xor(ss, 32);
                    sc = rsqrtf(ss * (1.0f / 64.0f) + 1e-6f) * (which == 0 ? 0.125f : 1.0f); }
                bf16_t* rp = dst + (size_t)(row0 + ai * 128 + m * 16) * D + col0;
#pragma unroll
                for (int bj = 0; bj < 2; ++bj) { const f32x4 v0 = acc[ai][bj][m][0] * gv[bj][0] * sc, v1 = acc[ai][bj][m][1] * gv[bj][1] * sc;
                    u32x4 w; w.x = cvt_pk_bf16(v0[0], v0[1]); w.y = cvt_pk_bf16(v0[2], v0[3]); w.z = cvt_pk_bf16(v1[0], v1[1]); w.w = cvt_pk_bf16(v1[2], v1[3]);
                    *(u32x4*)(rp + bj * 32) = w; } }
    }
};
struct EpiFfn1 {
    static constexpr bool PERM = true;
    bf16_t* Aout; const float* cw; const float* cb; float* raw; LAS float* xch;
    __device__ __forceinline__ void operator()(AccRef acc, const Unit& u, int wr, int wc, int fr, int fq) const {
        const int clb = 32 * wc + 8 * fq;
        if (fr >= 14) {
#pragma unroll
            for (int ai = 0; ai < 2; ++ai)
#pragma unroll
                for (int bj = 0; bj < 2; ++bj)
#pragma unroll
                    for (int n = 0; n < 2; ++n) *(LAS f32x4*)(xch + ((ai * 2 + wr) * 2 + (fr - 14)) * 256 + bj * 128 + clb + 4 * n) = acc[ai][bj][3][n];
        }
        float* rawu = raw + (size_t)(u.pm * 22 + u.pn) * 1024;
        if (wr == 0 && fr < 2) {
#pragma unroll
            for (int bj = 0; bj < 2; ++bj)
#pragma unroll
                for (int n = 0; n < 2; ++n) *(f32x4*)(rawu + fr * 256 + bj * 128 + clb + 4 * n) = acc[0][bj][0][n];
        }
        if (wr == 1 && fr >= 14) {
#pragma unroll
            for (int bj = 0; bj < 2; ++bj)
#pragma unroll
                for (int n = 0; n < 2; ++n) *(f32x4*)(rawu + (fr - 12) * 256 + bj * 128 + clb + 4 * n) = acc[1][bj][3][n];
        }
        asm volatile("s_waitcnt lgkmcnt(0)" ::: "memory"); __builtin_amdgcn_s_barrier(); __builtin_amdgcn_s_barrier(); asm volatile("" ::: "memory");
        const int hc0 = 128 * u.pn + clb, row0 = u.pm * 256 + wr * 64 + fr;
        const float m1 = fr == 0 ? 1.f : 0.f, m2 = fr < 2 ? 1.f : 0.f;
#pragma unroll
        for (int n = 0; n < 2; ++n) {
            const float* cv = cw + hc0 + 4 * n; const float* cg = cw + FH + hc0 + 4 * n;
            const f32x4 w0v = *(const f32x4*)(cv), w1v = *(const f32x4*)(cv + F2), w2v = *(const f32x4*)(cv + 2 * F2), bvv = *(const f32x4*)(cb + hc0 + 4 * n);
            const f32x4 w0g = *(const f32x4*)(cg), w1g = *(const f32x4*)(cg + F2), w2g = *(const f32x4*)(cg + 2 * F2), bvg = *(const f32x4*)(cb + FH + hc0 + 4 * n);
            const f32x4 w0vm = w0v * m2, w1vm = w1v * m1, w0gm = w0g * m2, w1gm = w1g * m1;
#pragma unroll
            for (int ai = 0; ai < 2; ++ai) {
                f32x4 hv = (f32x4){0.f, 0.f, 0.f, 0.f}, hg = hv;
                const int pb = ai * 2 + wr - 1;
                if (pb >= 0 && fr >= 14) { hv = *(const LAS f32x4*)(xch + (pb * 2 + (fr - 14)) * 256 + clb + 4 * n); hg = *(const LAS f32x4*)(xch + (pb * 2 + (fr - 14)) * 256 + 128 + clb + 4 * n); }
#pragma unroll
                for (int m = 0; m < 4; ++m) {
                    const f32x4 pv = m ? acc[ai][0][m ? m - 1 : 0][n] : hv, pg = m ? acc[ai][1][m ? m - 1 : 0][n] : hg;
                    const f32x4 cvv = acc[ai][0][m][n], cgg = acc[ai][1][m][n];
                    float o[4];
#pragma unroll
                    for (int j = 0; j < 4; ++j) {
                        float hval = bvv[j] + w2v[j] * cvv[j];
                        conv_taps(hval, cvv[j], pv[j], w1v[j], w0v[j], w1vm[j], w0vm[j]);
                        float hgat = bvg[j] + w2g[j] * cgg[j];
                        conv_taps(hgat, cgg[j], pg[j], w1g[j], w0g[j], w1gm[j], w0gm[j]);
                        o[j] = hgat * sigmoidf_(hgat) * hval; }
                    u32x2 w; w.x = cvt_pk_bf16(o[0], o[1]); w.y = cvt_pk_bf16(o[2], o[3]);
                    *(u32x2*)(Aout + (size_t)(row0 + ai * 128 + m * 16) * FH + hc0 + 4 * n) = w; } } }
    }
};

#define XB_TMO      128
#define XB_XCNT(j)  (256  + 64 * (j))
#define XB_XSUB(j)  (1280 + 64 * (j))
#define XB_XGEN(j)  (2304 + 64 * (j))
#define XB_TOP      3328
#define XB_TOPGEN   3392
#define XCD_BAR_WORDS 3456
#define XB_SPIN_CAP (1u << 24)
__device__ __forceinline__ unsigned xb_ld(unsigned* p)              { return __hip_atomic_load(p, __ATOMIC_RELAXED, __HIP_MEMORY_SCOPE_AGENT); }
__device__ __forceinline__ unsigned xb_add(unsigned* p, unsigned v) { return __hip_atomic_fetch_add(p, v, __ATOMIC_RELAXED, __HIP_MEMORY_SCOPE_AGENT); }
__device__ __forceinline__ unsigned xb_xcc_id() { return (unsigned)__builtin_amdgcn_s_getreg((3 << 11) | 20) & 0xFu; }
#define XB_SPIN(cond, bar) do { unsigned _sp = 0; while (cond) { __builtin_amdgcn_s_sleep(1); \
    if ((++_sp & 255u) == 0u) { if (xb_ld(&(bar)[XB_TMO])) break; if (_sp > XB_SPIN_CAP) { atomicAdd(&(bar)[XB_TMO], 1u); break; } } } } while (0)
struct XcdBarrier { unsigned* bar; unsigned x; volatile LAS unsigned* st; };
__device__ __forceinline__ XcdBarrier xcd_barrier_post(unsigned* bar, volatile LAS unsigned* st) {
    XcdBarrier b; b.bar = bar; b.x = xb_xcc_id(); b.st = st;
    if (threadIdx.x == 0) (void)xb_add(&bar[XB_XCNT(b.x)], 1u);
    return b;
}
__device__ __forceinline__ void xcd_barrier_complete(unsigned* bar, unsigned x, unsigned& nloc, unsigned& nx) {
    const unsigned G = gridDim.x * gridDim.y * gridDim.z;
    unsigned sum, cnt, mine, sp = 0u;
    for (;;) {
        sum = 0u; cnt = 0u; mine = 0u;
#pragma unroll
        for (unsigned j = 0; j < 16; ++j) { const unsigned c = xb_ld(&bar[XB_XCNT(j)]); sum += c; cnt += (c > 0u) ? 1u : 0u; mine = (j == x) ? c : mine; }
        if (sum == G) break;
        __builtin_amdgcn_s_sleep(1);
        if ((++sp & 255u) == 0u) { if (xb_ld(&bar[XB_TMO])) break; if (sp > XB_SPIN_CAP) { atomicAdd(&bar[XB_TMO], 1u); break; } }
    }
    nloc = mine > 0u ? mine : 1u; nx = cnt > 0u ? cnt : 1u;
}
__device__ __forceinline__ void xcd_barrier(const XcdBarrier& b) {
    asm volatile("s_waitcnt vmcnt(0) lgkmcnt(0)" ::: "memory");
    __syncthreads();
    if (threadIdx.x == 0) {
        unsigned* bar = b.bar;
        __builtin_amdgcn_s_waitcnt(0);
        unsigned nloc = b.st[0], nx = b.st[1];
        if (nloc == 0u) { xcd_barrier_complete(bar, b.x, nloc, nx); b.st[0] = nloc; b.st[1] = nx; }
        const unsigned old = xb_add(&bar[XB_XSUB(b.x)], 1u);
        const unsigned gen = old / nloc;
        if (old + 1u == (gen + 1u) * nloc) {
            __builtin_amdgcn_fence(__ATOMIC_RELEASE, "agent");
            asm volatile("s_waitcnt vmcnt(0)" ::: "memory");
            const unsigned og = xb_add(&bar[XB_TOP], 1u);
            const unsigned tg = og / nx;
            if (og + 1u == (tg + 1u) * nx) xb_add(&bar[XB_TOPGEN], 1u);
            else XB_SPIN(xb_ld(&bar[XB_TOPGEN]) == tg, bar);
            __builtin_amdgcn_fence(__ATOMIC_ACQUIRE, "agent");
            xb_add(&bar[XB_XGEN(b.x)], 1u);
            asm volatile("s_waitcnt vmcnt(0)" ::: "memory");
        } else {
            XB_SPIN(xb_ld(&bar[XB_XGEN(b.x)]) == gen, bar);
            __builtin_amdgcn_fence(__ATOMIC_ACQUIRE, "agent");
            asm volatile("s_waitcnt vmcnt(0)" ::: "memory");
        }
    }
    __syncthreads();
}

struct Job { const float* src; bf16_t* dst; int K, ld, nrows, map, hh, item0; };
constexpr int NJOBS = 33;
struct Params {
    const float* in[33]; float* out; unsigned char* ws;
    Job jobs[NJOBS]; int nitems; int pad;
};

__device__ __forceinline__ int map_col(int map, int hh, int j) {
    if (map == 0) return j;
    if (map == 1) { const int pn = j >> 8, bj = (j >> 7) & 1, i = j & 127; return bj * hh + 128 * pn + i; }
    const int pn = j >> 8, cl = j & 255, bj = cl >> 7, h4 = (cl & 127) >> 5, i = cl & 31; return 256 * pn + 64 * h4 + 32 * bj + i;
}

__device__ __forceinline__ void weights_phase(const Params& P, LAS unsigned char* lds) {
    const int tid__ = otid(); const int lane = tid__ & 63, wave = tid__ >> 6;
    LAS float* scr = (LAS float*)(lds + wave * 8448);
    const int gw = blockIdx.x * 8 + wave, ngw = gridDim.x * 8;
    for (int it = gw; it < P.nitems; it += ngw) {
        int ji = 0;
#pragma unroll 1
        for (int q = 1; q < NJOBS; ++q) if (it >= P.jobs[q].item0) ji = q;
        const Job jb = P.jobs[ji];
        const int r = it - jb.item0, nblk = jb.nrows / 32, kb = r / nblk, nb = r % nblk, k0 = 64 * kb, n0 = 32 * nb, c0 = map_col(jb.map, jb.hh, n0);
#pragma unroll 8
        for (int i = 0; i < 32; ++i) { const int kk = 2 * i + (lane >> 5); scr[kk * 33 + (lane & 31)] = jb.src[(size_t)(k0 + kk) * jb.ld + c0 + (lane & 31)]; }
        asm volatile("s_waitcnt lgkmcnt(0)" ::: "memory");
        const int c = lane & 7;
#pragma unroll
        for (int j = 0; j < 4; ++j) { const int n = (lane >> 3) + 8 * j; const LAS float* s = scr + (8 * c) * 33 + n;
            u32x4 o; o.x = cvt_pk_bf16(s[0 * 33], s[1 * 33]); o.y = cvt_pk_bf16(s[2 * 33], s[3 * 33]); o.z = cvt_pk_bf16(s[4 * 33], s[5 * 33]); o.w = cvt_pk_bf16(s[6 * 33], s[7 * 33]);
            *(u32x4*)(jb.dst + (size_t)(n0 + n) * jb.K + k0 + 8 * c) = o; }
        asm volatile("s_waitcnt lgkmcnt(0)" ::: "memory");
    }
}
__device__ __forceinline__ void rmsnorm_phase(const float* x, const float* g, bf16_t* hn) {
    const int tid__ = otid(); const int lane = tid__ & 63, wave = tid__ >> 6;
    const int gw = blockIdx.x * 8 + wave, ngw = gridDim.x * 8;
    f32x4 gv[4];
#pragma unroll
    for (int j = 0; j < 4; ++j) gv[j] = *((const f32x4*)g + lane + 64 * j);
    for (int m = gw; m < T; m += ngw) {
        const f32x4* xr = (const f32x4*)(x + (size_t)m * D) + lane;
        f32x4 v[4]; float s = 0.f;
#pragma unroll
        for (int j = 0; j < 4; ++j) { v[j] = xr[64 * j]; s += (v[j][0] * v[j][0] + v[j][1] * v[j][1]) + (v[j][2] * v[j][2] + v[j][3] * v[j][3]); }
        const float rstd = rsqrtf(wave_sum(s) * (1.0f / D) + 1e-6f);
        u32x2* o = (u32x2*)(hn + (size_t)m * D) + lane;
#pragma unroll
        for (int j = 0; j < 4; ++j) { const f32x4 y = v[j] * rstd * gv[j]; u32x2 w; w.x = cvt_pk_bf16(y[0], y[1]); w.y = cvt_pk_bf16(y[2], y[3]); o[64 * j] = w; }
    }
}
__device__ __forceinline__ void ld8(const bf16_t* p, float (&v)[8]) {
    const u32x4 w = *(const u32x4*)p;
#pragma unroll
    for (int i = 0; i < 4; ++i) { v[2 * i] = bflo(w[i]); v[2 * i + 1] = bfhi(w[i]); }
}
__device__ __forceinline__ void st8(bf16_t* p, const float (&v)[8]) {
    u32x4 w; w.x = cvt_pk_bf16(v[0], v[1]); w.y = cvt_pk_bf16(v[2], v[3]); w.z = cvt_pk_bf16(v[4], v[5]); w.w = cvt_pk_bf16(v[6], v[7]);
    *(u32x4*)p = w;
}
__device__ __forceinline__ void pool_phase(const bf16_t* hn, bf16_t* dd) {
    for (int gid = blockIdx.x * NTHREADS + otid(); gid < (T / 32) * 128; gid += gridDim.x * NTHREADS) {
        const int col8 = gid & 127, chunk = gid >> 7, w = 2 << (col8 >> 5), t0 = chunk * 32, pos0 = t0 & (SEQ - 1);
        const bf16_t* hp = hn + (size_t)t0 * D + col8 * 8; bf16_t* dp = dd + (size_t)t0 * D + col8 * 8;
        float s[8];
#pragma unroll
        for (int i = 0; i < 8; ++i) s[i] = 0.f;
        if (pos0) for (int k = 1; k <= w; ++k) { float v[8]; ld8(hp - (size_t)k * D, v);
#pragma unroll
            for (int i = 0; i < 8; ++i) s[i] += v[i]; }
        for (int i = 0; i < 32; ++i) {
            float cur[8]; ld8(hp + (size_t)i * D, cur); const int pos = pos0 + i;
#pragma unroll
            for (int q = 0; q < 8; ++q) s[q] += cur[q];
            if (pos >= w) { float v[8]; ld8(hp + (size_t)(i - w) * D, v);
#pragma unroll
                for (int q = 0; q < 8; ++q) s[q] -= v[q]; }
            const float inv = 1.0f / (float)(pos + 1 < w ? pos + 1 : w);
            float o[8];
#pragma unroll
            for (int q = 0; q < 8; ++q) o[q] = s[q] * inv - cur[q];
            st8(dp + (size_t)i * D, o);
        }
    }
}
__device__ __forceinline__ void lruconv_phase(const bf16_t* pre, const float* cw, const float* cb, bf16_t* rec) {
    for (int gid = blockIdx.x * NTHREADS + otid(); gid < (T / 32) * 128; gid += gridDim.x * NTHREADS) {
        const int col8 = gid & 127, chunk = gid >> 7, t0 = chunk * 32, pos0 = t0 & (SEQ - 1);
        const bf16_t* hp = pre + (size_t)t0 * D + col8 * 8; bf16_t* dp = rec + (size_t)t0 * D + col8 * 8;
        float w0[8], w1[8], w2[8], w3[8], bb[8], p3[8], p2[8], p1[8];
#pragma unroll
        for (int i = 0; i < 8; ++i) { w0[i] = cw[col8 * 8 + i]; w1[i] = cw[D + col8 * 8 + i]; w2[i] = cw[2 * D + col8 * 8 + i]; w3[i] = cw[3 * D + col8 * 8 + i]; bb[i] = cb[col8 * 8 + i]; p3[i] = 0.f; p2[i] = 0.f; p1[i] = 0.f; }
        if (pos0) { ld8(hp - 3 * (size_t)D, p3); ld8(hp - 2 * (size_t)D, p2); ld8(hp - (size_t)D, p1); }
        for (int i = 0; i < 32; ++i) {
            float cur[8], o[8]; ld8(hp + (size_t)i * D, cur);
#pragma unroll
            for (int q = 0; q < 8; ++q) { o[q] = bb[q] + w0[q] * p3[q] + w1[q] * p2[q] + w2[q] * p1[q] + w3[q] * cur[q]; p3[q] = p2[q]; p2[q] = p1[q]; p1[q] = cur[q]; }
            st8(dp + (size_t)i * D, o);
        }
    }
}
__device__ __forceinline__ void lruscan_phase(const bf16_t* LA, const bf16_t* BV, bf16_t* GG, LAS unsigned char* lds) {
    LAS float* sA = (LAS float*)lds; LAS float* sB = sA + 64 * 64;
    const int tid__ = otid(); const int c8 = tid__ & 7, tc = tid__ >> 3;
    for (int unit = blockIdx.x; unit < 256; unit += gridDim.x) {
        const int b = unit >> 4, cgp = unit & 15;
        const size_t base = ((size_t)b * SEQ + tc * 32) * D + cgp * 64 + c8 * 8;
        float sl[8], Bv[8], h[8];
#pragma unroll
        for (int q = 0; q < 8; ++q) { sl[q] = 0.f; Bv[q] = 0.f; h[q] = 0.f; }
#pragma unroll 4
        for (int i = 0; i < 32; ++i) { float la[8], bb[8]; ld8(LA + base + (size_t)i * D, la); ld8(BV + base + (size_t)i * D, bb);
#pragma unroll
            for (int q = 0; q < 8; ++q) { Bv[q] = __expf(la[q]) * Bv[q] + bb[q]; sl[q] += la[q]; } }
#pragma unroll
        for (int q = 0; q < 8; ++q) { sA[tc * 64 + c8 * 8 + q] = __expf(sl[q]); sB[tc * 64 + c8 * 8 + q] = Bv[q]; }
        __syncthreads();
        for (int j = 0; j < tc; ++j) {
            const f32x4 a0 = *(const LAS f32x4*)(sA + j * 64 + c8 * 8), a1 = *(const LAS f32x4*)(sA + j * 64 + c8 * 8 + 4), b0 = *(const LAS f32x4*)(sB + j * 64 + c8 * 8), b1 = *(const LAS f32x4*)(sB + j * 64 + c8 * 8 + 4);
#pragma unroll
            for (int q = 0; q < 4; ++q) { h[q] = a0[q] * h[q] + b0[q]; h[4 + q] = a1[q] * h[4 + q] + b1[q]; } }
#pragma unroll 4
        for (int i = 0; i < 32; ++i) { float la[8], bb[8], gg[8], y[8]; ld8(LA + base + (size_t)i * D, la); ld8(BV + base + (size_t)i * D, bb); ld8(GG + base + (size_t)i * D, gg);
#pragma unroll
            for (int q = 0; q < 8; ++q) { h[q] = __expf(la[q]) * h[q] + bb[q]; y[q] = gg[q] * h[q]; }
            st8(GG + base + (size_t)i * D, y); }
        __syncthreads();
    }
}
__device__ __forceinline__ void ffn_fix_panel(const float* raw, const float* cw, const float* cb, bf16_t* Aout, int pm) {
    if ((pm & 7) == 0) return;
    for (int idx = otid(); idx < 2 * FH; idx += NTHREADS) {
        const int hc = idx % FH, rr = idx / FH;
        const int pn = hc >> 7, cl = hc & 127;
        const float* cur = raw + (size_t)(pm * 22 + pn) * 1024; const float* prv = raw + (size_t)((pm - 1) * 22 + pn) * 1024;
        float hh[2];
#pragma unroll
        for (int part = 0; part < 2; ++part) { const int off = part * 128 + cl, col = part * FH + hc;
            const float x0 = cur[rr * 256 + off], x1 = rr ? cur[off] : prv[3 * 256 + off], x2 = rr ? prv[3 * 256 + off] : prv[2 * 256 + off];
            hh[part] = cb[col] + cw[2 * F2 + col] * x0 + cw[F2 + col] * x1 + cw[col] * x2; }
        const float o = hh[1] * sigmoidf_(hh[1]) * hh[0];
        Aout[(size_t)(pm * 256 + rr) * FH + hc] = (bf16_t)(cvt_pk_bf16(o, 0.f) & 0xffffu);
    }
}
__device__ __forceinline__ void vt_phase(const bf16_t* V, bf16_t* VT, LAS unsigned char* lds) {
    const int tid__ = otid(); const int lane = tid__ & 63, wave = tid__ >> 6;
    LAS bf16_t* scr = (LAS bf16_t*)(lds + wave * 8704);
    const int gw = blockIdx.x * 8 + wave, ngw = gridDim.x * 8;
    for (int it = gw; it < 16 * 16 * 32; it += ngw) {
        const int st = it & 31, h = (it >> 5) & 15, b = it >> 9, s0 = st * 64;
#pragma unroll
        for (int j = 0; j < 8; ++j) { const int i = (lane >> 3) + 8 * j, c = lane & 7;
            const u32x4 w = *(const u32x4*)(V + (size_t)(b * SEQ + s0 + i) * D + h * 64 + 8 * c);
            *(LAS u32x2*)(scr + i * 68 + 8 * c) = (u32x2){w.x, w.y}; *(LAS u32x2*)(scr + i * 68 + 8 * c + 4) = (u32x2){w.z, w.w}; }
        asm volatile("s_waitcnt lgkmcnt(0)" ::: "memory");
#pragma unroll
        for (int j = 0; j < 8; ++j) { const int d = (lane >> 3) + 8 * j, c = lane & 7;
            unsigned short e[8];
#pragma unroll
            for (int k = 0; k < 8; ++k) e[k] = scr[(8 * c + k) * 68 + d];
            u32x4 w; w.x = e[0] | ((unsigned)e[1] << 16); w.y = e[2] | ((unsigned)e[3] << 16); w.z = e[4] | ((unsigned)e[5] << 16); w.w = e[6] | ((unsigned)e[7] << 16);
            *(u32x4*)(VT + ((size_t)(b * 16 + h) * 64 + d) * SEQ + s0 + 8 * c) = w; }
        asm volatile("s_waitcnt lgkmcnt(0)" ::: "memory");
    }
}

__device__ __forceinline__ void s5_phase(const Params& P, const bf16_t* hn, bf16_t* ys, LAS unsigned char* lds) {
    const int tid__ = otid(); const int lane = tid__ & 63, wave = tid__ >> 6;
    if (wave >= 4) return;
    LAS unsigned* S = (LAS unsigned*)(lds + wave * 8704);
    const float* lam_re = P.in[6]; const float* lam_im = P.in[7]; const float* log_dt = P.in[8]; const float* b_re = P.in[9]; const float* b_im = P.in[10];
    const float* c_re = P.in[11]; const float* c_im = P.in[12]; const float* dsk = P.in[13];
    const int c32 = lane & 31, hf = lane >> 5, c16 = lane & 15, q4 = lane >> 4;
    for (int unit = blockIdx.x * 4 + wave; unit < 1024; unit += gridDim.x * 4) {
        const int b = unit >> 6, g = unit & 63;
        const float dt = expf(log_dt[g]);
        float ar, ai;
        { const float lr = fminf(lam_re[g * 64 + lane], -1e-4f), li = lam_im[g * 64 + lane]; const float er = expf(lr * dt); ar = er * cosf(li * dt); ai = er * sinf(li * dt); }
        bf16x8 Bre[2], Bim[2];
#pragma unroll
        for (int pb = 0; pb < 2; ++pb) {
            const int pp = pb * 32 + c32;
            const float lr = fminf(lam_re[g * 64 + pp], -1e-4f), li = lam_im[g * 64 + pp]; const float er = expf(lr * dt);
            const float nr = er * cosf(li * dt) - 1.0f, ni = er * sinf(li * dt), dd = lr * lr + li * li;
            const float cr = (nr * lr + ni * li) / dd, ci = (ni * lr - nr * li) / dd;
            const float* br = b_re + (size_t)(g * 64 + pp) * 16 + 8 * hf; const float* bi = b_im + (size_t)(g * 64 + pp) * 16 + 8 * hf;
            unsigned wr_[4], wi_[4];
#pragma unroll
            for (int i = 0; i < 4; ++i) { const float r0 = br[2 * i], i0 = bi[2 * i], r1 = br[2 * i + 1], i1 = bi[2 * i + 1];
                wr_[i] = cvt_pk_bf16(cr * r0 - ci * i0, cr * r1 - ci * i1); wi_[i] = cvt_pk_bf16(cr * i0 + ci * r0, cr * i1 + ci * r1); }
            Bre[pb] = __builtin_bit_cast(bf16x8, (u32x4){wr_[0], wr_[1], wr_[2], wr_[3]}); Bim[pb] = __builtin_bit_cast(bf16x8, (u32x4){wi_[0], wi_[1], wi_[2], wi_[3]});
        }
        bf16x8 Cf[4];
#pragma unroll
        for (int kb = 0; kb < 4; ++kb) { const int p0 = kb * 16 + 4 * q4; const float* cr = c_re + (size_t)(g * 16 + c16) * 64 + p0; const float* ci = c_im + (size_t)(g * 16 + c16) * 64 + p0;
            Cf[kb] = __builtin_bit_cast(bf16x8, (u32x4){cvt_pk_bf16(cr[0], -ci[0]), cvt_pk_bf16(cr[1], -ci[1]), cvt_pk_bf16(cr[2], -ci[2]), cvt_pk_bf16(cr[3], -ci[3])}); }
        float dk[4];
#pragma unroll
        for (int r = 0; r < 4; ++r) dk[r] = dsk[g * 16 + 4 * q4 + r];
        float sr = 0.f, si = 0.f;
        const bf16_t* hb = hn + (size_t)b * SEQ * D + g * 16; bf16_t* yb = ys + (size_t)b * SEQ * D + g * 16;
        for (int c = 0; c < SEQ / 32; ++c) {
            const int t0 = c * 32;
            const bf16x8 uf = *(const bf16x8*)(hb + (size_t)(t0 + c32) * D + 8 * hf);
            const f32x16 z16 = {0.f, 0.f, 0.f, 0.f, 0.f, 0.f, 0.f, 0.f, 0.f, 0.f, 0.f, 0.f, 0.f, 0.f, 0.f, 0.f};
            f32x16 r0 = __builtin_amdgcn_mfma_f32_32x32x16_bf16(uf, Bre[0], z16, 0, 0, 0), r1 = __builtin_amdgcn_mfma_f32_32x32x16_bf16(uf, Bre[1], z16, 0, 0, 0);
            f32x16 i0 = __builtin_amdgcn_mfma_f32_32x32x16_bf16(uf, Bim[0], z16, 0, 0, 0), i1 = __builtin_amdgcn_mfma_f32_32x32x16_bf16(uf, Bim[1], z16, 0, 0, 0);
#pragma unroll
            for (int q = 0; q < 4; ++q) {
                float xr[8], xi[8];
#pragma unroll
                for (int i = 0; i < 4; ++i) {
                    auto pr = __builtin_amdgcn_permlane32_swap(__float_as_uint(r0[4 * q + i]), __float_as_uint(r1[4 * q + i]), false, false);
                    auto pi = __builtin_amdgcn_permlane32_swap(__float_as_uint(i0[4 * q + i]), __float_as_uint(i1[4 * q + i]), false, false);
                    xr[i] = __uint_as_float(pr[0]); xr[4 + i] = __uint_as_float(pr[1]); xi[i] = __uint_as_float(pi[0]); xi[4 + i] = __uint_as_float(pi[1]); }
#pragma unroll
                for (int i = 0; i < 8; ++i) { const float nr = ar * sr - ai * si + xr[i], ni = ar * si + ai * sr + xi[i]; sr = nr; si = ni;
                    S[(8 * q + i) * 68 + lane] = cvt_pk_bf16(sr, si); }
            }
            asm volatile("" ::: "memory");
#pragma unroll
            for (int tb = 0; tb < 2; ++tb) {
                f32x4 y = (f32x4){0.f, 0.f, 0.f, 0.f};
#pragma unroll
                for (int kb = 0; kb < 4; ++kb) { const bf16x8 sf = __builtin_bit_cast(bf16x8, *(const LAS u32x4*)(S + (tb * 16 + c16) * 68 + kb * 16 + 4 * q4));
                    y = __builtin_amdgcn_mfma_f32_16x16x32_bf16(Cf[kb], sf, y, 0, 0, 0); }
                const size_t off = (size_t)(t0 + tb * 16 + c16) * D + 4 * q4;
                const u32x2 uw = *(const u32x2*)(hb + off);
                const float u0 = bflo(uw.x), u1 = bfhi(uw.x), u2 = bflo(uw.y), u3 = bfhi(uw.y);
                u32x2 w; w.x = cvt_pk_bf16(gelu_tanh(y[0] + dk[0] * u0), gelu_tanh(y[1] + dk[1] * u1)); w.y = cvt_pk_bf16(gelu_tanh(y[2] + dk[2] * u2), gelu_tanh(y[3] + dk[3] * u3));
                *(u32x2*)(yb + off) = w;
            }
        }
    }
}

__device__ __forceinline__ void attn_phase(const bf16_t* Q, const bf16_t* Kb, const bf16_t* VT, bf16_t* O) {
    const int tid__ = otid(); const int lane = tid__ & 63, wave = tid__ >> 6, c32 = lane & 31, hf = lane >> 5;
    for (int bh = blockIdx.x; bh < 256; bh += gridDim.x) {
        const int b = bh >> 4, h = bh & 15;
        const bf16_t* vtb = VT + (size_t)(b * 16 + h) * 64 * SEQ;
        for (int it = 0; it < 8; ++it) {
            const int qb = wave * 8 + it, t0 = qb * 32;
            const bf16_t* qp = Q + (size_t)(b * SEQ + t0 + c32) * D + h * 64 + 8 * hf;
            bf16x8 qf[4];
#pragma unroll
            for (int kd = 0; kd < 4; ++kd) qf[kd] = *(const bf16x8*)(qp + 16 * kd);
            f32x16 o0 = {0.f, 0.f, 0.f, 0.f, 0.f, 0.f, 0.f, 0.f, 0.f, 0.f, 0.f, 0.f, 0.f, 0.f, 0.f, 0.f}, o1 = o0;
            float R = 0.f;
            for (int kt = qb; kt >= 0; --kt) {
                const int s0 = kt * 32;
                const bf16_t* kp = Kb + (size_t)(b * SEQ + s0 + c32) * D + h * 64 + 8 * hf;
                f32x16 z = {0.f, 0.f, 0.f, 0.f, 0.f, 0.f, 0.f, 0.f, 0.f, 0.f, 0.f, 0.f, 0.f, 0.f, 0.f, 0.f};
#pragma unroll
                for (int kd = 0; kd < 4; ++kd) { const bf16x8 kf = *(const bf16x8*)(kp + 16 * kd); z = __builtin_amdgcn_mfma_f32_32x32x16_bf16(kf, qf[kd], z, 0, 0, 0); }
                bf16x8 vf[2][2];
#pragma unroll
                for (int db = 0; db < 2; ++db)
#pragma unroll
                    for (int ks = 0; ks < 2; ++ks) { const bf16_t* vp = vtb + (size_t)(db * 32 + c32) * SEQ + s0 + 16 * ks + 4 * hf;
                        const u32x2 a = *(const u32x2*)vp, c = *(const u32x2*)(vp + 8); vf[db][ks] = __builtin_bit_cast(bf16x8, (u32x4){a.x, a.y, c.x, c.y}); }
                float L[16], lg[16];
                const bool diag = (kt == qb);
#pragma unroll
                for (int r = 0; r < 16; ++r) { const float zz = z[r]; const float sp = fmaxf(zz, 0.f) + __logf(1.0f + __expf(-fabsf(zz)));
                    const int sl = 8 * (r >> 2) + 4 * hf + (r & 3); const bool valid = !diag || (sl < c32);
                    L[r] = valid ? -sp : 0.f; lg[r] = valid ? zz - sp : -1e30f; }
                float bs[4], pbs[4];
#pragma unroll
                for (int q = 0; q < 4; ++q) { bs[q] = (L[4 * q] + L[4 * q + 1]) + (L[4 * q + 2] + L[4 * q + 3]); pbs[q] = __shfl_xor(bs[q], 32); }
                float after = R; float att[16];
#pragma unroll
                for (int q = 3; q >= 0; --q) {
                    const float off = after + (hf == 0 ? pbs[q] : 0.f);
                    const float e3 = off, e2 = e3 + L[4 * q + 3], e1 = e2 + L[4 * q + 2], e0 = e1 + L[4 * q + 1];
                    att[4 * q + 3] = __expf(lg[4 * q + 3] + e3); att[4 * q + 2] = __expf(lg[4 * q + 2] + e2); att[4 * q + 1] = __expf(lg[4 * q + 1] + e1); att[4 * q] = __expf(lg[4 * q] + e0);
                    after += bs[q] + pbs[q];
                }
                R = after;
#pragma unroll
                for (int ks = 0; ks < 2; ++ks) {
                    const bf16x8 pf = __builtin_bit_cast(bf16x8, (u32x4){cvt_pk_bf16(att[8 * ks], att[8 * ks + 1]), cvt_pk_bf16(att[8 * ks + 2], att[8 * ks + 3]), cvt_pk_bf16(att[8 * ks + 4], att[8 * ks + 5]), cvt_pk_bf16(att[8 * ks + 6], att[8 * ks + 7])});
                    o0 = __builtin_amdgcn_mfma_f32_32x32x16_bf16(vf[0][ks], pf, o0, 0, 0, 0); o1 = __builtin_amdgcn_mfma_f32_32x32x16_bf16(vf[1][ks], pf, o1, 0, 0, 0); }
                if (__all(R < -120.0f)) break;
            }
            bf16_t* op = O + (size_t)(b * SEQ + t0 + c32) * D + h * 64 + 4 * hf;
#pragma unroll
            for (int q = 0; q < 4; ++q) {
                u32x2 w0; w0.x = cvt_pk_bf16(o0[4 * q], o0[4 * q + 1]); w0.y = cvt_pk_bf16(o0[4 * q + 2], o0[4 * q + 3]); *(u32x2*)(op + 8 * q) = w0;
                u32x2 w1; w1.x = cvt_pk_bf16(o1[4 * q], o1[4 * q + 1]); w1.y = cvt_pk_bf16(o1[4 * q + 2], o1[4 * q + 3]); *(u32x2*)(op + 32 + 8 * q) = w1; }
        }
    }
}


__global__ void __launch_bounds__(NTHREADS, 2) fwd_megakernel(Params P) {
    extern __shared__ __attribute__((aligned(16))) unsigned char lds_raw[];
    LAS unsigned char* lds = (LAS unsigned char*)lds_raw;
    cg::grid_group grid = cg::this_grid();
    unsigned char* ws = P.ws;
    bf16_t* HN = (bf16_t*)(ws + WS_HN);
    bf16_t* B0 = (bf16_t*)(ws + WS_BIG); bf16_t* B1 = (bf16_t*)(ws + WS_BIG + ACT); bf16_t* B2 = (bf16_t*)(ws + WS_BIG + 2 * ACT); bf16_t* B3 = (bf16_t*)(ws + WS_BIG + 3 * ACT); bf16_t* B4 = (bf16_t*)(ws + WS_BIG + 4 * ACT);
    float* RAW = (float*)(ws + WS_RAW);
    float* X = P.out;
    const int G = gridDim.x, bx = blockIdx.x;
    pg8::StaticOrder S;
    volatile LAS unsigned* MISC = (volatile LAS unsigned*)(lds + MISC_OFF);
    if (threadIdx.x < 2) MISC[threadIdx.x] = 0u;
    __syncthreads();
    const XcdBarrier bar = xcd_barrier_post((unsigned*)ws, MISC);
    grid.sync();
#define SYNC() xcd_barrier(bar)

    weights_phase(P, lds);
    rmsnorm_phase(P.in[0], P.in[1], HN);
    SYNC();
#define FFN_BLOCK(layer, LASTSYNC) do { \
        rmsnorm_phase(X, P.in[2] + (layer) * D, HN); \
        SYNC(); \
        const float* cw = P.in[30] + (size_t)(layer) * 3 * F2; const float* cb = P.in[31] + (size_t)(layer) * F2; \
        { pg8::Gemm g{HN, (const bf16_t*)(ws + WS_WF1) + (size_t)(layer) * F2 * D, T, F2, 1024, D, D, 0, 0}; S.init(T, F2, G, bx); \
          EpiFfn1 E{B0, cw, cb, RAW, (LAS float*)(lds + XCH_OFF)}; pg8::gemm_phase(lds, g, S, E); } \
        SYNC(); \
        { pg8::Gemm g{B0, (const bf16_t*)(ws + WS_WF2) + (size_t)(layer) * D * FH, T, 1024, FH, FH, FH, 0, 0}; S.init(T, 1024, G, bx); \
          { Unit fu; int lastpm = -1; for (int i = 0; S.next(i, fu); ++i) if (fu.pm != lastpm) { ffn_fix_panel(RAW, cw, cb, B0, fu.pm); lastpm = fu.pm; } } \
          asm volatile("s_waitcnt vmcnt(0)" ::: "memory"); __syncthreads(); \
          EpiRes E{X, X, nullptr, nullptr}; pg8::gemm_phase(lds, g, S, E); } \
        if (LASTSYNC) SYNC(); } while (0)

    pool_phase(HN, B0);
    SYNC();
    { pg8::Gemm g{B0, (const bf16_t*)(ws + WS_WPOOL), T, 1024, 256, D, 256, 0, 512}; S.init(T, 1024, G, bx);
      EpiRes E{P.in[0], X, P.in[5], P.in[4]}; pg8::gemm_phase(lds, g, S, E); }
    SYNC();
    FFN_BLOCK(0, true);
    rmsnorm_phase(X, P.in[1] + 1 * D, HN);
    SYNC();
    s5_phase(P, HN, B0, lds);
    SYNC();
    { pg8::Gemm g{B0, (const bf16_t*)(ws + WS_WS5), T, 2048, 1024, D, D, 0, 0}; S.init(T, 2048, G, bx);
      EpiGateRes E{X, P.in[15]}; pg8::gemm_phase(lds, g, S, E); }
    SYNC();
    FFN_BLOCK(1, true);
    rmsnorm_phase(X, P.in[1] + 2 * D, HN);
    SYNC();
    { pg8::Gemm g{HN, (const bf16_t*)(ws + WS_WLIN), T, 2048, 1024, D, D, 0, 0}; S.init(T, 2048, G, bx);
      EpiLruIn E{B0, B1}; pg8::gemm_phase(lds, g, S, E); }
    SYNC();
    lruconv_phase(B1, P.in[17], P.in[18], B2);
    SYNC();
    { pg8::Gemm g{B2, (const bf16_t*)(ws + WS_WGATE), T, 2048, 256, D, 256, 1, 512}; S.init(T, 2048, G, bx);
      EpiGates E{B2, B3, B4, P.in[20], P.in[22], P.in[23]}; pg8::gemm_phase(lds, g, S, E); }
    SYNC();
    lruscan_phase(B3, B4, B0, lds);
    SYNC();
    { pg8::Gemm g{B0, (const bf16_t*)(ws + WS_WLOUT), T, 1024, 1024, D, D, 0, 0}; S.init(T, 1024, G, bx);
      EpiRes E{X, X, nullptr, nullptr}; pg8::gemm_phase(lds, g, S, E); }
    SYNC();
    FFN_BLOCK(2, true);
    rmsnorm_phase(X, P.in[1] + 3 * D, HN);
    SYNC();
    { pg8::Gemm g{HN, (const bf16_t*)(ws + WS_WQKV), T, 3072, 1024, D, D, 0, 0}; S.init(T, 3072, G, bx);
      EpiQKV E{B0, P.in[26], P.in[27]}; pg8::gemm_phase(lds, g, S, E); }
    SYNC();
    vt_phase(B2, B3, lds);
    SYNC();
    attn_phase(B0, B1, B3, B4);
    SYNC();
    { pg8::Gemm g{B4, (const bf16_t*)(ws + WS_WWO), T, 1024, 1024, D, D, 0, 0}; S.init(T, 1024, G, bx);
      EpiRes E{X, X, nullptr, nullptr}; pg8::gemm_phase(lds, g, S, E); }
    SYNC();
    FFN_BLOCK(3, false);
}

extern "C" void kernel_launch(void* const* d_in, const int* in_sizes, int n_in, void* d_out, int out_size, void* d_ws, size_t ws_size, hipStream_t stream) {
    static int grid = 0;
    if (grid == 0) {
        if (n_in != 33 || out_size != T * D || ws_size < WS_END) { fprintf(stderr, "kernel_launch: unexpected shapes (n_in %d out %d ws %zu)\n", n_in, out_size, ws_size); grid = -1; return; }
        int dev = 0, cus = 0, per_cu = 0;
        (void)hipGetDevice(&dev); (void)hipDeviceGetAttribute(&cus, hipDeviceAttributeMultiprocessorCount, dev);
        if (hipFuncSetAttribute((const void*)fwd_megakernel, hipFuncAttributeMaxDynamicSharedMemorySize, LDS_BYTES) != hipSuccess) { fprintf(stderr, "kernel_launch: hipFuncSetAttribute failed\n"); grid = -1; return; }
        (void)hipOccupancyMaxActiveBlocksPerMultiprocessor(&per_cu, (const void*)fwd_megakernel, NTHREADS, LDS_BYTES);
        (void)hipGetLastError();
        if (per_cu < 1) per_cu = 1;
        grid = cus * per_cu;
        if (grid > 256) grid = 256;
    }
    if (grid < 0) return;
    Params p; memset(&p, 0, sizeof(p));
    for (int i = 0; i < 33; ++i) p.in[i] = (const float*)d_in[i];
    p.out = (float*)d_out; p.ws = (unsigned char*)d_ws;
    unsigned char* ws = (unsigned char*)d_ws;
    int nj = 0, items = 0;
    auto add = [&](const float* src, bf16_t* dst, int K, int ld, int nrows, int map, int hh) {
        Job& j = p.jobs[nj++]; j.src = src; j.dst = dst; j.K = K; j.ld = ld; j.nrows = nrows; j.map = map; j.hh = hh; j.item0 = items; items += (K / 64) * (nrows / 32); };
    for (int l = 0; l < 4; ++l) add(p.in[29] + (size_t)l * D * F2, (bf16_t*)(ws + WS_WF1) + (size_t)l * F2 * D, 1024, F2, F2, 1, FH);
    for (int l = 0; l < 4; ++l) add(p.in[32] + (size_t)l * FH * D, (bf16_t*)(ws + WS_WF2) + (size_t)l * D * FH, FH, D, D, 0, 0);
    for (int gI = 0; gI < 4; ++gI) add(p.in[3] + (size_t)gI * 65536, (bf16_t*)(ws + WS_WPOOL) + (size_t)gI * 65536, 256, 256, 256, 0, 0);
    add(p.in[14], (bf16_t*)(ws + WS_WS5), 1024, 2048, 2048, 1, 1024);
    add(p.in[16], (bf16_t*)(ws + WS_WLIN), 1024, 2048, 2048, 0, 0);
    for (int pn = 0; pn < 8; ++pn) for (int bj = 0; bj < 2; ++bj)
        add((bj ? p.in[21] : p.in[19]) + (size_t)(pn >> 1) * 65536 + (pn & 1) * 128, (bf16_t*)(ws + WS_WGATE) + (size_t)(pn * 256 + bj * 128) * 256, 256, 256, 128, 0, 0);
    add(p.in[24], (bf16_t*)(ws + WS_WLOUT), 1024, 1024, 1024, 0, 0);
    add(p.in[25], (bf16_t*)(ws + WS_WQKV), 1024, 3072, 3072, 2, 0);
    add(p.in[28], (bf16_t*)(ws + WS_WWO), 1024, 1024, 1024, 0, 0);
    p.nitems = items;
    if (hipMemsetAsync(d_ws, 0, 16384, stream) != hipSuccess) { fprintf(stderr, "kernel_launch: memset failed\n"); return; }
    void* args[] = {&p};
    hipError_t e = hipLaunchCooperativeKernel((const void*)fwd_megakernel, dim3(grid), dim3(NTHREADS), args, LDS_BYTES, stream);
    if (e != hipSuccess) fprintf(stderr, "cooperative launch failed: %s (grid %d)\n", hipGetErrorString(e), grid);
}
```

```cpp
#include <hip/hip_runtime.h>
#include <hip/hip_cooperative_groups.h>
#include <cstdio>
#include <cstring>
namespace cg = cooperative_groups;

#define LAS __attribute__((address_space(3)))
typedef unsigned short bf16_t;
typedef short bf16x8 __attribute__((ext_vector_type(8)));
typedef short bf16x4 __attribute__((ext_vector_type(4)));
typedef float f32x4 __attribute__((ext_vector_type(4)));
typedef float f32x16 __attribute__((ext_vector_type(16)));
typedef unsigned u32x4 __attribute__((ext_vector_type(4)));
typedef unsigned u32x2 __attribute__((ext_vector_type(2)));

constexpr int T = 32768, D = 1024, SEQ = 2048, FH = 2816, F2 = 5632;
constexpr int NTHREADS = 512;
constexpr int LDS_BYTES = 147456;
constexpr int XCH_OFF = 131072, MISC_OFF = 131072 + 8192;
constexpr size_t MiB = 1u << 20;
constexpr size_t WS_WPOOL = 1 * MiB, WS_WS5 = 2 * MiB, WS_WLIN = 6 * MiB, WS_WGATE = 10 * MiB, WS_WLOUT = 11 * MiB,
                 WS_WQKV = 13 * MiB, WS_WWO = 19 * MiB, WS_WF1 = 21 * MiB, WS_WF2 = 65 * MiB,
                 WS_HN = 96 * MiB, WS_BIG = 160 * MiB, WS_RAW = 480 * MiB, WS_END = 492 * MiB;
constexpr size_t ACT = 64 * MiB;

typedef __bf16 bf16v2_t __attribute__((ext_vector_type(2)));
__device__ __forceinline__ unsigned cvt_pk_bf16(float lo, float hi) { const bf16v2_t v = {(__bf16)lo, (__bf16)hi}; return __builtin_bit_cast(unsigned, v); }
__device__ __forceinline__ float bf2f(unsigned short b) { return __uint_as_float(((unsigned)b) << 16); }
__device__ __forceinline__ float bflo(unsigned w) { return __uint_as_float(w << 16); }
__device__ __forceinline__ float bfhi(unsigned w) { return __uint_as_float(w & 0xffff0000u); }
__device__ __forceinline__ float sigmoidf_(float x) { return __builtin_amdgcn_rcpf(1.0f + __expf(-x)); }
__device__ __forceinline__ float gelu_tanh(float x) { const float k = 1.5957691216f * (x + 0.044715f * x * x * x); return x * __builtin_amdgcn_rcpf(1.0f + __expf(-k)); }
__device__ __forceinline__ float wave_sum(float v) {
#pragma unroll
    for (int o = 1; o < 64; o <<= 1) v += __shfl_xor(v, o);
    return v;
}
__device__ __forceinline__ int otid() { int t = threadIdx.x; asm volatile("" : "+v"(t)); return t; }
template <int CTRL> __device__ __forceinline__ float dpp_upd(float old, float src) {
    return __int_as_float(__builtin_amdgcn_update_dpp(__float_as_int(old), __float_as_int(src), CTRL, 0xf, 0xf, false));
}
template <int CTRL> __device__ __forceinline__ float dpp0(float src) { return __int_as_float(__builtin_amdgcn_update_dpp(0, __float_as_int(src), CTRL, 0xf, 0xf, true)); }
__device__ __forceinline__ void conv_taps(float& h, float cur, float prev, float w1, float w0, float w1m, float w0m) {
    asm("s_nop 1\n\t"
        "v_fmac_f32_dpp %0, %1, %3 row_shr:1 row_mask:0xf bank_mask:0xf bound_ctrl:1\n\t"
        "v_fmac_f32_dpp %0, %1, %4 row_shr:2 row_mask:0xf bank_mask:0xf bound_ctrl:1\n\t"
        "v_fmac_f32_dpp %0, %2, %5 row_ror:1 row_mask:0xf bank_mask:0xf\n\t"
        "v_fmac_f32_dpp %0, %2, %6 row_ror:2 row_mask:0xf bank_mask:0xf"
        : "+v"(h) : "v"(cur), "v"(prev), "v"(w1), "v"(w0), "v"(w1m), "v"(w0m));
}
__device__ __forceinline__ float prev1(float prev, float cur) { const float t = dpp_upd<0x121>(0.f, prev); return dpp_upd<0x111>(t, cur); }
__device__ __forceinline__ float prev2(float prev, float cur) { const float t = dpp_upd<0x122>(0.f, prev); return dpp_upd<0x112>(t, cur); }

namespace pg8 {
constexpr int BM = 256, BK = 64, HALF = 128, HTB = HALF * BK * 2, STAGE_BYTES = 8 * HTB, NXCD = 8, WGM = 8;
__host__ __device__ __forceinline__ int lds_byte(int r, int c) { const int st = (r >> 4) * 2 + (c >> 5), rr = r & 15, cc = c & 31, ob = rr * 64 + cc * 2; return st * 1024 + (ob ^ (((ob >> 9) & 1) << 5)); }
__host__ __device__ __forceinline__ void stage_rc(int b, int& R, int& C) { const int st = b / 1024, sb = b % 1024, swz = sb ^ (((sb >> 9) & 1) << 5); R = (st >> 1) * 16 + swz / 64; C = (st & 1) * 32 + (swz % 64) / 2; }
__host__ __device__ __forceinline__ int perm32(int rho) { const int n = rho >> 4, i = rho & 15; return 8 * (i >> 2) + 4 * n + (i & 3); }
struct Unit { int pm, pn; };
struct Gemm { const bf16_t* A; const bf16_t* Bt; int M, N, K, lda, ldb, a_shift, a_step; };
struct StaticOrder {
    int nM, nN, nwg, G, c;
    __device__ __forceinline__ void init(int M, int N, int G_, int c_) { nM = M / BM; nN = N / BM; nwg = nM * nN; G = G_; c = c_; }
    __device__ __forceinline__ bool next(int i, Unit& u) const {
        const long L = (long)i * G + c; if (L >= nwg) return false;
        int wgid = (int)L; { const int q = nwg / NXCD, r = nwg % NXCD, xcd = wgid % NXCD, off = wgid / NXCD; wgid = (xcd < r ? xcd * (q + 1) : r * (q + 1) + (xcd - r) * q) + off; }
        const int nig = WGM * nN, gid = wgid / nig, fm = gid * WGM, gsz = (nM - fm) < WGM ? (nM - fm) : WGM;
        u.pm = fm + ((wgid % nig) % gsz); u.pn = (wgid % nig) / gsz; return true;
    }
};
template <class Epi>
__device__ __forceinline__ void gemm_phase(LAS unsigned char* lds, const Gemm g, const StaticOrder& S, const Epi& E) {
    int tid_ = threadIdx.x; asm volatile("" : "+v"(tid_));
    const int tid = tid_, wid = __builtin_amdgcn_readfirstlane(tid >> 6), lane = tid & 63, wr = wid >> 2, wc = wid & 3, fr = lane & 15, fq = lane >> 4;
    const int K = g.K, nt = K / BK;
    unsigned voffA[2], voffB[2];
#pragma unroll
    for (int i = 0; i < 2; ++i) { int R, C; stage_rc(tid * 16 + i * 8192, R, C); const int Rb = Epi::PERM ? ((R & ~31) + perm32(R & 31)) : R;
        voffA[i] = (unsigned)(R * g.lda + C) * 2u; voffB[i] = (unsigned)(Rb * g.ldb + C) * 2u; }
    const size_t kstep = (size_t)(BK * 2);
    const size_t hstepA = (size_t)HALF * g.lda * 2, hstepB = (size_t)HALF * g.ldb * 2;
    const size_t tstepA = 2 * hstepA, tstepB = 2 * hstepB;
    const unsigned ldsw = (unsigned)wid * 1024u;
    const int aoff = lds_byte(wr * 64 + fr, fq * 8), boff = lds_byte(wc * 32 + fr, fq * 8);
#define PG8_SA(b, h) (((b) * 2 + (h)) * HTB)
#define PG8_SB(b, h) ((4 + (b) * 2 + (h)) * HTB)
#define PG8_STAGE(bufoff, gbase, voff) do { _Pragma("unroll") for (int _i = 0; _i < 2; ++_i) \
        __builtin_amdgcn_global_load_lds((const unsigned*)((const char*)(gbase) + (voff)[_i]), (LAS unsigned*)(lds + (bufoff) + ldsw + _i * 8192), 16, 0, 0); } while (0)
#define PG8_LDA(dst, b, h) do { _Pragma("unroll") for (int m = 0; m < 4; ++m) _Pragma("unroll") for (int k = 0; k < 2; ++k) dst[m][k] = *(const LAS bf16x8*)(lds + PG8_SA(b, h) + aoff + m * 2048 + k * 1024); } while (0)
#define PG8_LDB(dst, b, h) do { _Pragma("unroll") for (int n = 0; n < 2; ++n) _Pragma("unroll") for (int k = 0; k < 2; ++k) dst[n][k] = *(const LAS bf16x8*)(lds + PG8_SB(b, h) + boff + n * 2048 + k * 1024); } while (0)
#define PG8_MMA(ai, bj, At, Bt) do { __builtin_amdgcn_s_setprio(1); _Pragma("unroll") for (int m = 0; m < 4; ++m) _Pragma("unroll") for (int n = 0; n < 2; ++n) _Pragma("unroll") for (int k = 0; k < 2; ++k) \
        acc[ai][bj][m][n] = __builtin_amdgcn_mfma_f32_16x16x32_bf16(Bt[n][k], At[m][k], acc[ai][bj][m][n], 0, 0, 0); __builtin_amdgcn_s_setprio(0); } while (0)
#define PG8_WAIT_V(n) asm volatile("s_waitcnt vmcnt(" #n ")" ::: "memory")
#define PG8_WAIT_L(n) asm volatile("s_waitcnt lgkmcnt(" #n ")" ::: "memory")
#define PG8_BAR __builtin_amdgcn_s_barrier()
#define PG8_SCHED __builtin_amdgcn_sched_barrier(0)
    Unit cur, nxt; int ui = 0;
    if (!S.next(0, cur)) return;
    f32x4 acc[2][2][4][2];
#pragma unroll
    for (int a = 0; a < 2; ++a)
#pragma unroll
        for (int b = 0; b < 2; ++b)
#pragma unroll
            for (int m = 0; m < 4; ++m)
#pragma unroll
                for (int n = 0; n < 2; ++n) acc[a][b][m][n] = (f32x4){0.f, 0.f, 0.f, 0.f};
    bf16x8 At[4][2], B0[2][2], B1[2][2];
    const char* cA = (const char*)g.A + (size_t)cur.pm * tstepA + (size_t)(cur.pn >> g.a_shift) * g.a_step; const char* cB = (const char*)g.Bt + (size_t)cur.pn * tstepB;
    PG8_STAGE(PG8_SB(0, 0), cB, voffB); PG8_STAGE(PG8_SA(0, 0), cA, voffA); PG8_STAGE(PG8_SB(0, 1), cB + hstepB, voffB); PG8_STAGE(PG8_SA(0, 1), cA + hstepA, voffA);
    if (wr == 1) PG8_BAR;
    PG8_WAIT_V(4); PG8_BAR;
    PG8_STAGE(PG8_SB(1, 0), cB + kstep, voffB); PG8_STAGE(PG8_SA(1, 0), cA + kstep, voffA); PG8_STAGE(PG8_SB(1, 1), cB + hstepB + kstep, voffB);
    PG8_WAIT_V(6); PG8_BAR;
    for (;;) {
        const bool has_next = S.next(ui + 1, nxt);
        const char* nA = has_next ? (const char*)g.A + (size_t)nxt.pm * tstepA + (size_t)(nxt.pn >> g.a_shift) * g.a_step : cA; const char* nB = has_next ? (const char*)g.Bt + (size_t)nxt.pn * tstepB : cB;
        for (int t = 0; t < nt; t += 2) {
            const bool last = (t == nt - 2);
            const char* a1 = cA + (size_t)(t + 1) * kstep;
            const char* a2 = last ? nA : cA + (size_t)(t + 2) * kstep; const char* b2 = last ? nB : cB + (size_t)(t + 2) * kstep;
            const char* a3 = a2 + kstep; const char* b3 = b2 + kstep;
            PG8_LDB(B0, 0, 0); PG8_SCHED; PG8_LDA(At, 0, 0); PG8_STAGE(PG8_SA(1, 1), a1 + hstepA, voffA);
            PG8_WAIT_L(8); PG8_BAR; PG8_WAIT_L(0); PG8_MMA(0, 0, At, B0); PG8_BAR; PG8_SCHED;
            PG8_LDB(B1, 0, 1); PG8_STAGE(PG8_SB(0, 0), b2, voffB);
            PG8_BAR; PG8_WAIT_L(0); PG8_MMA(0, 1, At, B1); PG8_BAR;
            PG8_LDA(At, 0, 1); PG8_STAGE(PG8_SA(0, 0), a2, voffA);
            PG8_BAR; PG8_WAIT_L(0); PG8_MMA(1, 0, At, B0); PG8_BAR; PG8_SCHED;
            PG8_STAGE(PG8_SB(0, 1), b2 + hstepB, voffB);
            PG8_WAIT_V(6); PG8_BAR; PG8_MMA(1, 1, At, B1); PG8_BAR;
            PG8_LDB(B0, 1, 0); PG8_SCHED; PG8_LDA(At, 1, 0); PG8_STAGE(PG8_SA(0, 1), a2 + hstepA, voffA);
            PG8_WAIT_L(8); PG8_BAR; PG8_WAIT_L(0); PG8_MMA(0, 0, At, B0); PG8_BAR; PG8_SCHED;
            PG8_LDB(B1, 1, 1); PG8_STAGE(PG8_SB(1, 0), b3, voffB);
            PG8_BAR; PG8_WAIT_L(0); PG8_MMA(0, 1, At, B1); PG8_BAR;
            PG8_LDA(At, 1, 1); PG8_STAGE(PG8_SA(1, 0), a3, voffA);
            PG8_BAR; PG8_WAIT_L(0); PG8_MMA(1, 0, At, B0); PG8_BAR; PG8_SCHED;
            PG8_STAGE(PG8_SB(1, 1), b3 + hstepB, voffB);
            PG8_WAIT_V(6); PG8_BAR; PG8_MMA(1, 1, At, B1); PG8_BAR;
        }
        E(acc, cur, wr, wc, fr, fq);
        if (!has_next) break;
#pragma unroll
        for (int a = 0; a < 2; ++a)
#pragma unroll
            for (int b = 0; b < 2; ++b)
#pragma unroll
                for (int m = 0; m < 4; ++m)
#pragma unroll
                    for (int n = 0; n < 2; ++n) acc[a][b][m][n] = (f32x4){0.f, 0.f, 0.f, 0.f};
        cur = nxt; cA = nA; cB = nB; ++ui;
    }
    PG8_WAIT_V(0);
    if (wr == 0) PG8_BAR;
    PG8_BAR;
#undef PG8_SA
#undef PG8_SB
#undef PG8_STAGE
#undef PG8_LDA
#undef PG8_LDB
#undef PG8_MMA
#undef PG8_WAIT_V
#undef PG8_WAIT_L
#undef PG8_BAR
#undef PG8_SCHED
}
}
using pg8::Unit;
typedef const f32x4 (&AccRef)[2][2][4][2];

struct EpiRes {
    static constexpr bool PERM = false;
    const float* base; float* out; const float* scale; const float* bias;
    __device__ __forceinline__ void operator()(AccRef acc, const Unit& u, int wr, int wc, int fr, int fq) const {
        const int row0 = u.pm * 256 + wr * 64 + fr, col0 = u.pn * 256 + wc * 32 + 4 * fq;
        f32x4 sv[2][2], bv[2][2];
#pragma unroll
        for (int bj = 0; bj < 2; ++bj)
#pragma unroll
            for (int n = 0; n < 2; ++n) {
                sv[bj][n] = scale ? *(const f32x4*)(scale + col0 + bj * 128 + n * 16) : (f32x4){1.f, 1.f, 1.f, 1.f};
                bv[bj][n] = bias ? *(const f32x4*)(bias + col0 + bj * 128 + n * 16) : (f32x4){0.f, 0.f, 0.f, 0.f}; }
#pragma unroll
        for (int ai = 0; ai < 2; ++ai)
#pragma unroll
            for (int mh = 0; mh < 2; ++mh) {
                f32x4 bs[2][2][2];
#pragma unroll
                for (int m = 0; m < 2; ++m)
#pragma unroll
                    for (int bj = 0; bj < 2; ++bj)
#pragma unroll
                        for (int n = 0; n < 2; ++n) bs[m][bj][n] = *(const f32x4*)(base + (size_t)(row0 + ai * 128 + (2 * mh + m) * 16) * D + col0 + bj * 128 + n * 16);
#pragma unroll
                for (int m = 0; m < 2; ++m)
#pragma unroll
                    for (int bj = 0; bj < 2; ++bj)
#pragma unroll
                        for (int n = 0; n < 2; ++n) *(f32x4*)(out + (size_t)(row0 + ai * 128 + (2 * mh + m) * 16) * D + col0 + bj * 128 + n * 16) = bs[m][bj][n] + sv[bj][n] * (acc[ai][bj][2 * mh + m][n] + bv[bj][n]);
                asm volatile("" ::: "memory"); }
    }
};
struct EpiGateRes {
    static constexpr bool PERM = true;
    float* x; const float* bias;
    __device__ __forceinline__ void operator()(AccRef acc, const Unit& u, int wr, int wc, int fr, int fq) const {
        const int row0 = u.pm * 256 + wr * 64 + fr, col0 = u.pn * 128 + wc * 32 + 8 * fq;
        f32x4 bv[2], bg[2];
#pragma unroll
        for (int n = 0; n < 2; ++n) { bv[n] = *(const f32x4*)(bias + col0 + 4 * n); bg[n] = *(const f32x4*)(bias + D + col0 + 4 * n); }
#pragma unroll
        for (int ai = 0; ai < 2; ++ai) {
            f32x4 xs[4][2];
#pragma unroll
            for (int m = 0; m < 4; ++m)
#pragma unroll
                for (int n = 0; n < 2; ++n) xs[m][n] = *(const f32x4*)(x + (size_t)(row0 + ai * 128 + m * 16) * D + col0 + 4 * n);
#pragma unroll
            for (int m = 0; m < 4; ++m)
#pragma unroll
                for (int n = 0; n < 2; ++n) { f32x4 xv = xs[m][n]; const f32x4 v = acc[ai][0][m][n] + bv[n], gt = acc[ai][1][m][n] + bg[n];
#pragma unroll
                    for (int j = 0; j < 4; ++j) xv[j] += v[j] * sigmoidf_(gt[j]);
                    *(f32x4*)(x + (size_t)(row0 + ai * 128 + m * 16) * D + col0 + 4 * n) = xv; }
            asm volatile("" ::: "memory"); }
    }
};
struct EpiLruIn {
    static constexpr bool PERM = true;
    bf16_t* GG; bf16_t* RP;
    __device__ __forceinline__ void operator()(AccRef acc, const Unit& u, int wr, int wc, int fr, int fq) const {
        const int row0 = u.pm * 256 + wr * 64 + fr; const bool isg = u.pn < 4;
        bf16_t* dst = isg ? GG : RP; const int col0 = (u.pn & 3) * 256 + wc * 32 + 8 * fq;
#pragma unroll
        for (int ai = 0; ai < 2; ++ai)
#pragma unroll
            for (int m = 0; m < 4; ++m) { bf16_t* rp = dst + (size_t)(row0 + ai * 128 + m * 16) * D + col0;
#pragma unroll
                for (int bj = 0; bj < 2; ++bj) { f32x4 v0 = acc[ai][bj][m][0], v1 = acc[ai][bj][m][1];
                    if (isg) {
#pragma unroll
                        for (int j = 0; j < 4; ++j) { v0[j] = gelu_tanh(v0[j]); v1[j] = gelu_tanh(v1[j]); } }
                    u32x4 w; w.x = cvt_pk_bf16(v0[0], v0[1]); w.y = cvt_pk_bf16(v0[2], v0[3]); w.z = cvt_pk_bf16(v1[0], v1[1]); w.w = cvt_pk_bf16(v1[2], v1[3]);
                    *(u32x4*)(rp + bj * 128) = w; } }
    }
};
struct EpiGates {
    static constexpr bool PERM = true;
    const bf16_t* REC; bf16_t* LA; bf16_t* BV; const float* b_a; const float* b_x; const float* lam;
    __device__ __forceinline__ void operator()(AccRef acc, const Unit& u, int wr, int wc, int fr, int fq) const {
        const int row0 = u.pm * 256 + wr * 64 + fr, col0 = u.pn * 128 + wc * 32 + 8 * fq;
        u32x4 rws[2][4];
#pragma unroll
        for (int ai = 0; ai < 2; ++ai)
#pragma unroll
            for (int m = 0; m < 4; ++m) rws[ai][m] = *(const u32x4*)(REC + (size_t)(row0 + ai * 128 + m * 16) * D + col0);
#pragma unroll
        for (int n = 0; n < 2; ++n) {
            const f32x4 ba = *(const f32x4*)(b_a + col0 + 4 * n), bx = *(const f32x4*)(b_x + col0 + 4 * n), l = *(const f32x4*)(lam + col0 + 4 * n);
            f32x4 k8;
#pragma unroll
            for (int j = 0; j < 4; ++j) k8[j] = -8.0f * __logf(1.0f + __expf(-l[j]));
#pragma unroll
            for (int ai = 0; ai < 2; ++ai)
#pragma unroll
                for (int m = 0; m < 4; ++m) { const size_t off = (size_t)(row0 + ai * 128 + m * 16) * D + col0 + 4 * n;
                    float lo[4], bo[4];
#pragma unroll
                    for (int j = 0; j < 4; ++j) { const unsigned w = rws[ai][m][2 * n + (j >> 1)]; const float rec = (j & 1) ? bfhi(w) : bflo(w);
                        const float r = sigmoidf_(acc[ai][0][m][n][j] + ba[j]), ig = sigmoidf_(acc[ai][1][m][n][j] + bx[j]);
                        const float la = k8[j] * r; const float mult = __builtin_sqrtf(1.0f - __expf(2.0f * la));
                        lo[j] = la; bo[j] = mult * ig * rec; }
                    *(u32x2*)(LA + off) = (u32x2){cvt_pk_bf16(lo[0], lo[1]), cvt_pk_bf16(lo[2], lo[3])}; *(u32x2*)(BV + off) = (u32x2){cvt_pk_bf16(bo[0], bo[1]), cvt_pk_bf16(bo[2], bo[3])}; }
        }
    }
};
struct EpiQKV {
    static constexpr bool PERM = true;
    bf16_t* QKV; const float* qg; const float* kg;
    __device__ __forceinline__ void operator()(AccRef acc, const Unit& u, int wr, int wc, int fr, int fq) const {
        const int which = u.pn >> 2, row0 = u.pm * 256 + wr * 64 + fr, col0 = (u.pn & 3) * 256 + wc * 64 + 8 * fq;
        bf16_t* dst = QKV + (size_t)which * ((size_t)T * D);
        f32x4 gv[2][2];
#pragma unroll
        for (int bj = 0; bj < 2; ++bj)
#pragma unroll
            for (int n = 0; n < 2; ++n) { const f32x4 a = *(const f32x4*)(qg + 32 * bj + 8 * fq + 4 * n), b = *(const f32x4*)(kg + 32 * bj + 8 * fq + 4 * n);
                gv[bj][n] = which == 0 ? a : (which == 1 ? b : (f32x4){1.f, 1.f, 1.f, 1.f}); }
#pragma unroll
        for (int ai = 0; ai < 2; ++ai)
#pragma unroll
            for (int m = 0; m < 4; ++m) {
                float sc = 1.0f;
                if (which < 2) { float ss = 0.f;
#pragma unroll
                    for (int bj = 0; bj < 2; ++bj)
#pragma unroll
                        for (int n = 0; n < 2; ++n) { const f32x4 v = acc[ai][bj][m][n]; ss += (v[0] * v[0] + v[1] * v[1]) + (v[2] * v[2] + v[3] * v[3]); }
                    ss += __shfl_xor(ss, 16); ss += __shfl_xor(ss, 32);
                    sc = rsqrtf(ss * (1.0f / 64.0f) + 1e-6f) * (which == 0 ? 0.125f : 1.0f); }
                bf16_t* rp = dst + (size_t)(row0 + ai * 128 + m * 16) * D + col0;
#pragma unroll
                for (int bj = 0; bj < 2; ++bj) { const f32x4 v0 = acc[ai][bj][m][0] * gv[bj][0] * sc, v1 = acc[ai][bj][m][1] * gv[bj][1] * sc;
                    u32x4 w; w.x = cvt_pk_bf16(v0[0], v0[1]); w.y = cvt_pk_bf16(v0[2], v0[3]); w.z = cvt_pk_bf16(v1[0], v1[1]); w.w = cvt_pk_bf16(v1[2], v1[3]);
                    *(u32x4*)(rp + bj * 32) = w; } }
    }
};
struct EpiFfn1 {
    static constexpr bool PERM = true;
    bf16_t* Aout; const float* cw; const float* cb; float* raw; LAS float* xch;
    __device__ __forceinline__ void operator()(AccRef acc, const Unit& u, int wr, int wc, int fr, int fq) const {
        const int clb = 32 * wc + 8 * fq;
        f32x4 cwv[2][8];
        { const float* cv = cw + 128 * u.pn + clb; const float* cg = cv + FH; const float* bp = cb + 128 * u.pn + clb;
          cwv[0][0] = *(const f32x4*)(cv); cwv[0][1] = *(const f32x4*)(cv + F2); cwv[0][2] = *(const f32x4*)(cv + 2 * F2); cwv[0][3] = *(const f32x4*)(bp);
          cwv[0][4] = *(const f32x4*)(cg); cwv[0][5] = *(const f32x4*)(cg + F2); cwv[0][6] = *(const f32x4*)(cg + 2 * F2); cwv[0][7] = *(const f32x4*)(bp + FH); }
        if (fr >= 14) {
#pragma unroll
            for (int ai = 0; ai < 2; ++ai)
#pragma unroll
                for (int bj = 0; bj < 2; ++bj)
#pragma unroll
                    for (int n = 0; n < 2; ++n) *(LAS f32x4*)(xch + ((ai * 2 + wr) * 2 + (fr - 14)) * 256 + bj * 128 + clb + 4 * n) = acc[ai][bj][3][n];
        }
        float* rawu = raw + (size_t)(u.pm * 22 + u.pn) * 1024;
        if (wr == 0 && fr < 2) {
#pragma unroll
            for (int bj = 0; bj < 2; ++bj)
#pragma unroll
                for (int n = 0; n < 2; ++n) *(f32x4*)(rawu + fr * 256 + bj * 128 + clb + 4 * n) = acc[0][bj][0][n];
        }
        if (wr == 1 && fr >= 14) {
#pragma unroll
            for (int bj = 0; bj < 2; ++bj)
#pragma unroll
                for (int n = 0; n < 2; ++n) *(f32x4*)(rawu + (fr - 12) * 256 + bj * 128 + clb + 4 * n) = acc[1][bj][3][n];
        }
        asm volatile("s_waitcnt lgkmcnt(0)" ::: "memory"); __builtin_amdgcn_s_barrier(); __builtin_amdgcn_s_barrier(); asm volatile("" ::: "memory");
        const int hc0 = 128 * u.pn + clb, row0 = u.pm * 256 + wr * 64 + fr;
        const float m1 = fr == 0 ? 1.f : 0.f, m2 = fr < 2 ? 1.f : 0.f;
#pragma unroll
        for (int n = 0; n < 2; ++n) {
            const f32x4 w0v = cwv[n][0], w1v = cwv[n][1], w2v = cwv[n][2], bvv = cwv[n][3], w0g = cwv[n][4], w1g = cwv[n][5], w2g = cwv[n][6], bvg = cwv[n][7];
            const f32x4 w0vm = w0v * m2, w1vm = w1v * m1, w0gm = w0g * m2, w1gm = w1g * m1;
#pragma unroll
            for (int ai = 0; ai < 2; ++ai) {
                if (n == 0 && ai == 1) {
                    asm volatile("" ::: "memory");
                    const float* cv = cw + hc0 + 4; const float* cg = cv + FH; const float* bp = cb + hc0 + 4;
                    cwv[1][0] = *(const f32x4*)(cv); cwv[1][1] = *(const f32x4*)(cv + F2); cwv[1][2] = *(const f32x4*)(cv + 2 * F2); cwv[1][3] = *(const f32x4*)(bp);
                    cwv[1][4] = *(const f32x4*)(cg); cwv[1][5] = *(const f32x4*)(cg + F2); cwv[1][6] = *(const f32x4*)(cg + 2 * F2); cwv[1][7] = *(const f32x4*)(bp + FH);
                    asm volatile("" ::: "memory"); }
                f32x4 hv = (f32x4){0.f, 0.f, 0.f, 0.f}, hg = hv;
                const int pb = ai * 2 + wr - 1;
                if (pb >= 0 && fr >= 14) { hv = *(const LAS f32x4*)(xch + (pb * 2 + (fr - 14)) * 256 + clb + 4 * n); hg = *(const LAS f32x4*)(xch + (pb * 2 + (fr - 14)) * 256 + 128 + clb + 4 * n); }
#pragma unroll
                for (int m = 0; m < 4; ++m) {
                    const f32x4 pv = m ? acc[ai][0][m ? m - 1 : 0][n] : hv, pg = m ? acc[ai][1][m ? m - 1 : 0][n] : hg;
                    const f32x4 cvv = acc[ai][0][m][n], cgg = acc[ai][1][m][n];
                    float o[4];
#pragma unroll
                    for (int j = 0; j < 4; ++j) {
                        float hval = bvv[j] + w2v[j] * cvv[j];
                        conv_taps(hval, cvv[j], pv[j], w1v[j], w0v[j], w1vm[j], w0vm[j]);
                        float hgat = bvg[j] + w2g[j] * cgg[j];
                        conv_taps(hgat, cgg[j], pg[j], w1g[j], w0g[j], w1gm[j], w0gm[j]);
                        o[j] = hgat * sigmoidf_(hgat) * hval; }
                    u32x2 w; w.x = cvt_pk_bf16(o[0], o[1]); w.y = cvt_pk_bf16(o[2], o[3]);
                    *(u32x2*)(Aout + (size_t)(row0 + ai * 128 + m * 16) * FH + hc0 + 4 * n) = w; } } }
    }
};

#define XB_TMO      128
#define XB_XCNT(j)  (256  + 64 * (j))
#define XB_XSUB(j)  (1280 + 64 * (j))
#define XB_XGEN(j)  (2304 + 64 * (j))
#define XB_TOP      3328
#define XB_TOPGEN   3392
#define XCD_BAR_WORDS 3456
#define XB_SPIN_CAP (1u << 24)
__device__ __forceinline__ unsigned xb_ld(unsigned* p)              { return __hip_atomic_load(p, __ATOMIC_RELAXED, __HIP_MEMORY_SCOPE_AGENT); }
__device__ __forceinline__ unsigned xb_add(unsigned* p, unsigned v) { return __hip_atomic_fetch_add(p, v, __ATOMIC_RELAXED, __HIP_MEMORY_SCOPE_AGENT); }
__device__ __forceinline__ unsigned xb_xcc_id() { return (unsigned)__builtin_amdgcn_s_getreg((3 << 11) | 20) & 0xFu; }
#define XB_SPIN(cond, bar) do { unsigned _sp = 0; while (cond) { __builtin_amdgcn_s_sleep(1); \
    if ((++_sp & 255u) == 0u) { if (xb_ld(&(bar)[XB_TMO])) break; if (_sp > XB_SPIN_CAP) { atomicAdd(&(bar)[XB_TMO], 1u); break; } } } } while (0)
struct XcdBarrier { unsigned* bar; unsigned x; volatile LAS unsigned* st; };
__device__ __forceinline__ XcdBarrier xcd_barrier_post(unsigned* bar, volatile LAS unsigned* st) {
    XcdBarrier b; b.bar = bar; b.x = xb_xcc_id(); b.st = st;
    if (threadIdx.x == 0) (void)xb_add(&bar[XB_XCNT(b.x)], 1u);
    return b;
}
__device__ __forceinline__ void xcd_barrier_complete(unsigned* bar, unsigned x, unsigned& nloc, unsigned& nx) {
    const unsigned G = gridDim.x * gridDim.y * gridDim.z;
    unsigned sum, cnt, mine, sp = 0u;
    for (;;) {
        sum = 0u; cnt = 0u; mine = 0u;
#pragma unroll
        for (unsigned j = 0; j < 16; ++j) { const unsigned c = xb_ld(&bar[XB_XCNT(j)]); sum += c; cnt += (c > 0u) ? 1u : 0u; mine = (j == x) ? c : mine; }
        if (sum == G) break;
        __builtin_amdgcn_s_sleep(1);
        if ((++sp & 255u) == 0u) { if (xb_ld(&bar[XB_TMO])) break; if (sp > XB_SPIN_CAP) { atomicAdd(&bar[XB_TMO], 1u); break; } }
    }
    nloc = mine > 0u ? mine : 1u; nx = cnt > 0u ? cnt : 1u;
}
__device__ __forceinline__ void xcd_barrier(const XcdBarrier& b) {
    asm volatile("s_waitcnt vmcnt(0) lgkmcnt(0)" ::: "memory");
    __syncthreads();
    if (threadIdx.x == 0) {
        unsigned* bar = b.bar;
        __builtin_amdgcn_s_waitcnt(0);
        unsigned nloc = b.st[0], nx = b.st[1];
        if (nloc == 0u) { xcd_barrier_complete(bar, b.x, nloc, nx); b.st[0] = nloc; b.st[1] = nx; }
        const unsigned old = xb_add(&bar[XB_XSUB(b.x)], 1u);
        const unsigned gen = old / nloc;
        if (old + 1u == (gen + 1u) * nloc) {
            __builtin_amdgcn_fence(__ATOMIC_RELEASE, "agent");
            asm volatile("s_waitcnt vmcnt(0)" ::: "memory");
            const unsigned og = xb_add(&bar[XB_TOP], 1u);
            const unsigned tg = og / nx;
            if (og + 1u == (tg + 1u) * nx) xb_add(&bar[XB_TOPGEN], 1u);
            else XB_SPIN(xb_ld(&bar[XB_TOPGEN]) == tg, bar);
            __builtin_amdgcn_fence(__ATOMIC_ACQUIRE, "agent");
            xb_add(&bar[XB_XGEN(b.x)], 1u);
            asm volatile("s_waitcnt vmcnt(0)" ::: "memory");
        } else {
            XB_SPIN(xb_ld(&bar[XB_XGEN(b.x)]) == gen, bar);
            __builtin_amdgcn_fence(__ATOMIC_ACQUIRE, "agent");
            asm volatile("s_waitcnt vmcnt(0)" ::: "memory");
        }
    }
    __syncthreads();
}

struct Job { const float* src; bf16_t* dst; int K, ld, nrows, map, hh, item0; };
constexpr int NJOBS = 33;
struct Params {
    const float* in[33]; float* out; unsigned char* ws;
    Job jobs[NJOBS]; int nitems; int pad;
};

__device__ __forceinline__ int map_col(int map, int hh, int j) {
    if (map == 0) return j;
    if (map == 1) { const int pn = j >> 8, bj = (j >> 7) & 1, i = j & 127; return bj * hh + 128 * pn + i; }
    const int pn = j >> 8, cl = j & 255, bj = cl >> 7, h4 = (cl & 127) >> 5, i = cl & 31; return 256 * pn + 64 * h4 + 32 * bj + i;
}

__device__ __forceinline__ void weights_phase(const Params& P, LAS unsigned char* lds) {
    const int tid__ = otid(); const int lane = tid__ & 63, wave = tid__ >> 6;
    LAS float* scr = (LAS float*)(lds + wave * 8448);
    const int gw = blockIdx.x * 8 + wave, ngw = gridDim.x * 8;
    for (int it = gw; it < P.nitems; it += ngw) {
        int ji = 0;
#pragma unroll 1
        for (int q = 1; q < NJOBS; ++q) if (it >= P.jobs[q].item0) ji = q;
        const Job jb = P.jobs[ji];
        const int r = it - jb.item0, nblk = jb.nrows / 32, kb = r / nblk, nb = r % nblk, k0 = 64 * kb, n0 = 32 * nb, c0 = map_col(jb.map, jb.hh, n0);
#pragma unroll 8
        for (int i = 0; i < 32; ++i) { const int kk = 2 * i + (lane >> 5); scr[kk * 33 + (lane & 31)] = jb.src[(size_t)(k0 + kk) * jb.ld + c0 + (lane & 31)]; }
        asm volatile("s_waitcnt lgkmcnt(0)" ::: "memory");
        const int c = lane & 7;
#pragma unroll
        for (int j = 0; j < 4; ++j) { const int n = (lane >> 3) + 8 * j; const LAS float* s = scr + (8 * c) * 33 + n;
            u32x4 o; o.x = cvt_pk_bf16(s[0 * 33], s[1 * 33]); o.y = cvt_pk_bf16(s[2 * 33], s[3 * 33]); o.z = cvt_pk_bf16(s[4 * 33], s[5 * 33]); o.w = cvt_pk_bf16(s[6 * 33], s[7 * 33]);
            *(u32x4*)(jb.dst + (size_t)(n0 + n) * jb.K + k0 + 8 * c) = o; }
        asm volatile("s_waitcnt lgkmcnt(0)" ::: "memory");
    }
}
__device__ __forceinline__ void rmsnorm_phase(const float* x, const float* g, bf16_t* hn) {
    const int tid__ = otid(); const int lane = tid__ & 63, wave = tid__ >> 6;
    const int gw = blockIdx.x * 8 + wave, ngw = gridDim.x * 8;
    f32x4 gv[4];
#pragma unroll
    for (int j = 0; j < 4; ++j) gv[j] = *((const f32x4*)g + lane + 64 * j);
    f32x4 v[4];
    if (gw < T) {
#pragma unroll
        for (int j = 0; j < 4; ++j) v[j] = ((const f32x4*)(x + (size_t)gw * D) + lane)[64 * j]; }
    for (int m = gw; m < T; m += ngw) {
        f32x4 vn[4];
        const int mn = (m + ngw < T) ? m + ngw : m;
#pragma unroll
        for (int j = 0; j < 4; ++j) vn[j] = ((const f32x4*)(x + (size_t)mn * D) + lane)[64 * j];
        float s = 0.f;
#pragma unroll
        for (int j = 0; j < 4; ++j) s += (v[j][0] * v[j][0] + v[j][1] * v[j][1]) + (v[j][2] * v[j][2] + v[j][3] * v[j][3]);
        const float rstd = rsqrtf(wave_sum(s) * (1.0f / D) + 1e-6f);
        u32x2* o = (u32x2*)(hn + (size_t)m * D) + lane;
#pragma unroll
        for (int j = 0; j < 4; ++j) { const f32x4 y = v[j] * rstd * gv[j]; u32x2 w; w.x = cvt_pk_bf16(y[0], y[1]); w.y = cvt_pk_bf16(y[2], y[3]); o[64 * j] = w; }
#pragma unroll
        for (int j = 0; j < 4; ++j) v[j] = vn[j];
    }
}
__device__ __forceinline__ void ld8(const bf16_t* p, float (&v)[8]) {
    const u32x4 w = *(const u32x4*)p;
#pragma unroll
    for (int i = 0; i < 4; ++i) { v[2 * i] = bflo(w[i]); v[2 * i + 1] = bfhi(w[i]); }
}
__device__ __forceinline__ void st8(bf16_t* p, const float (&v)[8]) {
    u32x4 w; w.x = cvt_pk_bf16(v[0], v[1]); w.y = cvt_pk_bf16(v[2], v[3]); w.z = cvt_pk_bf16(v[4], v[5]); w.w = cvt_pk_bf16(v[6], v[7]);
    *(u32x4*)p = w;
}
__device__ __forceinline__ void pool_phase(const bf16_t* hn, bf16_t* dd) {
    for (int gid = blockIdx.x * NTHREADS + otid(); gid < (T / 32) * 128; gid += gridDim.x * NTHREADS) {
        const int col8 = gid & 127, chunk = gid >> 7, w = 2 << (col8 >> 5), t0 = chunk * 32, pos0 = t0 & (SEQ - 1);
        const bf16_t* hp = hn + (size_t)t0 * D + col8 * 8; bf16_t* dp = dd + (size_t)t0 * D + col8 * 8;
        float s[8];
#pragma unroll
        for (int i = 0; i < 8; ++i) s[i] = 0.f;
        if (pos0) for (int k = 1; k <= w; ++k) { float v[8]; ld8(hp - (size_t)k * D, v);
#pragma unroll
            for (int i = 0; i < 8; ++i) s[i] += v[i]; }
        for (int i = 0; i < 32; ++i) {
            float cur[8]; ld8(hp + (size_t)i * D, cur); const int pos = pos0 + i;
#pragma unroll
            for (int q = 0; q < 8; ++q) s[q] += cur[q];
            if (pos >= w) { float v[8]; ld8(hp + (size_t)(i - w) * D, v);
#pragma unroll
                for (int q = 0; q < 8; ++q) s[q] -= v[q]; }
            const float inv = 1.0f / (float)(pos + 1 < w ? pos + 1 : w);
            float o[8];
#pragma unroll
            for (int q = 0; q < 8; ++q) o[q] = s[q] * inv - cur[q];
            st8(dp + (size_t)i * D, o);
        }
    }
}
__device__ __forceinline__ void lruconv_phase(const bf16_t* pre, const float* cw, const float* cb, bf16_t* rec) {
    for (int gid = blockIdx.x * NTHREADS + otid(); gid < (T / 32) * 128; gid += gridDim.x * NTHREADS) {
        const int col8 = gid & 127, chunk = gid >> 7, t0 = chunk * 32, pos0 = t0 & (SEQ - 1);
        const bf16_t* hp = pre + (size_t)t0 * D + col8 * 8; bf16_t* dp = rec + (size_t)t0 * D + col8 * 8;
        float w0[8], w1[8], w2[8], w3[8], bb[8], p3[8], p2[8], p1[8];
#pragma unroll
        for (int i = 0; i < 8; ++i) { w0[i] = cw[col8 * 8 + i]; w1[i] = cw[D + col8 * 8 + i]; w2[i] = cw[2 * D + col8 * 8 + i]; w3[i] = cw[3 * D + col8 * 8 + i]; bb[i] = cb[col8 * 8 + i]; p3[i] = 0.f; p2[i] = 0.f; p1[i] = 0.f; }
        if (pos0) { ld8(hp - 3 * (size_t)D, p3); ld8(hp - 2 * (size_t)D, p2); ld8(hp - (size_t)D, p1); }
        for (int i = 0; i < 32; ++i) {
            float cur[8], o[8]; ld8(hp + (size_t)i * D, cur);
#pragma unroll
            for (int q = 0; q < 8; ++q) { o[q] = bb[q] + w0[q] * p3[q] + w1[q] * p2[q] + w2[q] * p1[q] + w3[q] * cur[q]; p3[q] = p2[q]; p2[q] = p1[q]; p1[q] = cur[q]; }
            st8(dp + (size_t)i * D, o);
        }
    }
}
__device__ __forceinline__ void lruscan_phase(const bf16_t* LA, const bf16_t* BV, bf16_t* GG, LAS unsigned char* lds) {
    LAS float* sA = (LAS float*)lds; LAS float* sB = sA + 64 * 64;
    const int tid__ = otid(); const int c8 = tid__ & 7, tc = tid__ >> 3;
    for (int unit = blockIdx.x; unit < 256; unit += gridDim.x) {
        const int b = unit >> 4, cgp = unit & 15;
        const size_t base = ((size_t)b * SEQ + tc * 32) * D + cgp * 64 + c8 * 8;
        float sl[8], Bv[8], h[8];
#pragma unroll
        for (int q = 0; q < 8; ++q) { sl[q] = 0.f; Bv[q] = 0.f; h[q] = 0.f; }
#pragma unroll 4
        for (int i = 0; i < 32; ++i) { float la[8], bb[8]; ld8(LA + base + (size_t)i * D, la); ld8(BV + base + (size_t)i * D, bb);
#pragma unroll
            for (int q = 0; q < 8; ++q) { Bv[q] = __expf(la[q]) * Bv[q] + bb[q]; sl[q] += la[q]; } }
#pragma unroll
        for (int q = 0; q < 8; ++q) { sA[tc * 64 + c8 * 8 + q] = __expf(sl[q]); sB[tc * 64 + c8 * 8 + q] = Bv[q]; }
        __syncthreads();
        for (int j = 0; j < tc; ++j) {
            const f32x4 a0 = *(const LAS f32x4*)(sA + j * 64 + c8 * 8), a1 = *(const LAS f32x4*)(sA + j * 64 + c8 * 8 + 4), b0 = *(const LAS f32x4*)(sB + j * 64 + c8 * 8), b1 = *(const LAS f32x4*)(sB + j * 64 + c8 * 8 + 4);
#pragma unroll
            for (int q = 0; q < 4; ++q) { h[q] = a0[q] * h[q] + b0[q]; h[4 + q] = a1[q] * h[4 + q] + b1[q]; } }
#pragma unroll 4
        for (int i = 0; i < 32; ++i) { float la[8], bb[8], gg[8], y[8]; ld8(LA + base + (size_t)i * D, la); ld8(BV + base + (size_t)i * D, bb); ld8(GG + base + (size_t)i * D, gg);
#pragma unroll
            for (int q = 0; q < 8; ++q) { h[q] = __expf(la[q]) * h[q] + bb[q]; y[q] = gg[q] * h[q]; }
            st8(GG + base + (size_t)i * D, y); }
        __syncthreads();
    }
}
__device__ __forceinline__ void ffn_fix_panel(const float* raw, const float* cw, const float* cb, bf16_t* Aout, int pm) {
    if ((pm & 7) == 0) return;
    for (int idx = otid(); idx < 2 * FH; idx += NTHREADS) {
        const int hc = idx % FH, rr = idx / FH;
        const int pn = hc >> 7, cl = hc & 127;
        const float* cur = raw + (size_t)(pm * 22 + pn) * 1024; const float* prv = raw + (size_t)((pm - 1) * 22 + pn) * 1024;
        float hh[2];
#pragma unroll
        for (int part = 0; part < 2; ++part) { const int off = part * 128 + cl, col = part * FH + hc;
            const float x0 = cur[rr * 256 + off], x1 = rr ? cur[off] : prv[3 * 256 + off], x2 = rr ? prv[3 * 256 + off] : prv[2 * 256 + off];
            hh[part] = cb[col] + cw[2 * F2 + col] * x0 + cw[F2 + col] * x1 + cw[col] * x2; }
        const float o = hh[1] * sigmoidf_(hh[1]) * hh[0];
        Aout[(size_t)(pm * 256 + rr) * FH + hc] = (bf16_t)(cvt_pk_bf16(o, 0.f) & 0xffffu);
    }
}
__device__ __forceinline__ void vt_phase(const bf16_t* V, bf16_t* VT, LAS unsigned char* lds) {
    const int tid__ = otid(); const int lane = tid__ & 63, wave = tid__ >> 6;
    LAS bf16_t* scr = (LAS bf16_t*)(lds + wave * 8704);
    const int gw = blockIdx.x * 8 + wave, ngw = gridDim.x * 8;
    for (int it = gw; it < 16 * 16 * 32; it += ngw) {
        const int st = it & 31, h = (it >> 5) & 15, b = it >> 9, s0 = st * 64;
#pragma unroll
        for (int j = 0; j < 8; ++j) { const int i = (lane >> 3) + 8 * j, c = lane & 7;
            const u32x4 w = *(const u32x4*)(V + (size_t)(b * SEQ + s0 + i) * D + h * 64 + 8 * c);
            *(LAS u32x2*)(scr + i * 68 + 8 * c) = (u32x2){w.x, w.y}; *(LAS u32x2*)(scr + i * 68 + 8 * c + 4) = (u32x2){w.z, w.w}; }
        asm volatile("s_waitcnt lgkmcnt(0)" ::: "memory");
#pragma unroll
        for (int j = 0; j < 8; ++j) { const int d = (lane >> 3) + 8 * j, c = lane & 7;
            unsigned short e[8];
#pragma unroll
            for (int k = 0; k < 8; ++k) e[k] = scr[(8 * c + k) * 68 + d];
            u32x4 w; w.x = e[0] | ((unsigned)e[1] << 16); w.y = e[2] | ((unsigned)e[3] << 16); w.z = e[4] | ((unsigned)e[5] << 16); w.w = e[6] | ((unsigned)e[7] << 16);
            *(u32x4*)(VT + ((size_t)(b * 16 + h) * 64 + d) * SEQ + s0 + 8 * c) = w; }
        asm volatile("s_waitcnt lgkmcnt(0)" ::: "memory");
    }
}

__device__ __forceinline__ void s5_phase(const Params& P, const bf16_t* hn, bf16_t* ys, LAS unsigned char* lds) {
    const int tid__ = otid(); const int lane = tid__ & 63, wave = tid__ >> 6;
    if (wave >= 4) return;
    LAS unsigned* S = (LAS unsigned*)(lds + wave * 8704);
    const float* lam_re = P.in[6]; const float* lam_im = P.in[7]; const float* log_dt = P.in[8]; const float* b_re = P.in[9]; const float* b_im = P.in[10];
    const float* c_re = P.in[11]; const float* c_im = P.in[12]; const float* dsk = P.in[13];
    const int c32 = lane & 31, hf = lane >> 5, c16 = lane & 15, q4 = lane >> 4;
    for (int unit = blockIdx.x * 4 + wave; unit < 1024; unit += gridDim.x * 4) {
        const int b = unit >> 6, g = unit & 63;
        const float dt = expf(log_dt[g]);
        float ar, ai;
        { const float lr = fminf(lam_re[g * 64 + lane], -1e-4f), li = lam_im[g * 64 + lane]; const float er = expf(lr * dt); ar = er * cosf(li * dt); ai = er * sinf(li * dt); }
        bf16x8 Bre[2], Bim[2];
#pragma unroll
        for (int pb = 0; pb < 2; ++pb) {
            const int pp = pb * 32 + c32;
            const float lr = fminf(lam_re[g * 64 + pp], -1e-4f), li = lam_im[g * 64 + pp]; const float er = expf(lr * dt);
            const float nr = er * cosf(li * dt) - 1.0f, ni = er * sinf(li * dt), dd = lr * lr + li * li;
            const float cr = (nr * lr + ni * li) / dd, ci = (ni * lr - nr * li) / dd;
            const float* br = b_re + (size_t)(g * 64 + pp) * 16 + 8 * hf; const float* bi = b_im + (size_t)(g * 64 + pp) * 16 + 8 * hf;
            unsigned wr_[4], wi_[4];
#pragma unroll
            for (int i = 0; i < 4; ++i) { const float r0 = br[2 * i], i0 = bi[2 * i], r1 = br[2 * i + 1], i1 = bi[2 * i + 1];
                wr_[i] = cvt_pk_bf16(cr * r0 - ci * i0, cr * r1 - ci * i1); wi_[i] = cvt_pk_bf16(cr * i0 + ci * r0, cr * i1 + ci * r1); }
            Bre[pb] = __builtin_bit_cast(bf16x8, (u32x4){wr_[0], wr_[1], wr_[2], wr_[3]}); Bim[pb] = __builtin_bit_cast(bf16x8, (u32x4){wi_[0], wi_[1], wi_[2], wi_[3]});
        }
        bf16x8 Cf[4];
#pragma unroll
        for (int kb = 0; kb < 4; ++kb) { const int p0 = kb * 16 + 4 * q4; const float* cr = c_re + (size_t)(g * 16 + c16) * 64 + p0; const float* ci = c_im + (size_t)(g * 16 + c16) * 64 + p0;
            Cf[kb] = __builtin_bit_cast(bf16x8, (u32x4){cvt_pk_bf16(cr[0], -ci[0]), cvt_pk_bf16(cr[1], -ci[1]), cvt_pk_bf16(cr[2], -ci[2]), cvt_pk_bf16(cr[3], -ci[3])}); }
        float dk[4];
#pragma unroll
        for (int r = 0; r < 4; ++r) dk[r] = dsk[g * 16 + 4 * q4 + r];
        float sr = 0.f, si = 0.f;
        const bf16_t* hb = hn + (size_t)b * SEQ * D + g * 16; bf16_t* yb = ys + (size_t)b * SEQ * D + g * 16;
        bf16x8 ufn = *(const bf16x8*)(hb + (size_t)c32 * D + 8 * hf);
        u32x2 uwn[2];
#pragma unroll
        for (int tb = 0; tb < 2; ++tb) uwn[tb] = *(const u32x2*)(hb + (size_t)(tb * 16 + c16) * D + 4 * q4);
        for (int c = 0; c < SEQ / 32; ++c) {
            const int t0 = c * 32;
            const bf16x8 uf = ufn; const u32x2 uwc[2] = {uwn[0], uwn[1]};
            { const int tn = (c + 1 < SEQ / 32) ? t0 + 32 : t0;
              ufn = *(const bf16x8*)(hb + (size_t)(tn + c32) * D + 8 * hf);
#pragma unroll
              for (int tb = 0; tb < 2; ++tb) uwn[tb] = *(const u32x2*)(hb + (size_t)(tn + tb * 16 + c16) * D + 4 * q4); }
            const f32x16 z16 = {0.f, 0.f, 0.f, 0.f, 0.f, 0.f, 0.f, 0.f, 0.f, 0.f, 0.f, 0.f, 0.f, 0.f, 0.f, 0.f};
            f32x16 r0 = __builtin_amdgcn_mfma_f32_32x32x16_bf16(uf, Bre[0], z16, 0, 0, 0), r1 = __builtin_amdgcn_mfma_f32_32x32x16_bf16(uf, Bre[1], z16, 0, 0, 0);
            f32x16 i0 = __builtin_amdgcn_mfma_f32_32x32x16_bf16(uf, Bim[0], z16, 0, 0, 0), i1 = __builtin_amdgcn_mfma_f32_32x32x16_bf16(uf, Bim[1], z16, 0, 0, 0);
#pragma unroll
            for (int q = 0; q < 4; ++q) {
                float xr[8], xi[8];
#pragma unroll
                for (int i = 0; i < 4; ++i) {
                    auto pr = __builtin_amdgcn_permlane32_swap(__float_as_uint(r0[4 * q + i]), __float_as_uint(r1[4 * q + i]), false, false);
                    auto pi = __builtin_amdgcn_permlane32_swap(__float_as_uint(i0[4 * q + i]), __float_as_uint(i1[4 * q + i]), false, false);
                    xr[i] = __uint_as_float(pr[0]); xr[4 + i] = __uint_as_float(pr[1]); xi[i] = __uint_as_float(pi[0]); xi[4 + i] = __uint_as_float(pi[1]); }
#pragma unroll
                for (int i = 0; i < 8; ++i) { const float nr = ar * sr - ai * si + xr[i], ni = ar * si + ai * sr + xi[i]; sr = nr; si = ni;
                    S[(8 * q + i) * 68 + lane] = cvt_pk_bf16(sr, si); }
            }
            asm volatile("" ::: "memory");
#pragma unroll
            for (int tb = 0; tb < 2; ++tb) {
                f32x4 y = (f32x4){0.f, 0.f, 0.f, 0.f};
#pragma unroll
                for (int kb = 0; kb < 4; ++kb) { const bf16x8 sf = __builtin_bit_cast(bf16x8, *(const LAS u32x4*)(S + (tb * 16 + c16) * 68 + kb * 16 + 4 * q4));
                    y = __builtin_amdgcn_mfma_f32_16x16x32_bf16(Cf[kb], sf, y, 0, 0, 0); }
                const size_t off = (size_t)(t0 + tb * 16 + c16) * D + 4 * q4;
                const u32x2 uw = uwc[tb];
                const float u0 = bflo(uw.x), u1 = bfhi(uw.x), u2 = bflo(uw.y), u3 = bfhi(uw.y);
                u32x2 w; w.x = cvt_pk_bf16(gelu_tanh(y[0] + dk[0] * u0), gelu_tanh(y[1] + dk[1] * u1)); w.y = cvt_pk_bf16(gelu_tanh(y[2] + dk[2] * u2), gelu_tanh(y[3] + dk[3] * u3));
                *(u32x2*)(yb + off) = w;
            }
        }
    }
}

__device__ __forceinline__ void attn_phase(const bf16_t* Q, const bf16_t* Kb, const bf16_t* VT, bf16_t* O) {
    const int tid__ = otid(); const int lane = tid__ & 63, wave = tid__ >> 6, c32 = lane & 31, hf = lane >> 5;
    for (int bh = blockIdx.x; bh < 256; bh += gridDim.x) {
        const int b = bh >> 4, h = bh & 15;
        const bf16_t* vtb = VT + (size_t)(b * 16 + h) * 64 * SEQ;
        for (int it = 0; it < 8; ++it) {
            const int qb = wave * 8 + it, t0 = qb * 32;
            const bf16_t* qp = Q + (size_t)(b * SEQ + t0 + c32) * D + h * 64 + 8 * hf;
            bf16x8 qf[4];
#pragma unroll
            for (int kd = 0; kd < 4; ++kd) qf[kd] = *(const bf16x8*)(qp + 16 * kd);
            f32x16 o0 = {0.f, 0.f, 0.f, 0.f, 0.f, 0.f, 0.f, 0.f, 0.f, 0.f, 0.f, 0.f, 0.f, 0.f, 0.f, 0.f}, o1 = o0;
            float R = 0.f;
            bf16x8 kfn[4];
            { const bf16_t* kp = Kb + (size_t)(b * SEQ + qb * 32 + c32) * D + h * 64 + 8 * hf;
#pragma unroll
              for (int kd = 0; kd < 4; ++kd) kfn[kd] = *(const bf16x8*)(kp + 16 * kd); }
            for (int kt = qb; kt >= 0; --kt) {
                const int s0 = kt * 32;
                f32x16 z = {0.f, 0.f, 0.f, 0.f, 0.f, 0.f, 0.f, 0.f, 0.f, 0.f, 0.f, 0.f, 0.f, 0.f, 0.f, 0.f};
#pragma unroll
                for (int kd = 0; kd < 4; ++kd) z = __builtin_amdgcn_mfma_f32_32x32x16_bf16(kfn[kd], qf[kd], z, 0, 0, 0);
                { const int sn = kt > 0 ? s0 - 32 : s0;
                  const bf16_t* kp = Kb + (size_t)(b * SEQ + sn + c32) * D + h * 64 + 8 * hf;
#pragma unroll
                  for (int kd = 0; kd < 4; ++kd) kfn[kd] = *(const bf16x8*)(kp + 16 * kd); }
                bf16x8 vf[2][2];
#pragma unroll
                for (int db = 0; db < 2; ++db)
#pragma unroll
                    for (int ks = 0; ks < 2; ++ks) { const bf16_t* vp = vtb + (size_t)(db * 32 + c32) * SEQ + s0 + 16 * ks + 4 * hf;
                        const u32x2 a = *(const u32x2*)vp, c = *(const u32x2*)(vp + 8); vf[db][ks] = __builtin_bit_cast(bf16x8, (u32x4){a.x, a.y, c.x, c.y}); }
                float L[16], lg[16];
                const bool diag = (kt == qb);
#pragma unroll
                for (int r = 0; r < 16; ++r) { const float zz = z[r]; const float sp = fmaxf(zz, 0.f) + __logf(1.0f + __expf(-fabsf(zz)));
                    const int sl = 8 * (r >> 2) + 4 * hf + (r & 3); const bool valid = !diag || (sl < c32);
                    L[r] = valid ? -sp : 0.f; lg[r] = valid ? zz - sp : -1e30f; }
                float bs[4], pbs[4];
#pragma unroll
                for (int q = 0; q < 4; ++q) { bs[q] = (L[4 * q] + L[4 * q + 1]) + (L[4 * q + 2] + L[4 * q + 3]); pbs[q] = __shfl_xor(bs[q], 32); }
                float after = R; float att[16];
#pragma unroll
                for (int q = 3; q >= 0; --q) {
                    const float off = after + (hf == 0 ? pbs[q] : 0.f);
                    const float e3 = off, e2 = e3 + L[4 * q + 3], e1 = e2 + L[4 * q + 2], e0 = e1 + L[4 * q + 1];
                    att[4 * q + 3] = __expf(lg[4 * q + 3] + e3); att[4 * q + 2] = __expf(lg[4 * q + 2] + e2); att[4 * q + 1] = __expf(lg[4 * q + 1] + e1); att[4 * q] = __expf(lg[4 * q] + e0);
                    after += bs[q] + pbs[q];
                }
                R = after;
#pragma unroll
                for (int ks = 0; ks < 2; ++ks) {
                    const bf16x8 pf = __builtin_bit_cast(bf16x8, (u32x4){cvt_pk_bf16(att[8 * ks], att[8 * ks + 1]), cvt_pk_bf16(att[8 * ks + 2], att[8 * ks + 3]), cvt_pk_bf16(att[8 * ks + 4], att[8 * ks + 5]), cvt_pk_bf16(att[8 * ks + 6], att[8 * ks + 7])});
                    o0 = __builtin_amdgcn_mfma_f32_32x32x16_bf16(vf[0][ks], pf, o0, 0, 0, 0); o1 = __builtin_amdgcn_mfma_f32_32x32x16_bf16(vf[1][ks], pf, o1, 0, 0, 0); }
                if (__all(R < -120.0f)) break;
            }
            bf16_t* op = O + (size_t)(b * SEQ + t0 + c32) * D + h * 64 + 4 * hf;
#pragma unroll
            for (int q = 0; q < 4; ++q) {
                u32x2 w0; w0.x = cvt_pk_bf16(o0[4 * q], o0[4 * q + 1]); w0.y = cvt_pk_bf16(o0[4 * q + 2], o0[4 * q + 3]); *(u32x2*)(op + 8 * q) = w0;
                u32x2 w1; w1.x = cvt_pk_bf16(o1[4 * q], o1[4 * q + 1]); w1.y = cvt_pk_bf16(o1[4 * q + 2], o1[4 * q + 3]); *(u32x2*)(op + 32 + 8 * q) = w1; }
        }
    }
}


__global__ void __launch_bounds__(NTHREADS, 2) fwd_megakernel(Params P) {
    extern __shared__ __attribute__((aligned(16))) unsigned char lds_raw[];
    LAS unsigned char* lds = (LAS unsigned char*)lds_raw;
    cg::grid_group grid = cg::this_grid();
    unsigned char* ws = P.ws;
    bf16_t* HN = (bf16_t*)(ws + WS_HN);
    bf16_t* B0 = (bf16_t*)(ws + WS_BIG); bf16_t* B1 = (bf16_t*)(ws + WS_BIG + ACT); bf16_t* B2 = (bf16_t*)(ws + WS_BIG + 2 * ACT); bf16_t* B3 = (bf16_t*)(ws + WS_BIG + 3 * ACT); bf16_t* B4 = (bf16_t*)(ws + WS_BIG + 4 * ACT);
    float* RAW = (float*)(ws + WS_RAW);
    float* X = P.out;
    const int G = gridDim.x, bx = blockIdx.x;
    pg8::StaticOrder S;
    volatile LAS unsigned* MISC = (volatile LAS unsigned*)(lds + MISC_OFF);
    if (threadIdx.x < 2) MISC[threadIdx.x] = 0u;
    __syncthreads();
    const XcdBarrier bar = xcd_barrier_post((unsigned*)ws, MISC);
    grid.sync();
#define SYNC() xcd_barrier(bar)

    weights_phase(P, lds);
    rmsnorm_phase(P.in[0], P.in[1], HN);
    SYNC();
#define FFN_BLOCK(layer, LASTSYNC) do { \
        rmsnorm_phase(X, P.in[2] + (layer) * D, HN); \
        SYNC(); \
        const float* cw = P.in[30] + (size_t)(layer) * 3 * F2; const float* cb = P.in[31] + (size_t)(layer) * F2; \
        { pg8::Gemm g{HN, (const bf16_t*)(ws + WS_WF1) + (size_t)(layer) * F2 * D, T, F2, 1024, D, D, 0, 0}; S.init(T, F2, G, bx); \
          EpiFfn1 E{B0, cw, cb, RAW, (LAS float*)(lds + XCH_OFF)}; pg8::gemm_phase(lds, g, S, E); } \
        SYNC(); \
        { pg8::Gemm g{B0, (const bf16_t*)(ws + WS_WF2) + (size_t)(layer) * D * FH, T, 1024, FH, FH, FH, 0, 0}; S.init(T, 1024, G, bx); \
          { Unit fu; int lastpm = -1; for (int i = 0; S.next(i, fu); ++i) if (fu.pm != lastpm) { ffn_fix_panel(RAW, cw, cb, B0, fu.pm); lastpm = fu.pm; } } \
          asm volatile("s_waitcnt vmcnt(0)" ::: "memory"); __syncthreads(); \
          EpiRes E{X, X, nullptr, nullptr}; pg8::gemm_phase(lds, g, S, E); } \
        if (LASTSYNC) SYNC(); } while (0)

    pool_phase(HN, B0);
    SYNC();
    { pg8::Gemm g{B0, (const bf16_t*)(ws + WS_WPOOL), T, 1024, 256, D, 256, 0, 512}; S.init(T, 1024, G, bx);
      EpiRes E{P.in[0], X, P.in[5], P.in[4]}; pg8::gemm_phase(lds, g, S, E); }
    SYNC();
    FFN_BLOCK(0, true);
    rmsnorm_phase(X, P.in[1] + 1 * D, HN);
    SYNC();
    s5_phase(P, HN, B0, lds);
    SYNC();
    { pg8::Gemm g{B0, (const bf16_t*)(ws + WS_WS5), T, 2048, 1024, D, D, 0, 0}; S.init(T, 2048, G, bx);
      EpiGateRes E{X, P.in[15]}; pg8::gemm_phase(lds, g, S, E); }
    SYNC();
    FFN_BLOCK(1, true);
    rmsnorm_phase(X, P.in[1] + 2 * D, HN);
    SYNC();
    { pg8::Gemm g{HN, (const bf16_t*)(ws + WS_WLIN), T, 2048, 1024, D, D, 0, 0}; S.init(T, 2048, G, bx);
      EpiLruIn E{B0, B1}; pg8::gemm_phase(lds, g, S, E); }
    SYNC();
    lruconv_phase(B1, P.in[17], P.in[18], B2);
    SYNC();
    { pg8::Gemm g{B2, (const bf16_t*)(ws + WS_WGATE), T, 2048, 256, D, 256, 1, 512}; S.init(T, 2048, G, bx);
      EpiGates E{B2, B3, B4, P.in[20], P.in[22], P.in[23]}; pg8::gemm_phase(lds, g, S, E); }
    SYNC();
    lruscan_phase(B3, B4, B0, lds);
    SYNC();
    { pg8::Gemm g{B0, (const bf16_t*)(ws + WS_WLOUT), T, 1024, 1024, D, D, 0, 0}; S.init(T, 1024, G, bx);
      EpiRes E{X, X, nullptr, nullptr}; pg8::gemm_phase(lds, g, S, E); }
    SYNC();
    FFN_BLOCK(2, true);
    rmsnorm_phase(X, P.in[1] + 3 * D, HN);
    SYNC();
    { pg8::Gemm g{HN, (const bf16_t*)(ws + WS_WQKV), T, 3072, 1024, D, D, 0, 0}; S.init(T, 3072, G, bx);
      EpiQKV E{B0, P.in[26], P.in[27]}; pg8::gemm_phase(lds, g, S, E); }
    SYNC();
    vt_phase(B2, B3, lds);
    SYNC();
    attn_phase(B0, B1, B3, B4);
    SYNC();
    { pg8::Gemm g{B4, (const bf16_t*)(ws + WS_WWO), T, 1024, 1024, D, D, 0, 0}; S.init(T, 1024, G, bx);
      EpiRes E{X, X, nullptr, nullptr}; pg8::gemm_phase(lds, g, S, E); }
    SYNC();
    FFN_BLOCK(3, false);
}

extern "C" void kernel_launch(void* const* d_in, const int* in_sizes, int n_in, void* d_out, int out_size, void* d_ws, size_t ws_size, hipStream_t stream) {
    static int grid = 0;
    if (grid == 0) {
        if (n_in != 33 || out_size != T * D || ws_size < WS_END) { fprintf(stderr, "kernel_launch: unexpected shapes (n_in %d out %d ws %zu)\n", n_in, out_size, ws_size); grid = -1; return; }
        int dev = 0, cus = 0, per_cu = 0;
        (void)hipGetDevice(&dev); (void)hipDeviceGetAttribute(&cus, hipDeviceAttributeMultiprocessorCount, dev);
        if (hipFuncSetAttribute((const void*)fwd_megakernel, hipFuncAttributeMaxDynamicSharedMemorySize, LDS_BYTES) != hipSuccess) { fprintf(stderr, "kernel_launch: hipFuncSetAttribute failed\n"); grid = -1; return; }
        (void)hipOccupancyMaxActiveBlocksPerMultiprocessor(&per_cu, (const void*)fwd_megakernel, NTHREADS, LDS_BYTES);
        (void)hipGetLastError();
        if (per_cu < 1) per_cu = 1;
        grid = cus * per_cu;
        if (grid > 256) grid = 256;
    }
    if (grid < 0) return;
    Params p; memset(&p, 0, sizeof(p));
    for (int i = 0; i < 33; ++i) p.in[i] = (const float*)d_in[i];
    p.out = (float*)d_out; p.ws = (unsigned char*)d_ws;
    unsigned char* ws = (unsigned char*)d_ws;
    int nj = 0, items = 0;
    auto add = [&](const float* src, bf16_t* dst, int K, int ld, int nrows, int map, int hh) {
        Job& j = p.jobs[nj++]; j.src = src; j.dst = dst; j.K = K; j.ld = ld; j.nrows = nrows; j.map = map; j.hh = hh; j.item0 = items; items += (K / 64) * (nrows / 32); };
    for (int l = 0; l < 4; ++l) add(p.in[29] + (size_t)l * D * F2, (bf16_t*)(ws + WS_WF1) + (size_t)l * F2 * D, 1024, F2, F2, 1, FH);
    for (int l = 0; l < 4; ++l) add(p.in[32] + (size_t)l * FH * D, (bf16_t*)(ws + WS_WF2) + (size_t)l * D * FH, FH, D, D, 0, 0);
    for (int gI = 0; gI < 4; ++gI) add(p.in[3] + (size_t)gI * 65536, (bf16_t*)(ws + WS_WPOOL) + (size_t)gI * 65536, 256, 256, 256, 0, 0);
    add(p.in[14], (bf16_t*)(ws + WS_WS5), 1024, 2048, 2048, 1, 1024);
    add(p.in[16], (bf16_t*)(ws + WS_WLIN), 1024, 2048, 2048, 0, 0);
    for (int pn = 0; pn < 8; ++pn) for (int bj = 0; bj < 2; ++bj)
        add((bj ? p.in[21] : p.in[19]) + (size_t)(pn >> 1) * 65536 + (pn & 1) * 128, (bf16_t*)(ws + WS_WGATE) + (size_t)(pn * 256 + bj * 128) * 256, 256, 256, 128, 0, 0);
    add(p.in[24], (bf16_t*)(ws + WS_WLOUT), 1024, 1024, 1024, 0, 0);
    add(p.in[25], (bf16_t*)(ws + WS_WQKV), 1024, 3072, 3072, 2, 0);
    add(p.in[28], (bf16_t*)(ws + WS_WWO), 1024, 1024, 1024, 0, 0);
    p.nitems = items;
    if (hipMemsetAsync(d_ws, 0, 16384, stream) != hipSuccess) { fprintf(stderr, "kernel_launch: memset failed\n"); return; }
    void* args[] = {&p};
    hipError_t e = hipLaunchCooperativeKernel((const void*)fwd_megakernel, dim3(grid), dim3(NTHREADS), args, LDS_BYTES, stream);
    if (e != hipSuccess) fprintf(stderr, "cooperative launch failed: %s (grid %d)\n", hipGetErrorString(e), grid);
}
```

```cpp
#include <hip/hip_runtime.h>
#include <hip/hip_cooperative_groups.h>
#include <cstdio>
#include <cstring>
namespace cg = cooperative_groups;

#define LAS __attribute__((address_space(3)))
typedef unsigned short bf16_t;
typedef short bf16x8 __attribute__((ext_vector_type(8)));
typedef short bf16x4 __attribute__((ext_vector_type(4)));
typedef float f32x4 __attribute__((ext_vector_type(4)));
typedef float f32x16 __attribute__((ext_vector_type(16)));
typedef unsigned u32x4 __attribute__((ext_vector_type(4)));
typedef unsigned u32x2 __attribute__((ext_vector_type(2)));

constexpr int T = 32768, D = 1024, SEQ = 2048, FH = 2816, F2 = 5632;
constexpr int NTHREADS = 512;
constexpr int LDS_BYTES = 147456;
constexpr int XCH_OFF = 131072, MISC_OFF = 131072 + 8192;
constexpr size_t MiB = 1u << 20;
constexpr size_t WS_WPOOL = 1 * MiB, WS_WS5 = 2 * MiB, WS_WLIN = 6 * MiB, WS_WGATE = 10 * MiB, WS_WLOUT = 11 * MiB,
                 WS_WQKV = 13 * MiB, WS_WWO = 19 * MiB, WS_WF1 = 21 * MiB, WS_WF2 = 65 * MiB,
                 WS_HN = 96 * MiB, WS_BIG = 160 * MiB, WS_RAW = 480 * MiB, WS_END = 492 * MiB;
constexpr size_t ACT = 64 * MiB;

typedef __bf16 bf16v2_t __attribute__((ext_vector_type(2)));
__device__ __forceinline__ unsigned cvt_pk_bf16(float lo, float hi) { const bf16v2_t v = {(__bf16)lo, (__bf16)hi}; return __builtin_bit_cast(unsigned, v); }
__device__ __forceinline__ float bf2f(unsigned short b) { return __uint_as_float(((unsigned)b) << 16); }
__device__ __forceinline__ float bflo(unsigned w) { return __uint_as_float(w << 16); }
__device__ __forceinline__ float bfhi(unsigned w) { return __uint_as_float(w & 0xffff0000u); }
__device__ __forceinline__ float sigmoidf_(float x) { return __builtin_amdgcn_rcpf(1.0f + __expf(-x)); }
__device__ __forceinline__ float gelu_tanh(float x) { const float k = 1.5957691216f * (x + 0.044715f * x * x * x); return x * __builtin_amdgcn_rcpf(1.0f + __expf(-k)); }
__device__ __forceinline__ float wave_sum(float v) {
#pragma unroll
    for (int o = 1; o < 64; o <<= 1) v += __shfl_xor(v, o);
    return v;
}
__device__ __forceinline__ int otid() { int t = threadIdx.x; asm volatile("" : "+v"(t)); return t; }
template <int CTRL> __device__ __forceinline__ float dpp_upd(float old, float src) {
    return __int_as_float(__builtin_amdgcn_update_dpp(__float_as_int(old), __float_as_int(src), CTRL, 0xf, 0xf, false));
}
template <int CTRL> __device__ __forceinline__ float dpp0(float src) { return __int_as_float(__builtin_amdgcn_update_dpp(0, __float_as_int(src), CTRL, 0xf, 0xf, true)); }
__device__ __forceinline__ void conv_taps(float& h, float cur, float prev, float w1, float w0) {
    asm("s_nop 1\n\t"
        "v_fmac_f32_dpp %0, %1, %3 row_shr:1 row_mask:0xf bank_mask:0xf bound_ctrl:1\n\t"
        "v_fmac_f32_dpp %0, %1, %4 row_shr:2 row_mask:0xf bank_mask:0xf bound_ctrl:1\n\t"
        "v_fmac_f32_dpp %0, %2, %3 row_shl:15 row_mask:0xf bank_mask:0xf bound_ctrl:1\n\t"
        "v_fmac_f32_dpp %0, %2, %4 row_shl:14 row_mask:0xf bank_mask:0xf bound_ctrl:1"
        : "+v"(h) : "v"(cur), "v"(prev), "v"(w1), "v"(w0));
}
__device__ __forceinline__ float prev1(float prev, float cur) { const float t = dpp_upd<0x121>(0.f, prev); return dpp_upd<0x111>(t, cur); }
__device__ __forceinline__ float prev2(float prev, float cur) { const float t = dpp_upd<0x122>(0.f, prev); return dpp_upd<0x112>(t, cur); }

namespace pg8 {
constexpr int BM = 256, BK = 64, HALF = 128, HTB = HALF * BK * 2, STAGE_BYTES = 8 * HTB, NXCD = 8, WGM = 8;
__host__ __device__ __forceinline__ int lds_byte(int r, int c) { const int st = (r >> 4) * 2 + (c >> 5), rr = r & 15, cc = c & 31, ob = rr * 64 + cc * 2; return st * 1024 + (ob ^ (((ob >> 9) & 1) << 5)); }
__host__ __device__ __forceinline__ void stage_rc(int b, int& R, int& C) { const int st = b / 1024, sb = b % 1024, swz = sb ^ (((sb >> 9) & 1) << 5); R = (st >> 1) * 16 + swz / 64; C = (st & 1) * 32 + (swz % 64) / 2; }
__host__ __device__ __forceinline__ int perm32(int rho) { const int n = rho >> 4, i = rho & 15; return 8 * (i >> 2) + 4 * n + (i & 3); }
struct Unit { int pm, pn; };
struct Gemm { const bf16_t* A; const bf16_t* Bt; int M, N, K, lda, ldb, a_shift, a_step; };
struct StaticOrder {
    int nM, nN, nwg, G, c;
    __device__ __forceinline__ void init(int M, int N, int G_, int c_) { nM = M / BM; nN = N / BM; nwg = nM * nN; G = G_; c = c_; }
    __device__ __forceinline__ bool next(int i, Unit& u) const {
        const long L = (long)i * G + c; if (L >= nwg) return false;
        int wgid = (int)L; { const int q = nwg / NXCD, r = nwg % NXCD, xcd = wgid % NXCD, off = wgid / NXCD; wgid = (xcd < r ? xcd * (q + 1) : r * (q + 1) + (xcd - r) * q) + off; }
        const int nig = WGM * nN, gid = wgid / nig, fm = gid * WGM, gsz = (nM - fm) < WGM ? (nM - fm) : WGM;
        u.pm = fm + ((wgid % nig) % gsz); u.pn = (wgid % nig) / gsz; return true;
    }
};
template <class Epi>
__device__ __forceinline__ void gemm_phase(LAS unsigned char* lds, const Gemm g, const StaticOrder& S, const Epi& E) {
    int tid_ = threadIdx.x; asm volatile("" : "+v"(tid_));
    const int tid = tid_, wid = __builtin_amdgcn_readfirstlane(tid >> 6), lane = tid & 63, wr = wid >> 2, wc = wid & 3, fr = lane & 15, fq = lane >> 4;
    const int K = g.K, nt = K / BK;
    unsigned voffA[2], voffB[2];
#pragma unroll
    for (int i = 0; i < 2; ++i) { int R, C; stage_rc(tid * 16 + i * 8192, R, C); const int Rb = Epi::PERM ? ((R & ~31) + perm32(R & 31)) : R;
        voffA[i] = (unsigned)(R * g.lda + C) * 2u; voffB[i] = (unsigned)(Rb * g.ldb + C) * 2u; }
    const size_t kstep = (size_t)(BK * 2);
    const size_t hstepA = (size_t)HALF * g.lda * 2, hstepB = (size_t)HALF * g.ldb * 2;
    const size_t tstepA = 2 * hstepA, tstepB = 2 * hstepB;
    const unsigned ldsw = (unsigned)wid * 1024u;
    const int aoff = lds_byte(wr * 64 + fr, fq * 8), boff = lds_byte(wc * 32 + fr, fq * 8);
#define PG8_SA(b, h) (((b) * 2 + (h)) * HTB)
#define PG8_SB(b, h) ((4 + (b) * 2 + (h)) * HTB)
#define PG8_STAGE(bufoff, gbase, voff) do { _Pragma("unroll") for (int _i = 0; _i < 2; ++_i) \
        __builtin_amdgcn_global_load_lds((const unsigned*)((const char*)(gbase) + (voff)[_i]), (LAS unsigned*)(lds + (bufoff) + ldsw + _i * 8192), 16, 0, 0); } while (0)
#define PG8_LDA(dst, b, h) do { _Pragma("unroll") for (int m = 0; m < 4; ++m) _Pragma("unroll") for (int k = 0; k < 2; ++k) dst[m][k] = *(const LAS bf16x8*)(lds + PG8_SA(b, h) + aoff + m * 2048 + k * 1024); } while (0)
#define PG8_LDB(dst, b, h) do { _Pragma("unroll") for (int n = 0; n < 2; ++n) _Pragma("unroll") for (int k = 0; k < 2; ++k) dst[n][k] = *(const LAS bf16x8*)(lds + PG8_SB(b, h) + boff + n * 2048 + k * 1024); } while (0)
#define PG8_MMA(ai, bj, At, Bt) do { __builtin_amdgcn_s_setprio(1); _Pragma("unroll") for (int m = 0; m < 4; ++m) _Pragma("unroll") for (int n = 0; n < 2; ++n) _Pragma("unroll") for (int k = 0; k < 2; ++k) \
        acc[ai][bj][m][n] = __builtin_amdgcn_mfma_f32_16x16x32_bf16(Bt[n][k], At[m][k], acc[ai][bj][m][n], 0, 0, 0); __builtin_amdgcn_s_setprio(0); } while (0)
#define PG8_WAIT_V(n) asm volatile("s_waitcnt vmcnt(" #n ")" ::: "memory")
#define PG8_WAIT_L(n) asm volatile("s_waitcnt lgkmcnt(" #n ")" ::: "memory")
#define PG8_BAR __builtin_amdgcn_s_barrier()
#define PG8_SCHED __builtin_amdgcn_sched_barrier(0)
    Unit cur, nxt; int ui = 0;
    if (!S.next(0, cur)) return;
    f32x4 acc[2][2][4][2];
    {
#pragma unroll
    for (int a = 0; a < 2; ++a)
#pragma unroll
        for (int b = 0; b < 2; ++b)
#pragma unroll
            for (int m = 0; m < 4; ++m)
#pragma unroll
                for (int n = 0; n < 2; ++n) acc[a][b][m][n] = (f32x4){0.f, 0.f, 0.f, 0.f};
    }
    bf16x8 At[4][2], B0[2][2], B1[2][2];
    const char* cA = (const char*)g.A + (size_t)cur.pm * tstepA + (size_t)(cur.pn >> g.a_shift) * g.a_step; const char* cB = (const char*)g.Bt + (size_t)cur.pn * tstepB;
    PG8_STAGE(PG8_SB(0, 0), cB, voffB); PG8_STAGE(PG8_SA(0, 0), cA, voffA); PG8_STAGE(PG8_SB(0, 1), cB + hstepB, voffB); PG8_STAGE(PG8_SA(0, 1), cA + hstepA, voffA);
    if (wr == 1) PG8_BAR;
    PG8_WAIT_V(4); PG8_BAR;
    PG8_STAGE(PG8_SB(1, 0), cB + kstep, voffB); PG8_STAGE(PG8_SA(1, 0), cA + kstep, voffA); PG8_STAGE(PG8_SB(1, 1), cB + hstepB + kstep, voffB);
    PG8_WAIT_V(6); PG8_BAR;
    for (;;) {
        const bool has_next = S.next(ui + 1, nxt);
        const char* nA = has_next ? (const char*)g.A + (size_t)nxt.pm * tstepA + (size_t)(nxt.pn >> g.a_shift) * g.a_step : cA; const char* nB = has_next ? (const char*)g.Bt + (size_t)nxt.pn * tstepB : cB;
        for (int t = 0; t < nt; t += 2) {
            const bool last = (t == nt - 2);
            const char* a1 = cA + (size_t)(t + 1) * kstep;
            const char* a2 = last ? nA : cA + (size_t)(t + 2) * kstep; const char* b2 = last ? nB : cB + (size_t)(t + 2) * kstep;
            const char* a3 = a2 + kstep; const char* b3 = b2 + kstep;
            PG8_LDB(B0, 0, 0); PG8_SCHED; PG8_LDA(At, 0, 0); PG8_STAGE(PG8_SA(1, 1), a1 + hstepA, voffA);
            PG8_WAIT_L(8); PG8_BAR; PG8_WAIT_L(0); PG8_MMA(0, 0, At, B0); PG8_BAR; PG8_SCHED;
            PG8_LDB(B1, 0, 1); PG8_STAGE(PG8_SB(0, 0), b2, voffB);
            PG8_BAR; PG8_WAIT_L(0); PG8_MMA(0, 1, At, B1); PG8_BAR;
            PG8_LDA(At, 0, 1); PG8_STAGE(PG8_SA(0, 0), a2, voffA);
            PG8_BAR; PG8_WAIT_L(0); PG8_MMA(1, 0, At, B0); PG8_BAR; PG8_SCHED;
            PG8_STAGE(PG8_SB(0, 1), b2 + hstepB, voffB);
            PG8_WAIT_V(6); PG8_BAR; PG8_MMA(1, 1, At, B1); PG8_BAR;
            PG8_LDB(B0, 1, 0); PG8_SCHED; PG8_LDA(At, 1, 0); PG8_STAGE(PG8_SA(0, 1), a2 + hstepA, voffA);
            PG8_WAIT_L(8); PG8_BAR; PG8_WAIT_L(0); PG8_MMA(0, 0, At, B0); PG8_BAR; PG8_SCHED;
            PG8_LDB(B1, 1, 1); PG8_STAGE(PG8_SB(1, 0), b3, voffB);
            PG8_BAR; PG8_WAIT_L(0); PG8_MMA(0, 1, At, B1); PG8_BAR;
            PG8_LDA(At, 1, 1); PG8_STAGE(PG8_SA(1, 0), a3, voffA);
            PG8_BAR; PG8_WAIT_L(0); PG8_MMA(1, 0, At, B0); PG8_BAR; PG8_SCHED;
            PG8_STAGE(PG8_SB(1, 1), b3 + hstepB, voffB);
            PG8_WAIT_V(6); PG8_BAR; PG8_MMA(1, 1, At, B1); PG8_BAR;
        }
        E(acc, cur, wr, wc, fr, fq);
        if (!has_next) break;
        {
#pragma unroll
        for (int a = 0; a < 2; ++a)
#pragma unroll
            for (int b = 0; b < 2; ++b)
#pragma unroll
                for (int m = 0; m < 4; ++m)
#pragma unroll
                    for (int n = 0; n < 2; ++n) acc[a][b][m][n] = (f32x4){0.f, 0.f, 0.f, 0.f};
        }
        cur = nxt; cA = nA; cB = nB; ++ui;
    }
    PG8_WAIT_V(0);
    if (wr == 0) PG8_BAR;
    PG8_BAR;
#undef PG8_SA
#undef PG8_SB
#undef PG8_STAGE
#undef PG8_LDA
#undef PG8_LDB
#undef PG8_MMA
#undef PG8_WAIT_V
#undef PG8_WAIT_L
#undef PG8_BAR
#undef PG8_SCHED
}
}
using pg8::Unit;
typedef const f32x4 (&AccRef)[2][2][4][2];

struct EpiRes {
    static constexpr bool PERM = false;
    const float* base; float* out; const float* scale; const float* bias;
    __device__ __forceinline__ void operator()(AccRef acc, const Unit& u, int wr, int wc, int fr, int fq) const {
        const int row0 = u.pm * 256 + wr * 64 + fr, col0 = u.pn * 256 + wc * 32 + 4 * fq;
        f32x4 sv[2][2], bv[2][2];
#pragma unroll
        for (int bj = 0; bj < 2; ++bj)
#pragma unroll
            for (int n = 0; n < 2; ++n) {
                sv[bj][n] = scale ? *(const f32x4*)(scale + col0 + bj * 128 + n * 16) : (f32x4){1.f, 1.f, 1.f, 1.f};
                bv[bj][n] = bias ? *(const f32x4*)(bias + col0 + bj * 128 + n * 16) : (f32x4){0.f, 0.f, 0.f, 0.f}; }
#pragma unroll
        for (int ai = 0; ai < 2; ++ai)
#pragma unroll
            for (int mh = 0; mh < 2; ++mh) {
                f32x4 bs[2][2][2];
#pragma unroll
                for (int m = 0; m < 2; ++m)
#pragma unroll
                    for (int bj = 0; bj < 2; ++bj)
#pragma unroll
                        for (int n = 0; n < 2; ++n) bs[m][bj][n] = *(const f32x4*)(base + (size_t)(row0 + ai * 128 + (2 * mh + m) * 16) * D + col0 + bj * 128 + n * 16);
#pragma unroll
                for (int m = 0; m < 2; ++m)
#pragma unroll
                    for (int bj = 0; bj < 2; ++bj)
#pragma unroll
                        for (int n = 0; n < 2; ++n) *(f32x4*)(out + (size_t)(row0 + ai * 128 + (2 * mh + m) * 16) * D + col0 + bj * 128 + n * 16) = bs[m][bj][n] + sv[bj][n] * (acc[ai][bj][2 * mh + m][n] + bv[bj][n]);
                asm volatile("" ::: "memory"); }
    }
};
struct EpiGateRes {
    static constexpr bool PERM = true;
    float* x; const float* bias;
    __device__ __forceinline__ void operator()(AccRef acc, const Unit& u, int wr, int wc, int fr, int fq) const {
        const int row0 = u.pm * 256 + wr * 64 + fr, col0 = u.pn * 128 + wc * 32 + 8 * fq;
        f32x4 bv[2], bg[2];
#pragma unroll
        for (int n = 0; n < 2; ++n) { bv[n] = *(const f32x4*)(bias + col0 + 4 * n); bg[n] = *(const f32x4*)(bias + D + col0 + 4 * n); }
#pragma unroll
        for (int ai = 0; ai < 2; ++ai) {
            f32x4 xs[4][2];
#pragma unroll
            for (int m = 0; m < 4; ++m)
#pragma unroll
                for (int n = 0; n < 2; ++n) xs[m][n] = *(const f32x4*)(x + (size_t)(row0 + ai * 128 + m * 16) * D + col0 + 4 * n);
#pragma unroll
            for (int m = 0; m < 4; ++m)
#pragma unroll
                for (int n = 0; n < 2; ++n) { f32x4 xv = xs[m][n]; const f32x4 v = acc[ai][0][m][n] + bv[n], gt = acc[ai][1][m][n] + bg[n];
#pragma unroll
                    for (int j = 0; j < 4; ++j) xv[j] += v[j] * sigmoidf_(gt[j]);
                    *(f32x4*)(x + (size_t)(row0 + ai * 128 + m * 16) * D + col0 + 4 * n) = xv; }
            asm volatile("" ::: "memory"); }
    }
};
struct EpiLruIn {
    static constexpr bool PERM = true;
    bf16_t* GG; bf16_t* RP;
    __device__ __forceinline__ void operator()(AccRef acc, const Unit& u, int wr, int wc, int fr, int fq) const {
        const int row0 = u.pm * 256 + wr * 64 + fr; const bool isg = u.pn < 4;
        bf16_t* dst = isg ? GG : RP; const int col0 = (u.pn & 3) * 256 + wc * 32 + 8 * fq;
#pragma unroll
        for (int ai = 0; ai < 2; ++ai)
#pragma unroll
            for (int m = 0; m < 4; ++m) { bf16_t* rp = dst + (size_t)(row0 + ai * 128 + m * 16) * D + col0;
#pragma unroll
                for (int bj = 0; bj < 2; ++bj) { f32x4 v0 = acc[ai][bj][m][0], v1 = acc[ai][bj][m][1];
                    if (isg) {
#pragma unroll
                        for (int j = 0; j < 4; ++j) { v0[j] = gelu_tanh(v0[j]); v1[j] = gelu_tanh(v1[j]); } }
                    u32x4 w; w.x = cvt_pk_bf16(v0[0], v0[1]); w.y = cvt_pk_bf16(v0[2], v0[3]); w.z = cvt_pk_bf16(v1[0], v1[1]); w.w = cvt_pk_bf16(v1[2], v1[3]);
                    *(u32x4*)(rp + bj * 128) = w; } }
    }
};
struct EpiGates {
    static constexpr bool PERM = true;
    const bf16_t* REC; bf16_t* LA; bf16_t* BV; const float* b_a; const float* b_x; const float* lam;
    __device__ __forceinline__ void operator()(AccRef acc, const Unit& u, int wr, int wc, int fr, int fq) const {
        const int row0 = u.pm * 256 + wr * 64 + fr, col0 = u.pn * 128 + wc * 32 + 8 * fq;
        u32x4 rws[2][4];
#pragma unroll
        for (int ai = 0; ai < 2; ++ai)
#pragma unroll
            for (int m = 0; m < 4; ++m) rws[ai][m] = *(const u32x4*)(REC + (size_t)(row0 + ai * 128 + m * 16) * D + col0);
#pragma unroll
        for (int n = 0; n < 2; ++n) {
            const f32x4 ba = *(const f32x4*)(b_a + col0 + 4 * n), bx = *(const f32x4*)(b_x + col0 + 4 * n), l = *(const f32x4*)(lam + col0 + 4 * n);
            f32x4 k8;
#pragma unroll
            for (int j = 0; j < 4; ++j) k8[j] = -8.0f * __logf(1.0f + __expf(-l[j]));
#pragma unroll
            for (int ai = 0; ai < 2; ++ai)
#pragma unroll
                for (int m = 0; m < 4; ++m) { const size_t off = (size_t)(row0 + ai * 128 + m * 16) * D + col0 + 4 * n;
                    float lo[4], bo[4];
#pragma unroll
                    for (int j = 0; j < 4; ++j) { const unsigned w = rws[ai][m][2 * n + (j >> 1)]; const float rec = (j & 1) ? bfhi(w) : bflo(w);
                        const float r = sigmoidf_(acc[ai][0][m][n][j] + ba[j]), ig = sigmoidf_(acc[ai][1][m][n][j] + bx[j]);
                        const float la = k8[j] * r; const float mult = __builtin_sqrtf(1.0f - __expf(2.0f * la));
                        lo[j] = la; bo[j] = mult * ig * rec; }
                    *(u32x2*)(LA + off) = (u32x2){cvt_pk_bf16(lo[0], lo[1]), cvt_pk_bf16(lo[2], lo[3])}; *(u32x2*)(BV + off) = (u32x2){cvt_pk_bf16(bo[0], bo[1]), cvt_pk_bf16(bo[2], bo[3])}; }
        }
    }
};
struct EpiQKV {
    static constexpr bool PERM = true;
    bf16_t* QKV; const float* qg; const float* kg;
    __device__ __forceinline__ void operator()(AccRef acc, const Unit& u, int wr, int wc, int fr, int fq) const {
        const int which = u.pn >> 2, row0 = u.pm * 256 + wr * 64 + fr, col0 = (u.pn & 3) * 256 + wc * 64 + 8 * fq;
        bf16_t* dst = QKV + (size_t)which * ((size_t)T * D);
        f32x4 gv[2][2];
#pragma unroll
        for (int bj = 0; bj < 2; ++bj)
#pragma unroll
            for (int n = 0; n < 2; ++n) { const f32x4 a = *(const f32x4*)(qg + 32 * bj + 8 * fq + 4 * n), b = *(const f32x4*)(kg + 32 * bj + 8 * fq + 4 * n);
                gv[bj][n] = which == 0 ? a : (which == 1 ? b : (f32x4){1.f, 1.f, 1.f, 1.f}); }
#pragma unroll
        for (int ai = 0; ai < 2; ++ai)
#pragma unroll
            for (int m = 0; m < 4; ++m) {
                float sc = 1.0f;
                if (which < 2) { float ss = 0.f;
#pragma unroll
                    for (int bj = 0; bj < 2; ++bj)
#pragma unroll
                        for (int n = 0; n < 2; ++n) { const f32x4 v = acc[ai][bj][m][n]; ss += (v[0] * v[0] + v[1] * v[1]) + (v[2] * v[2] + v[3] * v[3]); }
                    ss += __shfl_xor(ss, 16); ss += __shfl_xor(ss, 32);
                    sc = rsqrtf(ss * (1.0f / 64.0f) + 1e-6f) * (which == 0 ? 0.125f : 1.0f); }
                bf16_t* rp = dst + (size_t)(row0 + ai * 128 + m * 16) * D + col0;
#pragma unroll
                for (int bj = 0; bj < 2; ++bj) { const f32x4 v0 = acc[ai][bj][m][0] * gv[bj][0] * sc, v1 = acc[ai][bj][m][1] * gv[bj][1] * sc;
                    u32x4 w; w.x = cvt_pk_bf16(v0[0], v0[1]); w.y = cvt_pk_bf16(v0[2], v0[3]); w.z = cvt_pk_bf16(v1[0], v1[1]); w.w = cvt_pk_bf16(v1[2], v1[3]);
                    *(u32x4*)(rp + bj * 32) = w; } }
    }
};
struct EpiFfn1 {
    static constexpr bool PERM = true;
    bf16_t* Aout; const float* cw; const float* cb; float* raw; LAS float* xch;
    __device__ __forceinline__ void operator()(AccRef acc, const Unit& u, int wr, int wc, int fr, int fq) const {
        const int clb = 32 * wc + 8 * fq;
        f32x4 cwv[2][8];
        { const float* cv = cw + 128 * u.pn + clb; const float* cg = cv + FH; const float* bp = cb + 128 * u.pn + clb;
          cwv[0][0] = *(const f32x4*)(cv); cwv[0][1] = *(const f32x4*)(cv + F2); cwv[0][2] = *(const f32x4*)(cv + 2 * F2); cwv[0][3] = *(const f32x4*)(bp);
          cwv[0][4] = *(const f32x4*)(cg); cwv[0][5] = *(const f32x4*)(cg + F2); cwv[0][6] = *(const f32x4*)(cg + 2 * F2); cwv[0][7] = *(const f32x4*)(bp + FH); }
        if (fr >= 14) {
#pragma unroll
            for (int ai = 0; ai < 2; ++ai)
#pragma unroll
                for (int bj = 0; bj < 2; ++bj)
#pragma unroll
                    for (int n = 0; n < 2; ++n) *(LAS f32x4*)(xch + ((ai * 2 + wr) * 2 + (fr - 14)) * 256 + bj * 128 + clb + 4 * n) = acc[ai][bj][3][n];
        }
        float* rawu = raw + (size_t)(u.pm * 22 + u.pn) * 1024;
        if (wr == 0 && fr < 2) {
#pragma unroll
            for (int bj = 0; bj < 2; ++bj)
#pragma unroll
                for (int n = 0; n < 2; ++n) *(f32x4*)(rawu + fr * 256 + bj * 128 + clb + 4 * n) = acc[0][bj][0][n];
        }
        if (wr == 1 && fr >= 14) {
#pragma unroll
            for (int bj = 0; bj < 2; ++bj)
#pragma unroll
                for (int n = 0; n < 2; ++n) *(f32x4*)(rawu + (fr - 12) * 256 + bj * 128 + clb + 4 * n) = acc[1][bj][3][n];
        }
        asm volatile("s_waitcnt lgkmcnt(0)" ::: "memory"); __builtin_amdgcn_s_barrier(); __builtin_amdgcn_s_barrier(); asm volatile("" ::: "memory");
        const int hc0 = 128 * u.pn + clb, row0 = u.pm * 256 + wr * 64 + fr;
#pragma unroll
        for (int n = 0; n < 2; ++n) {
            const f32x4 w0v = cwv[n][0], w1v = cwv[n][1], w2v = cwv[n][2], bvv = cwv[n][3], w0g = cwv[n][4], w1g = cwv[n][5], w2g = cwv[n][6], bvg = cwv[n][7];
#pragma unroll
            for (int ai = 0; ai < 2; ++ai) {
                if (n == 0 && ai == 0) {
                    asm volatile("" ::: "memory");
                    const float* cv = cw + hc0 + 4; const float* cg = cv + FH; const float* bp = cb + hc0 + 4;
                    cwv[1][0] = *(const f32x4*)(cv); cwv[1][1] = *(const f32x4*)(cv + F2); cwv[1][2] = *(const f32x4*)(cv + 2 * F2); cwv[1][3] = *(const f32x4*)(bp);
                    cwv[1][4] = *(const f32x4*)(cg); cwv[1][5] = *(const f32x4*)(cg + F2); cwv[1][6] = *(const f32x4*)(cg + 2 * F2); cwv[1][7] = *(const f32x4*)(bp + FH);
                    asm volatile("" ::: "memory"); }
                f32x4 hv = (f32x4){0.f, 0.f, 0.f, 0.f}, hg = hv;
                const int pb = ai * 2 + wr - 1;
                if (pb >= 0 && fr >= 14) { hv = *(const LAS f32x4*)(xch + (pb * 2 + (fr - 14)) * 256 + clb + 4 * n); hg = *(const LAS f32x4*)(xch + (pb * 2 + (fr - 14)) * 256 + 128 + clb + 4 * n); }
#pragma unroll
                for (int m = 0; m < 4; ++m) {
                    const f32x4 pv = m ? acc[ai][0][m ? m - 1 : 0][n] : hv, pg = m ? acc[ai][1][m ? m - 1 : 0][n] : hg;
                    const f32x4 cvv = acc[ai][0][m][n], cgg = acc[ai][1][m][n];
                    float o[4];
#pragma unroll
                    for (int j = 0; j < 4; ++j) {
                        float hval = bvv[j] + w2v[j] * cvv[j];
                        conv_taps(hval, cvv[j], pv[j], w1v[j], w0v[j]);
                        float hgat = bvg[j] + w2g[j] * cgg[j];
                        conv_taps(hgat, cgg[j], pg[j], w1g[j], w0g[j]);
                        o[j] = hgat * sigmoidf_(hgat) * hval; }
                    u32x2 w; w.x = cvt_pk_bf16(o[0], o[1]); w.y = cvt_pk_bf16(o[2], o[3]);
                    *(u32x2*)(Aout + (size_t)(row0 + ai * 128 + m * 16) * FH + hc0 + 4 * n) = w; } } }
    }
};

#define XB_TMO      128
#define XB_XCNT(j)  (256  + 64 * (j))
#define XB_XSUB(j)  (1280 + 64 * (j))
#define XB_XGEN(j)  (2304 + 64 * (j))
#define XB_TOP      3328
#define XB_TOPGEN   3392
#define XCD_BAR_WORDS 3456
#define XB_SPIN_CAP (1u << 24)
__device__ __forceinline__ unsigned xb_ld(unsigned* p)              { return __hip_atomic_load(p, __ATOMIC_RELAXED, __HIP_MEMORY_SCOPE_AGENT); }
__device__ __forceinline__ unsigned xb_add(unsigned* p, unsigned v) { return __hip_atomic_fetch_add(p, v, __ATOMIC_RELAXED, __HIP_MEMORY_SCOPE_AGENT); }
__device__ __forceinline__ unsigned xb_xcc_id() { return (unsigned)__builtin_amdgcn_s_getreg((3 << 11) | 20) & 0xFu; }
#define XB_SPIN(cond, bar) do { unsigned _sp = 0; while (cond) { __builtin_amdgcn_s_sleep(1); \
    if ((++_sp & 255u) == 0u) { if (xb_ld(&(bar)[XB_TMO])) break; if (_sp > XB_SPIN_CAP) { atomicAdd(&(bar)[XB_TMO], 1u); break; } } } } while (0)
struct XcdBarrier { unsigned* bar; unsigned x; volatile LAS unsigned* st; };
__device__ __forceinline__ XcdBarrier xcd_barrier_post(unsigned* bar, volatile LAS unsigned* st) {
    XcdBarrier b; b.bar = bar; b.x = xb_xcc_id(); b.st = st;
    if (threadIdx.x == 0) (void)xb_add(&bar[XB_XCNT(b.x)], 1u);
    return b;
}
__device__ __forceinline__ void xcd_barrier_complete(unsigned* bar, unsigned x, unsigned& nloc, unsigned& nx) {
    const unsigned G = gridDim.x * gridDim.y * gridDim.z;
    unsigned sum, cnt, mine, sp = 0u;
    for (;;) {
        sum = 0u; cnt = 0u; mine = 0u;
#pragma unroll
        for (unsigned j = 0; j < 16; ++j) { const unsigned c = xb_ld(&bar[XB_XCNT(j)]); sum += c; cnt += (c > 0u) ? 1u : 0u; mine = (j == x) ? c : mine; }
        if (sum == G) break;
        __builtin_amdgcn_s_sleep(1);
        if ((++sp & 255u) == 0u) { if (xb_ld(&bar[XB_TMO])) break; if (sp > XB_SPIN_CAP) { atomicAdd(&bar[XB_TMO], 1u); break; } }
    }
    nloc = mine > 0u ? mine : 1u; nx = cnt > 0u ? cnt : 1u;
}
__device__ __forceinline__ void xcd_barrier(const XcdBarrier& b) {
    asm volatile("s_waitcnt vmcnt(0) lgkmcnt(0)" ::: "memory");
    __syncthreads();
    if (threadIdx.x == 0) {
        unsigned* bar = b.bar;
        __builtin_amdgcn_s_waitcnt(0);
        unsigned nloc = b.st[0], nx = b.st[1];
        if (nloc == 0u) { xcd_barrier_complete(bar, b.x, nloc, nx); b.st[0] = nloc; b.st[1] = nx; }
        const unsigned old = xb_add(&bar[XB_XSUB(b.x)], 1u);
        const unsigned gen = old / nloc;
        if (old + 1u == (gen + 1u) * nloc) {
            __builtin_amdgcn_fence(__ATOMIC_RELEASE, "agent");
            asm volatile("s_waitcnt vmcnt(0)" ::: "memory");
            const unsigned og = xb_add(&bar[XB_TOP], 1u);
            const unsigned tg = og / nx;
            if (og + 1u == (tg + 1u) * nx) xb_add(&bar[XB_TOPGEN], 1u);
            else XB_SPIN(xb_ld(&bar[XB_TOPGEN]) == tg, bar);
            __builtin_amdgcn_fence(__ATOMIC_ACQUIRE, "agent");
            xb_add(&bar[XB_XGEN(b.x)], 1u);
            asm volatile("s_waitcnt vmcnt(0)" ::: "memory");
        } else {
            XB_SPIN(xb_ld(&bar[XB_XGEN(b.x)]) == gen, bar);
            __builtin_amdgcn_fence(__ATOMIC_ACQUIRE, "agent");
            asm volatile("s_waitcnt vmcnt(0)" ::: "memory");
        }
    }
    __syncthreads();
}

struct Job { const float* src; bf16_t* dst; int K, ld, nrows, map, hh, item0; };
constexpr int NJOBS = 33;
struct Params {
    const float* in[33]; float* out; unsigned char* ws;
    Job jobs[NJOBS]; int nitems; int pad;
};

__device__ __forceinline__ int map_col(int map, int hh, int j) {
    if (map == 0) return j;
    if (map == 1) { const int pn = j >> 8, bj = (j >> 7) & 1, i = j & 127; return bj * hh + 128 * pn + i; }
    const int pn = j >> 8, cl = j & 255, bj = cl >> 7, h4 = (cl & 127) >> 5, i = cl & 31; return 256 * pn + 64 * h4 + 32 * bj + i;
}

__device__ __forceinline__ void weights_phase(const Params& P, LAS unsigned char* lds) {
    const int tid__ = otid(); const int lane = tid__ & 63, wave = tid__ >> 6;
    LAS float* scr = (LAS float*)(lds + wave * 8448);
    const int gw = blockIdx.x * 8 + wave, ngw = gridDim.x * 8;
    for (int it = gw; it < P.nitems; it += ngw) {
        int ji = 0;
#pragma unroll 1
        for (int q = 1; q < NJOBS; ++q) if (it >= P.jobs[q].item0) ji = q;
        const Job jb = P.jobs[ji];
        const int r = it - jb.item0, nblk = jb.nrows / 32, kb = r / nblk, nb = r % nblk, k0 = 64 * kb, n0 = 32 * nb, c0 = map_col(jb.map, jb.hh, n0);
#pragma unroll 8
        for (int i = 0; i < 32; ++i) { const int kk = 2 * i + (lane >> 5); scr[kk * 33 + (lane & 31)] = jb.src[(size_t)(k0 + kk) * jb.ld + c0 + (lane & 31)]; }
        asm volatile("s_waitcnt lgkmcnt(0)" ::: "memory");
        const int c = lane & 7;
#pragma unroll
        for (int j = 0; j < 4; ++j) { const int n = (lane >> 3) + 8 * j; const LAS float* s = scr + (8 * c) * 33 + n;
            u32x4 o; o.x = cvt_pk_bf16(s[0 * 33], s[1 * 33]); o.y = cvt_pk_bf16(s[2 * 33], s[3 * 33]); o.z = cvt_pk_bf16(s[4 * 33], s[5 * 33]); o.w = cvt_pk_bf16(s[6 * 33], s[7 * 33]);
            *(u32x4*)(jb.dst + (size_t)(n0 + n) * jb.K + k0 + 8 * c) = o; }
        asm volatile("s_waitcnt lgkmcnt(0)" ::: "memory");
    }
}
__device__ __forceinline__ void rmsnorm_phase(const float* x, const float* g, bf16_t* hn) {
    const int tid__ = otid(); const int lane = tid__ & 63, wave = tid__ >> 6;
    const int gw = blockIdx.x * 8 + wave, ngw = gridDim.x * 8;
    f32x4 gv[4];
#pragma unroll
    for (int j = 0; j < 4; ++j) gv[j] = *((const f32x4*)g + lane + 64 * j);
    f32x4 v[4];
    if (gw < T) {
#pragma unroll
        for (int j = 0; j < 4; ++j) v[j] = ((const f32x4*)(x + (size_t)gw * D) + lane)[64 * j]; }
    for (int m = gw; m < T; m += ngw) {
        f32x4 vn[4];
        const int mn = (m + ngw < T) ? m + ngw : m;
#pragma unroll
        for (int j = 0; j < 4; ++j) vn[j] = ((const f32x4*)(x + (size_t)mn * D) + lane)[64 * j];
        float s = 0.f;
#pragma unroll
        for (int j = 0; j < 4; ++j) s += (v[j][0] * v[j][0] + v[j][1] * v[j][1]) + (v[j][2] * v[j][2] + v[j][3] * v[j][3]);
        const float rstd = rsqrtf(wave_sum(s) * (1.0f / D) + 1e-6f);
        u32x2* o = (u32x2*)(hn + (size_t)m * D) + lane;
#pragma unroll
        for (int j = 0; j < 4; ++j) { const f32x4 y = v[j] * rstd * gv[j]; u32x2 w; w.x = cvt_pk_bf16(y[0], y[1]); w.y = cvt_pk_bf16(y[2], y[3]); o[64 * j] = w; }
#pragma unroll
        for (int j = 0; j < 4; ++j) v[j] = vn[j];
    }
}
__device__ __forceinline__ void ld8(const bf16_t* p, float (&v)[8]) {
    const u32x4 w = *(const u32x4*)p;
#pragma unroll
    for (int i = 0; i < 4; ++i) { v[2 * i] = bflo(w[i]); v[2 * i + 1] = bfhi(w[i]); }
}
__device__ __forceinline__ void st8(bf16_t* p, const float (&v)[8]) {
    u32x4 w; w.x = cvt_pk_bf16(v[0], v[1]); w.y = cvt_pk_bf16(v[2], v[3]); w.z = cvt_pk_bf16(v[4], v[5]); w.w = cvt_pk_bf16(v[6], v[7]);
    *(u32x4*)p = w;
}
__device__ __forceinline__ void pool_phase(const bf16_t* hn, bf16_t* dd) {
    for (int gid = blockIdx.x * NTHREADS + otid(); gid < (T / 32) * 128; gid += gridDim.x * NTHREADS) {
        const int col8 = gid & 127, chunk = gid >> 7, w = 2 << (col8 >> 5), t0 = chunk * 32, pos0 = t0 & (SEQ - 1);
        const bf16_t* hp = hn + (size_t)t0 * D + col8 * 8; bf16_t* dp = dd + (size_t)t0 * D + col8 * 8;
        float s[8];
#pragma unroll
        for (int i = 0; i < 8; ++i) s[i] = 0.f;
        if (pos0) for (int k = 1; k <= w; ++k) { float v[8]; ld8(hp - (size_t)k * D, v);
#pragma unroll
            for (int i = 0; i < 8; ++i) s[i] += v[i]; }
        for (int i = 0; i < 32; ++i) {
            float cur[8]; ld8(hp + (size_t)i * D, cur); const int pos = pos0 + i;
#pragma unroll
            for (int q = 0; q < 8; ++q) s[q] += cur[q];
            if (pos >= w) { float v[8]; ld8(hp + (size_t)(i - w) * D, v);
#pragma unroll
                for (int q = 0; q < 8; ++q) s[q] -= v[q]; }
            const float inv = 1.0f / (float)(pos + 1 < w ? pos + 1 : w);
            float o[8];
#pragma unroll
            for (int q = 0; q < 8; ++q) o[q] = s[q] * inv - cur[q];
            st8(dp + (size_t)i * D, o);
        }
    }
}
__device__ __forceinline__ void lruconv_phase(const bf16_t* pre, const float* cw, const float* cb, bf16_t* rec) {
    for (int gid = blockIdx.x * NTHREADS + otid(); gid < (T / 32) * 128; gid += gridDim.x * NTHREADS) {
        const int col8 = gid & 127, chunk = gid >> 7, t0 = chunk * 32, pos0 = t0 & (SEQ - 1);
        const bf16_t* hp = pre + (size_t)t0 * D + col8 * 8; bf16_t* dp = rec + (size_t)t0 * D + col8 * 8;
        float w0[8], w1[8], w2[8], w3[8], bb[8], p3[8], p2[8], p1[8];
#pragma unroll
        for (int i = 0; i < 8; ++i) { w0[i] = cw[col8 * 8 + i]; w1[i] = cw[D + col8 * 8 + i]; w2[i] = cw[2 * D + col8 * 8 + i]; w3[i] = cw[3 * D + col8 * 8 + i]; bb[i] = cb[col8 * 8 + i]; p3[i] = 0.f; p2[i] = 0.f; p1[i] = 0.f; }
        if (pos0) { ld8(hp - 3 * (size_t)D, p3); ld8(hp - 2 * (size_t)D, p2); ld8(hp - (size_t)D, p1); }
        for (int i = 0; i < 32; ++i) {
            float cur[8], o[8]; ld8(hp + (size_t)i * D, cur);
#pragma unroll
            for (int q = 0; q < 8; ++q) { o[q] = bb[q] + w0[q] * p3[q] + w1[q] * p2[q] + w2[q] * p1[q] + w3[q] * cur[q]; p3[q] = p2[q]; p2[q] = p1[q]; p1[q] = cur[q]; }
            st8(dp + (size_t)i * D, o);
        }
    }
}
__device__ __forceinline__ void lruscan_phase(const bf16_t* LA, const bf16_t* BV, bf16_t* GG, LAS unsigned char* lds) {
    LAS float* sA = (LAS float*)lds; LAS float* sB = sA + 64 * 64;
    const int tid__ = otid(); const int c8 = tid__ & 7, tc = tid__ >> 3;
    for (int unit = blockIdx.x; unit < 256; unit += gridDim.x) {
        const int b = unit >> 4, cgp = unit & 15;
        const size_t base = ((size_t)b * SEQ + tc * 32) * D + cgp * 64 + c8 * 8;
        float sl[8], Bv[8], h[8];
#pragma unroll
        for (int q = 0; q < 8; ++q) { sl[q] = 0.f; Bv[q] = 0.f; h[q] = 0.f; }
#pragma unroll 4
        for (int i = 0; i < 32; ++i) { float la[8], bb[8]; ld8(LA + base + (size_t)i * D, la); ld8(BV + base + (size_t)i * D, bb);
#pragma unroll
            for (int q = 0; q < 8; ++q) { Bv[q] = __expf(la[q]) * Bv[q] + bb[q]; sl[q] += la[q]; } }
#pragma unroll
        for (int q = 0; q < 8; ++q) { sA[tc * 64 + c8 * 8 + q] = __expf(sl[q]); sB[tc * 64 + c8 * 8 + q] = Bv[q]; }
        __syncthreads();
        for (int j = 0; j < tc; ++j) {
            const f32x4 a0 = *(const LAS f32x4*)(sA + j * 64 + c8 * 8), a1 = *(const LAS f32x4*)(sA + j * 64 + c8 * 8 + 4), b0 = *(const LAS f32x4*)(sB + j * 64 + c8 * 8), b1 = *(const LAS f32x4*)(sB + j * 64 + c8 * 8 + 4);
#pragma unroll
            for (int q = 0; q < 4; ++q) { h[q] = a0[q] * h[q] + b0[q]; h[4 + q] = a1[q] * h[4 + q] + b1[q]; } }
#pragma unroll 4
        for (int i = 0; i < 32; ++i) { float la[8], bb[8], gg[8], y[8]; ld8(LA + base + (size_t)i * D, la); ld8(BV + base + (size_t)i * D, bb); ld8(GG + base + (size_t)i * D, gg);
#pragma unroll
            for (int q = 0; q < 8; ++q) { h[q] = __expf(la[q]) * h[q] + bb[q]; y[q] = gg[q] * h[q]; }
            st8(GG + base + (size_t)i * D, y); }
        __syncthreads();
    }
}
__device__ __forceinline__ void ffn_fix_panel(const float* raw, const float* cw, const float* cb, bf16_t* Aout, int pm) {
    if ((pm & 7) == 0) return;
    for (int idx = otid(); idx < 2 * FH; idx += NTHREADS) {
        const int hc = idx % FH, rr = idx / FH;
        const int pn = hc >> 7, cl = hc & 127;
        const float* cur = raw + (size_t)(pm * 22 + pn) * 1024; const float* prv = raw + (size_t)((pm - 1) * 22 + pn) * 1024;
        float hh[2];
#pragma unroll
        for (int part = 0; part < 2; ++part) { const int off = part * 128 + cl, col = part * FH + hc;
            const float x0 = cur[rr * 256 + off], x1 = rr ? cur[off] : prv[3 * 256 + off], x2 = rr ? prv[3 * 256 + off] : prv[2 * 256 + off];
            hh[part] = cb[col] + cw[2 * F2 + col] * x0 + cw[F2 + col] * x1 + cw[col] * x2; }
        const float o = hh[1] * sigmoidf_(hh[1]) * hh[0];
        Aout[(size_t)(pm * 256 + rr) * FH + hc] = (bf16_t)(cvt_pk_bf16(o, 0.f) & 0xffffu);
    }
}
__device__ __forceinline__ void s5_phase(const Params& P, const bf16_t* hn, bf16_t* ys, LAS unsigned char* lds) {
    const int tid__ = otid(); const int lane = tid__ & 63, wave = tid__ >> 6;
    if (wave >= 4) return;
    LAS unsigned* S = (LAS unsigned*)(lds + wave * 8704);
    const float* lam_re = P.in[6]; const float* lam_im = P.in[7]; const float* log_dt = P.in[8]; const float* b_re = P.in[9]; const float* b_im = P.in[10];
    const float* c_re = P.in[11]; const float* c_im = P.in[12]; const float* dsk = P.in[13];
    const int c32 = lane & 31, hf = lane >> 5, c16 = lane & 15, q4 = lane >> 4;
    for (int unit = blockIdx.x * 4 + wave; unit < 1024; unit += gridDim.x * 4) {
        const int b = unit >> 6, g = unit & 63;
        const float dt = expf(log_dt[g]);
        float ar, ai;
        { const float lr = fminf(lam_re[g * 64 + lane], -1e-4f), li = lam_im[g * 64 + lane]; const float er = expf(lr * dt); ar = er * cosf(li * dt); ai = er * sinf(li * dt); }
        bf16x8 Bre[2], Bim[2];
#pragma unroll
        for (int pb = 0; pb < 2; ++pb) {
            const int pp = pb * 32 + c32;
            const float lr = fminf(lam_re[g * 64 + pp], -1e-4f), li = lam_im[g * 64 + pp]; const float er = expf(lr * dt);
            const float nr = er * cosf(li * dt) - 1.0f, ni = er * sinf(li * dt), dd = lr * lr + li * li;
            const float cr = (nr * lr + ni * li) / dd, ci = (ni * lr - nr * li) / dd;
            const float* br = b_re + (size_t)(g * 64 + pp) * 16 + 8 * hf; const float* bi = b_im + (size_t)(g * 64 + pp) * 16 + 8 * hf;
            unsigned wr_[4], wi_[4];
#pragma unroll
            for (int i = 0; i < 4; ++i) { const float r0 = br[2 * i], i0 = bi[2 * i], r1 = br[2 * i + 1], i1 = bi[2 * i + 1];
                wr_[i] = cvt_pk_bf16(cr * r0 - ci * i0, cr * r1 - ci * i1); wi_[i] = cvt_pk_bf16(cr * i0 + ci * r0, cr * i1 + ci * r1); }
            Bre[pb] = __builtin_bit_cast(bf16x8, (u32x4){wr_[0], wr_[1], wr_[2], wr_[3]}); Bim[pb] = __builtin_bit_cast(bf16x8, (u32x4){wi_[0], wi_[1], wi_[2], wi_[3]});
        }
        bf16x8 Cf[4];
#pragma unroll
        for (int kb = 0; kb < 4; ++kb) { const int p0 = kb * 16 + 4 * q4; const float* cr = c_re + (size_t)(g * 16 + c16) * 64 + p0; const float* ci = c_im + (size_t)(g * 16 + c16) * 64 + p0;
            Cf[kb] = __builtin_bit_cast(bf16x8, (u32x4){cvt_pk_bf16(cr[0], -ci[0]), cvt_pk_bf16(cr[1], -ci[1]), cvt_pk_bf16(cr[2], -ci[2]), cvt_pk_bf16(cr[3], -ci[3])}); }
        float dk[4];
#pragma unroll
        for (int r = 0; r < 4; ++r) dk[r] = dsk[g * 16 + 4 * q4 + r];
        float sr = 0.f, si = 0.f;
        const bf16_t* hb = hn + (size_t)b * SEQ * D + g * 16; bf16_t* yb = ys + (size_t)b * SEQ * D + g * 16;
        bf16x8 ufn = *(const bf16x8*)(hb + (size_t)c32 * D + 8 * hf);
        u32x2 uwn[2];
#pragma unroll
        for (int tb = 0; tb < 2; ++tb) uwn[tb] = *(const u32x2*)(hb + (size_t)(tb * 16 + c16) * D + 4 * q4);
        for (int c = 0; c < SEQ / 32; ++c) {
            const int t0 = c * 32;
            const bf16x8 uf = ufn; const u32x2 uwc[2] = {uwn[0], uwn[1]};
            { const int tn = (c + 1 < SEQ / 32) ? t0 + 32 : t0;
              ufn = *(const bf16x8*)(hb + (size_t)(tn + c32) * D + 8 * hf);
#pragma unroll
              for (int tb = 0; tb < 2; ++tb) uwn[tb] = *(const u32x2*)(hb + (size_t)(tn + tb * 16 + c16) * D + 4 * q4); }
            const f32x16 z16 = {0.f, 0.f, 0.f, 0.f, 0.f, 0.f, 0.f, 0.f, 0.f, 0.f, 0.f, 0.f, 0.f, 0.f, 0.f, 0.f};
            f32x16 r0 = __builtin_amdgcn_mfma_f32_32x32x16_bf16(uf, Bre[0], z16, 0, 0, 0), r1 = __builtin_amdgcn_mfma_f32_32x32x16_bf16(uf, Bre[1], z16, 0, 0, 0);
            f32x16 i0 = __builtin_amdgcn_mfma_f32_32x32x16_bf16(uf, Bim[0], z16, 0, 0, 0), i1 = __builtin_amdgcn_mfma_f32_32x32x16_bf16(uf, Bim[1], z16, 0, 0, 0);
#pragma unroll
            for (int q = 0; q < 4; ++q) {
                float xr[8], xi[8];
#pragma unroll
                for (int i = 0; i < 4; ++i) {
                    auto pr = __builtin_amdgcn_permlane32_swap(__float_as_uint(r0[4 * q + i]), __float_as_uint(r1[4 * q + i]), false, false);
                    auto pi = __builtin_amdgcn_permlane32_swap(__float_as_uint(i0[4 * q + i]), __float_as_uint(i1[4 * q + i]), false, false);
                    xr[i] = __uint_as_float(pr[0]); xr[4 + i] = __uint_as_float(pr[1]); xi[i] = __uint_as_float(pi[0]); xi[4 + i] = __uint_as_float(pi[1]); }
#pragma unroll
                for (int i = 0; i < 8; ++i) { const float nr = ar * sr - ai * si + xr[i], ni = ar * si + ai * sr + xi[i]; sr = nr; si = ni;
                    S[(8 * q + i) * 68 + lane] = cvt_pk_bf16(sr, si); }
            }
            asm volatile("" ::: "memory");
#pragma unroll
            for (int tb = 0; tb < 2; ++tb) {
                f32x4 y = (f32x4){0.f, 0.f, 0.f, 0.f};
#pragma unroll
                for (int kb = 0; kb < 4; ++kb) { const bf16x8 sf = __builtin_bit_cast(bf16x8, *(const LAS u32x4*)(S + (tb * 16 + c16) * 68 + kb * 16 + 4 * q4));
                    y = __builtin_amdgcn_mfma_f32_16x16x32_bf16(Cf[kb], sf, y, 0, 0, 0); }
                const size_t off = (size_t)(t0 + tb * 16 + c16) * D + 4 * q4;
                const u32x2 uw = uwc[tb];
                const float u0 = bflo(uw.x), u1 = bfhi(uw.x), u2 = bflo(uw.y), u3 = bfhi(uw.y);
                u32x2 w; w.x = cvt_pk_bf16(gelu_tanh(y[0] + dk[0] * u0), gelu_tanh(y[1] + dk[1] * u1)); w.y = cvt_pk_bf16(gelu_tanh(y[2] + dk[2] * u2), gelu_tanh(y[3] + dk[3] * u3));
                *(u32x2*)(yb + off) = w;
            }
        }
    }
}

__device__ __forceinline__ void attn_phase(const bf16_t* Q, const bf16_t* Kb, const bf16_t* V, bf16_t* VT, bf16_t* O, LAS unsigned char* lds) {
    const int tid__ = otid(); const int lane = tid__ & 63, wave = tid__ >> 6, c32 = lane & 31, hf = lane >> 5;
    for (int bh = blockIdx.x; bh < 256; bh += gridDim.x) {
        const int b = bh >> 4, h = bh & 15;
        bf16_t* vtw = VT + (size_t)(b * 16 + h) * 64 * SEQ;
        {
            LAS bf16_t* scr = (LAS bf16_t*)(lds + wave * 8704);
            for (int st = wave * 4; st < wave * 4 + 4; ++st) {
                const int s0 = st * 64;
#pragma unroll
                for (int j = 0; j < 8; ++j) { const int i = (lane >> 3) + 8 * j, c = lane & 7;
                    const u32x4 w = *(const u32x4*)(V + (size_t)(b * SEQ + s0 + i) * D + h * 64 + 8 * c);
                    *(LAS u32x2*)(scr + i * 68 + 8 * c) = (u32x2){w.x, w.y}; *(LAS u32x2*)(scr + i * 68 + 8 * c + 4) = (u32x2){w.z, w.w}; }
                asm volatile("s_waitcnt lgkmcnt(0)" ::: "memory");
#pragma unroll
                for (int j = 0; j < 8; ++j) { const int d = (lane >> 3) + 8 * j, c = lane & 7;
                    unsigned short e[8];
#pragma unroll
                    for (int k = 0; k < 8; ++k) e[k] = scr[(8 * c + k) * 68 + d];
                    u32x4 w; w.x = e[0] | ((unsigned)e[1] << 16); w.y = e[2] | ((unsigned)e[3] << 16); w.z = e[4] | ((unsigned)e[5] << 16); w.w = e[6] | ((unsigned)e[7] << 16);
                    *(u32x4*)(vtw + (size_t)d * SEQ + s0 + 8 * c) = w; }
                asm volatile("s_waitcnt lgkmcnt(0)" ::: "memory");
            }
            asm volatile("s_waitcnt vmcnt(0)" ::: "memory"); __syncthreads();
        }
        const bf16_t* vtb = vtw;
        for (int it = 0; it < 8; ++it) {
            const int qb = wave * 8 + it, t0 = qb * 32;
            const bf16_t* qp = Q + (size_t)(b * SEQ + t0 + c32) * D + h * 64 + 8 * hf;
            bf16x8 qf[4];
#pragma unroll
            for (int kd = 0; kd < 4; ++kd) qf[kd] = *(const bf16x8*)(qp + 16 * kd);
            f32x16 o0 = {0.f, 0.f, 0.f, 0.f, 0.f, 0.f, 0.f, 0.f, 0.f, 0.f, 0.f, 0.f, 0.f, 0.f, 0.f, 0.f}, o1 = o0;
            float R = 0.f;
            bf16x8 kfn[4];
            { const bf16_t* kp = Kb + (size_t)(b * SEQ + qb * 32 + c32) * D + h * 64 + 8 * hf;
#pragma unroll
              for (int kd = 0; kd < 4; ++kd) kfn[kd] = *(const bf16x8*)(kp + 16 * kd); }
            for (int kt = qb; kt >= 0; --kt) {
                const int s0 = kt * 32;
                f32x16 z = {0.f, 0.f, 0.f, 0.f, 0.f, 0.f, 0.f, 0.f, 0.f, 0.f, 0.f, 0.f, 0.f, 0.f, 0.f, 0.f};
#pragma unroll
                for (int kd = 0; kd < 4; ++kd) z = __builtin_amdgcn_mfma_f32_32x32x16_bf16(kfn[kd], qf[kd], z, 0, 0, 0);
                { const int sn = kt > 0 ? s0 - 32 : s0;
                  const bf16_t* kp = Kb + (size_t)(b * SEQ + sn + c32) * D + h * 64 + 8 * hf;
#pragma unroll
                  for (int kd = 0; kd < 4; ++kd) kfn[kd] = *(const bf16x8*)(kp + 16 * kd); }
                bf16x8 vf[2][2];
#pragma unroll
                for (int db = 0; db < 2; ++db)
#pragma unroll
                    for (int ks = 0; ks < 2; ++ks) { const bf16_t* vp = vtb + (size_t)(db * 32 + c32) * SEQ + s0 + 16 * ks + 4 * hf;
                        const u32x2 a = *(const u32x2*)vp, c = *(const u32x2*)(vp + 8); vf[db][ks] = __builtin_bit_cast(bf16x8, (u32x4){a.x, a.y, c.x, c.y}); }
                float L[16], lg[16];
                const bool diag = (kt == qb);
#pragma unroll
                for (int r = 0; r < 16; ++r) { const float zz = z[r]; const float sp = fmaxf(zz, 0.f) + __logf(1.0f + __expf(-fabsf(zz)));
                    const int sl = 8 * (r >> 2) + 4 * hf + (r & 3); const bool valid = !diag || (sl < c32);
                    L[r] = valid ? -sp : 0.f; lg[r] = valid ? zz - sp : -1e30f; }
                float bs[4], pbs[4];
#pragma unroll
                for (int q = 0; q < 4; ++q) { bs[q] = (L[4 * q] + L[4 * q + 1]) + (L[4 * q + 2] + L[4 * q + 3]); pbs[q] = __shfl_xor(bs[q], 32); }
                float after = R; float att[16];
#pragma unroll
                for (int q = 3; q >= 0; --q) {
                    const float off = after + (hf == 0 ? pbs[q] : 0.f);
                    const float e3 = off, e2 = e3 + L[4 * q + 3], e1 = e2 + L[4 * q + 2], e0 = e1 + L[4 * q + 1];
                    att[4 * q + 3] = __expf(lg[4 * q + 3] + e3); att[4 * q + 2] = __expf(lg[4 * q + 2] + e2); att[4 * q + 1] = __expf(lg[4 * q + 1] + e1); att[4 * q] = __expf(lg[4 * q] + e0);
                    after += bs[q] + pbs[q];
                }
                R = after;
#pragma unroll
                for (int ks = 0; ks < 2; ++ks) {
                    const bf16x8 pf = __builtin_bit_cast(bf16x8, (u32x4){cvt_pk_bf16(att[8 * ks], att[8 * ks + 1]), cvt_pk_bf16(att[8 * ks + 2], att[8 * ks + 3]), cvt_pk_bf16(att[8 * ks + 4], att[8 * ks + 5]), cvt_pk_bf16(att[8 * ks + 6], att[8 * ks + 7])});
                    o0 = __builtin_amdgcn_mfma_f32_32x32x16_bf16(vf[0][ks], pf, o0, 0, 0, 0); o1 = __builtin_amdgcn_mfma_f32_32x32x16_bf16(vf[1][ks], pf, o1, 0, 0, 0); }
                if (__all(R < -120.0f)) break;
            }
            bf16_t* op = O + (size_t)(b * SEQ + t0 + c32) * D + h * 64 + 4 * hf;
#pragma unroll
            for (int q = 0; q < 4; ++q) {
                u32x2 w0; w0.x = cvt_pk_bf16(o0[4 * q], o0[4 * q + 1]); w0.y = cvt_pk_bf16(o0[4 * q + 2], o0[4 * q + 3]); *(u32x2*)(op + 8 * q) = w0;
                u32x2 w1; w1.x = cvt_pk_bf16(o1[4 * q], o1[4 * q + 1]); w1.y = cvt_pk_bf16(o1[4 * q + 2], o1[4 * q + 3]); *(u32x2*)(op + 32 + 8 * q) = w1; }
        }
    }
}


__global__ void __launch_bounds__(NTHREADS, 2) fwd_megakernel(Params P) {
    extern __shared__ __attribute__((aligned(16))) unsigned char lds_raw[];
    LAS unsigned char* lds = (LAS unsigned char*)lds_raw;
    cg::grid_group grid = cg::this_grid();
    unsigned char* ws = P.ws;
    bf16_t* HN = (bf16_t*)(ws + WS_HN);
    bf16_t* B0 = (bf16_t*)(ws + WS_BIG); bf16_t* B1 = (bf16_t*)(ws + WS_BIG + ACT); bf16_t* B2 = (bf16_t*)(ws + WS_BIG + 2 * ACT); bf16_t* B3 = (bf16_t*)(ws + WS_BIG + 3 * ACT); bf16_t* B4 = (bf16_t*)(ws + WS_BIG + 4 * ACT);
    float* RAW = (float*)(ws + WS_RAW);
    float* X = P.out;
    const int G = gridDim.x, bx = blockIdx.x;
    pg8::StaticOrder S;
    volatile LAS unsigned* MISC = (volatile LAS unsigned*)(lds + MISC_OFF);
    if (threadIdx.x < 2) MISC[threadIdx.x] = 0u;
    __syncthreads();
    const XcdBarrier bar = xcd_barrier_post((unsigned*)ws, MISC);
    grid.sync();
#define SYNC() xcd_barrier(bar)

    weights_phase(P, lds);
    rmsnorm_phase(P.in[0], P.in[1], HN);
    SYNC();
#define FFN_BLOCK(layer, LASTSYNC) do { \
        rmsnorm_phase(X, P.in[2] + (layer) * D, HN); \
        SYNC(); \
        const float* cw = P.in[30] + (size_t)(layer) * 3 * F2; const float* cb = P.in[31] + (size_t)(layer) * F2; \
        { pg8::Gemm g{HN, (const bf16_t*)(ws + WS_WF1) + (size_t)(layer) * F2 * D, T, F2, 1024, D, D, 0, 0}; S.init(T, F2, G, bx); \
          EpiFfn1 E{B0, cw, cb, RAW, (LAS float*)(lds + XCH_OFF)}; pg8::gemm_phase(lds, g, S, E); } \
        SYNC(); \
        { pg8::Gemm g{B0, (const bf16_t*)(ws + WS_WF2) + (size_t)(layer) * D * FH, T, 1024, FH, FH, FH, 0, 0}; S.init(T, 1024, G, bx); \
          { Unit fu; int lastpm = -1; for (int i = 0; S.next(i, fu); ++i) if (fu.pm != lastpm) { ffn_fix_panel(RAW, cw, cb, B0, fu.pm); lastpm = fu.pm; } } \
          asm volatile("s_waitcnt vmcnt(0)" ::: "memory"); __syncthreads(); \
          EpiRes E{X, X, nullptr, nullptr}; pg8::gemm_phase(lds, g, S, E); } \
        if (LASTSYNC) SYNC(); } while (0)

    pool_phase(HN, B0);
    SYNC();
    { pg8::Gemm g{B0, (const bf16_t*)(ws + WS_WPOOL), T, 1024, 256, D, 256, 0, 512}; S.init(T, 1024, G, bx);
      EpiRes E{P.in[0], X, P.in[5], P.in[4]}; pg8::gemm_phase(lds, g, S, E); }
    SYNC();
    FFN_BLOCK(0, true);
    rmsnorm_phase(X, P.in[1] + 1 * D, HN);
    SYNC();
    s5_phase(P, HN, B0, lds);
    SYNC();
    { pg8::Gemm g{B0, (const bf16_t*)(ws + WS_WS5), T, 2048, 1024, D, D, 0, 0}; S.init(T, 2048, G, bx);
      EpiGateRes E{X, P.in[15]}; pg8::gemm_phase(lds, g, S, E); }
    SYNC();
    FFN_BLOCK(1, true);
    rmsnorm_phase(X, P.in[1] + 2 * D, HN);
    SYNC();
    { pg8::Gemm g{HN, (const bf16_t*)(ws + WS_WLIN), T, 2048, 1024, D, D, 0, 0}; S.init(T, 2048, G, bx);
      EpiLruIn E{B0, B1}; pg8::gemm_phase(lds, g, S, E); }
    SYNC();
    lruconv_phase(B1, P.in[17], P.in[18], B2);
    SYNC();
    { pg8::Gemm g{B2, (const bf16_t*)(ws + WS_WGATE), T, 2048, 256, D, 256, 1, 512}; S.init(T, 2048, G, bx);
      EpiGates E{B2, B3, B4, P.in[20], P.in[22], P.in[23]}; pg8::gemm_phase(lds, g, S, E); }
    SYNC();
    lruscan_phase(B3, B4, B0, lds);
    SYNC();
    { pg8::Gemm g{B0, (const bf16_t*)(ws + WS_WLOUT), T, 1024, 1024, D, D, 0, 0}; S.init(T, 1024, G, bx);
      EpiRes E{X, X, nullptr, nullptr}; pg8::gemm_phase(lds, g, S, E); }
    SYNC();
    FFN_BLOCK(2, true);
    rmsnorm_phase(X, P.in[1] + 3 * D, HN);
    SYNC();
    { pg8::Gemm g{HN, (const bf16_t*)(ws + WS_WQKV), T, 3072, 1024, D, D, 0, 0}; S.init(T, 3072, G, bx);
      EpiQKV E{B0, P.in[26], P.in[27]}; pg8::gemm_phase(lds, g, S, E); }
    SYNC();
    attn_phase(B0, B1, B2, B3, B4, lds);
    SYNC();
    { pg8::Gemm g{B4, (const bf16_t*)(ws + WS_WWO), T, 1024, 1024, D, D, 0, 0}; S.init(T, 1024, G, bx);
      EpiRes E{X, X, nullptr, nullptr}; pg8::gemm_phase(lds, g, S, E); }
    SYNC();
    FFN_BLOCK(3, false);
}

extern "C" void kernel_launch(void* const* d_in, const int* in_sizes, int n_in, void* d_out, int out_size, void* d_ws, size_t ws_size, hipStream_t stream) {
    static int grid = 0;
    if (grid == 0) {
        if (n_in != 33 || out_size != T * D || ws_size < WS_END) { fprintf(stderr, "kernel_launch: unexpected shapes (n_in %d out %d ws %zu)\n", n_in, out_size, ws_size); grid = -1; return; }
        int dev = 0, cus = 0, per_cu = 0;
        (void)hipGetDevice(&dev); (void)hipDeviceGetAttribute(&cus, hipDeviceAttributeMultiprocessorCount, dev);
        if (hipFuncSetAttribute((const void*)fwd_megakernel, hipFuncAttributeMaxDynamicSharedMemorySize, LDS_BYTES) != hipSuccess) { fprintf(stderr, "kernel_launch: hipFuncSetAttribute failed\n"); grid = -1; return; }
        (void)hipOccupancyMaxActiveBlocksPerMultiprocessor(&per_cu, (const void*)fwd_megakernel, NTHREADS, LDS_BYTES);
        (void)hipGetLastError();
        if (per_cu < 1) per_cu = 1;
        grid = cus * per_cu;
        if (grid > 256) grid = 256;
    }
    if (grid < 0) return;
    Params p; memset(&p, 0, sizeof(p));
    for (int i = 0; i < 33; ++i) p.in[i] = (const float*)d_in[i];
    p.out = (float*)d_out; p.ws = (unsigned char*)d_ws;
    unsigned char* ws = (unsigned char*)d_ws;
    int nj = 0, items = 0;
    auto add = [&](const float* src, bf16_t* dst, int K, int ld, int nrows, int map, int hh) {
        Job& j = p.jobs[nj++]; j.src = src; j.dst = dst; j.K = K; j.ld = ld; j.nrows = nrows; j.map = map; j.hh = hh; j.item0 = items; items += (K / 64) * (nrows / 32); };
    for (int l = 0; l < 4; ++l) add(p.in[29] + (size_t)l * D * F2, (bf16_t*)(ws + WS_WF1) + (size_t)l * F2 * D, 1024, F2, F2, 1, FH);
    for (int l = 0; l < 4; ++l) add(p.in[32] + (size_t)l * FH * D, (bf16_t*)(ws + WS_WF2) + (size_t)l * D * FH, FH, D, D, 0, 0);
    for (int gI = 0; gI < 4; ++gI) add(p.in[3] + (size_t)gI * 65536, (bf16_t*)(ws + WS_WPOOL) + (size_t)gI * 65536, 256, 256, 256, 0, 0);
    add(p.in[14], (bf16_t*)(ws + WS_WS5), 1024, 2048, 2048, 1, 1024);
    add(p.in[16], (bf16_t*)(ws + WS_WLIN), 1024, 2048, 2048, 0, 0);
    for (int pn = 0; pn < 8; ++pn) for (int bj = 0; bj < 2; ++bj)
        add((bj ? p.in[21] : p.in[19]) + (size_t)(pn >> 1) * 65536 + (pn & 1) * 128, (bf16_t*)(ws + WS_WGATE) + (size_t)(pn * 256 + bj * 128) * 256, 256, 256, 128, 0, 0);
    add(p.in[24], (bf16_t*)(ws + WS_WLOUT), 1024, 1024, 1024, 0, 0);
    add(p.in[25], (bf16_t*)(ws + WS_WQKV), 1024, 3072, 3072, 2, 0);
    add(p.in[28], (bf16_t*)(ws + WS_WWO), 1024, 1024, 1024, 0, 0);
    p.nitems = items;
    if (hipMemsetAsync(d_ws, 0, 16384, stream) != hipSuccess) { fprintf(stderr, "kernel_launch: memset failed\n"); return; }
    void* args[] = {&p};
    hipError_t e = hipLaunchCooperativeKernel((const void*)fwd_megakernel, dim3(grid), dim3(NTHREADS), args, LDS_BYTES, stream);
    if (e != hipSuccess) fprintf(stderr, "cooperative launch failed: %s (grid %d)\n", hipGetErrorString(e), grid);
}
```

```cpp
#include <hip/hip_runtime.h>
#include <hip/hip_cooperative_groups.h>
#include <cstdio>
#include <cstring>
namespace cg = cooperative_groups;

#define LAS __attribute__((address_space(3)))
typedef unsigned short bf16_t;
typedef short bf16x8 __attribute__((ext_vector_type(8)));
typedef short bf16x4 __attribute__((ext_vector_type(4)));
typedef float f32x4 __attribute__((ext_vector_type(4)));
typedef float f32x16 __attribute__((ext_vector_type(16)));
typedef unsigned u32x4 __attribute__((ext_vector_type(4)));
typedef unsigned u32x2 __attribute__((ext_vector_type(2)));

constexpr int T = 32768, D = 1024, SEQ = 2048, FH = 2816, F2 = 5632;
constexpr int NTHREADS = 512;
constexpr int LDS_BYTES = 147456;
constexpr int XCH_OFF = 131072, MISC_OFF = 131072 + 8192;
constexpr size_t MiB = 1u << 20;
constexpr size_t WS_WPOOL = 1 * MiB, WS_WS5 = 2 * MiB, WS_WLIN = 6 * MiB, WS_WGATE = 10 * MiB, WS_WLOUT = 11 * MiB,
                 WS_WQKV = 13 * MiB, WS_WWO = 19 * MiB, WS_WF1 = 21 * MiB, WS_WF2 = 65 * MiB,
                 WS_HN = 96 * MiB, WS_BIG = 160 * MiB, WS_RAW = 480 * MiB, WS_END = 492 * MiB;
constexpr size_t ACT = 64 * MiB;

typedef __bf16 bf16v2_t __attribute__((ext_vector_type(2)));
__device__ __forceinline__ unsigned cvt_pk_bf16(float lo, float hi) { const bf16v2_t v = {(__bf16)lo, (__bf16)hi}; return __builtin_bit_cast(unsigned, v); }
__device__ __forceinline__ float bf2f(unsigned short b) { return __uint_as_float(((unsigned)b) << 16); }
__device__ __forceinline__ float bflo(unsigned w) { return __uint_as_float(w << 16); }
__device__ __forceinline__ float bfhi(unsigned w) { return __uint_as_float(w & 0xffff0000u); }
__device__ __forceinline__ float sigmoidf_(float x) { return __builtin_amdgcn_rcpf(1.0f + __expf(-x)); }
__device__ __forceinline__ float gelu_tanh(float x) { const float k = 1.5957691216f * (x + 0.044715f * x * x * x); return x * __builtin_amdgcn_rcpf(1.0f + __expf(-k)); }
__device__ __forceinline__ float wave_sum(float v) {
#pragma unroll
    for (int o = 1; o < 64; o <<= 1) v += __shfl_xor(v, o);
    return v;
}
__device__ __forceinline__ int otid() { int t = threadIdx.x; asm volatile("" : "+v"(t)); return t; }
template <int CTRL> __device__ __forceinline__ float dpp_upd(float old, float src) {
    return __int_as_float(__builtin_amdgcn_update_dpp(__float_as_int(old), __float_as_int(src), CTRL, 0xf, 0xf, false));
}
template <int CTRL> __device__ __forceinline__ float dpp0(float src) { return __int_as_float(__builtin_amdgcn_update_dpp(0, __float_as_int(src), CTRL, 0xf, 0xf, true)); }
__device__ __forceinline__ void conv_taps(float& h, float cur, float prev, float w1, float w0) {
    asm("s_nop 1\n\t"
        "v_fmac_f32_dpp %0, %1, %3 row_shr:1 row_mask:0xf bank_mask:0xf bound_ctrl:1\n\t"
        "v_fmac_f32_dpp %0, %1, %4 row_shr:2 row_mask:0xf bank_mask:0xf bound_ctrl:1\n\t"
        "v_fmac_f32_dpp %0, %2, %3 row_shl:15 row_mask:0xf bank_mask:0xf bound_ctrl:1\n\t"
        "v_fmac_f32_dpp %0, %2, %4 row_shl:14 row_mask:0xf bank_mask:0xf bound_ctrl:1"
        : "+v"(h) : "v"(cur), "v"(prev), "v"(w1), "v"(w0));
}
__device__ __forceinline__ float prev1(float prev, float cur) { const float t = dpp_upd<0x121>(0.f, prev); return dpp_upd<0x111>(t, cur); }
__device__ __forceinline__ float prev2(float prev, float cur) { const float t = dpp_upd<0x122>(0.f, prev); return dpp_upd<0x112>(t, cur); }

namespace pg8 {
constexpr int BM = 256, BK = 64, HALF = 128, HTB = HALF * BK * 2, STAGE_BYTES = 8 * HTB, NXCD = 8, WGM = 8;
__host__ __device__ __forceinline__ int lds_byte(int r, int c) { const int st = (r >> 4) * 2 + (c >> 5), rr = r & 15, cc = c & 31, ob = rr * 64 + cc * 2; return st * 1024 + (ob ^ (((ob >> 9) & 1) << 5)); }
__host__ __device__ __forceinline__ void stage_rc(int b, int& R, int& C) { const int st = b / 1024, sb = b % 1024, swz = sb ^ (((sb >> 9) & 1) << 5); R = (st >> 1) * 16 + swz / 64; C = (st & 1) * 32 + (swz % 64) / 2; }
__host__ __device__ __forceinline__ int perm32(int rho) { const int n = rho >> 4, i = rho & 15; return 8 * (i >> 2) + 4 * n + (i & 3); }
struct Unit { int pm, pn; };
struct Gemm { const bf16_t* A; const bf16_t* Bt; int M, N, K, lda, ldb, a_shift, a_step; };
struct StaticOrder {
    int nM, nN, nwg, G, c;
    __device__ __forceinline__ void init(int M, int N, int G_, int c_) { nM = M / BM; nN = N / BM; nwg = nM * nN; G = G_; c = c_; }
    __device__ __forceinline__ bool next(int i, Unit& u) const {
        const long L = (long)i * G + c; if (L >= nwg) return false;
        int wgid = (int)L; { const int q = nwg / NXCD, r = nwg % NXCD, xcd = wgid % NXCD, off = wgid / NXCD; wgid = (xcd < r ? xcd * (q + 1) : r * (q + 1) + (xcd - r) * q) + off; }
        const int nig = WGM * nN, gid = wgid / nig, fm = gid * WGM, gsz = (nM - fm) < WGM ? (nM - fm) : WGM;
        u.pm = fm + ((wgid % nig) % gsz); u.pn = (wgid % nig) / gsz; return true;
    }
};
template <class Epi>
__device__ __forceinline__ void gemm_phase(LAS unsigned char* lds, const Gemm g, const StaticOrder& S, const Epi& E) {
    int tid_ = threadIdx.x; asm volatile("" : "+v"(tid_));
    const int tid = tid_, wid = __builtin_amdgcn_readfirstlane(tid >> 6), lane = tid & 63, wr = wid >> 2, wc = wid & 3, fr = lane & 15, fq = lane >> 4;
    const int K = g.K, nt = K / BK;
    unsigned voffA[2], voffB[2];
#pragma unroll
    for (int i = 0; i < 2; ++i) { int R, C; stage_rc(tid * 16 + i * 8192, R, C); const int Rb = Epi::PERM ? ((R & ~31) + perm32(R & 31)) : R;
        voffA[i] = (unsigned)(R * g.lda + C) * 2u; voffB[i] = (unsigned)(Rb * g.ldb + C) * 2u; }
    const size_t kstep = (size_t)(BK * 2);
    const size_t hstepA = (size_t)HALF * g.lda * 2, hstepB = (size_t)HALF * g.ldb * 2;
    const size_t tstepA = 2 * hstepA, tstepB = 2 * hstepB;
    const unsigned ldsw = (unsigned)wid * 1024u;
    const int aoff = lds_byte(wr * 64 + fr, fq * 8), boff = lds_byte(wc * 32 + fr, fq * 8);
#define PG8_SA(b, h) (((b) * 2 + (h)) * HTB)
#define PG8_SB(b, h) ((4 + (b) * 2 + (h)) * HTB)
#define PG8_STAGE(bufoff, gbase, voff) do { _Pragma("unroll") for (int _i = 0; _i < 2; ++_i) \
        __builtin_amdgcn_global_load_lds((const unsigned*)((const char*)(gbase) + (voff)[_i]), (LAS unsigned*)(lds + (bufoff) + ldsw + _i * 8192), 16, 0, 0); } while (0)
#define PG8_LDA(dst, b, h) do { _Pragma("unroll") for (int m = 0; m < 4; ++m) _Pragma("unroll") for (int k = 0; k < 2; ++k) dst[m][k] = *(const LAS bf16x8*)(lds + PG8_SA(b, h) + aoff + m * 2048 + k * 1024); } while (0)
#define PG8_LDB(dst, b, h) do { _Pragma("unroll") for (int n = 0; n < 2; ++n) _Pragma("unroll") for (int k = 0; k < 2; ++k) dst[n][k] = *(const LAS bf16x8*)(lds + PG8_SB(b, h) + boff + n * 2048 + k * 1024); } while (0)
#define PG8_MMA(ai, bj, At, Bt) do { __builtin_amdgcn_s_setprio(1); _Pragma("unroll") for (int m = 0; m < 4; ++m) _Pragma("unroll") for (int n = 0; n < 2; ++n) _Pragma("unroll") for (int k = 0; k < 2; ++k) \
        acc[ai][bj][m][n] = __builtin_amdgcn_mfma_f32_16x16x32_bf16(Bt[n][k], At[m][k], acc[ai][bj][m][n], 0, 0, 0); __builtin_amdgcn_s_setprio(0); } while (0)
#define PG8_WAIT_V(n) asm volatile("s_waitcnt vmcnt(" #n ")" ::: "memory")
#define PG8_WAIT_L(n) asm volatile("s_waitcnt lgkmcnt(" #n ")" ::: "memory")
#define PG8_BAR __builtin_amdgcn_s_barrier()
#define PG8_SCHED __builtin_amdgcn_sched_barrier(0)
    Unit cur, nxt; int ui = 0;
    if (!S.next(0, cur)) return;
    f32x4 acc[2][2][4][2];
    {
#pragma unroll
    for (int a = 0; a < 2; ++a)
#pragma unroll
        for (int b = 0; b < 2; ++b)
#pragma unroll
            for (int m = 0; m < 4; ++m)
#pragma unroll
                for (int n = 0; n < 2; ++n) acc[a][b][m][n] = (f32x4){0.f, 0.f, 0.f, 0.f};
    }
    bf16x8 At[4][2], B0[2][2], B1[2][2];
    const char* cA = (const char*)g.A + (size_t)cur.pm * tstepA + (size_t)(cur.pn >> g.a_shift) * g.a_step; const char* cB = (const char*)g.Bt + (size_t)cur.pn * tstepB;
    PG8_STAGE(PG8_SB(0, 0), cB, voffB); PG8_STAGE(PG8_SA(0, 0), cA, voffA); PG8_STAGE(PG8_SB(0, 1), cB + hstepB, voffB); PG8_STAGE(PG8_SA(0, 1), cA + hstepA, voffA);
    if (wr == 1) PG8_BAR;
    PG8_WAIT_V(4); PG8_BAR;
    PG8_STAGE(PG8_SB(1, 0), cB + kstep, voffB); PG8_STAGE(PG8_SA(1, 0), cA + kstep, voffA); PG8_STAGE(PG8_SB(1, 1), cB + hstepB + kstep, voffB);
    PG8_WAIT_V(6); PG8_BAR;
    for (;;) {
        const bool has_next = S.next(ui + 1, nxt);
        const char* nA = has_next ? (const char*)g.A + (size_t)nxt.pm * tstepA + (size_t)(nxt.pn >> g.a_shift) * g.a_step : cA; const char* nB = has_next ? (const char*)g.Bt + (size_t)nxt.pn * tstepB : cB;
        for (int t = 0; t < nt; t += 2) {
            const bool last = (t == nt - 2);
            const char* a1 = cA + (size_t)(t + 1) * kstep;
            const char* a2 = last ? nA : cA + (size_t)(t + 2) * kstep; const char* b2 = last ? nB : cB + (size_t)(t + 2) * kstep;
            const char* a3 = a2 + kstep; const char* b3 = b2 + kstep;
            PG8_LDB(B0, 0, 0); PG8_SCHED; PG8_LDA(At, 0, 0); PG8_STAGE(PG8_SA(1, 1), a1 + hstepA, voffA);
            PG8_WAIT_L(8); PG8_BAR; PG8_WAIT_L(0); PG8_MMA(0, 0, At, B0); PG8_BAR; PG8_SCHED;
            PG8_LDB(B1, 0, 1); PG8_STAGE(PG8_SB(0, 0), b2, voffB);
            PG8_BAR; PG8_WAIT_L(0); PG8_MMA(0, 1, At, B1); PG8_BAR;
            PG8_LDA(At, 0, 1); PG8_STAGE(PG8_SA(0, 0), a2, voffA);
            PG8_BAR; PG8_WAIT_L(0); PG8_MMA(1, 0, At, B0); PG8_BAR; PG8_SCHED;
            PG8_STAGE(PG8_SB(0, 1), b2 + hstepB, voffB);
            PG8_WAIT_V(6); PG8_BAR; PG8_MMA(1, 1, At, B1); PG8_BAR;
            PG8_LDB(B0, 1, 0); PG8_SCHED; PG8_LDA(At, 1, 0); PG8_STAGE(PG8_SA(0, 1), a2 + hstepA, voffA);
            PG8_WAIT_L(8); PG8_BAR; PG8_WAIT_L(0); PG8_MMA(0, 0, At, B0); PG8_BAR; PG8_SCHED;
            PG8_LDB(B1, 1, 1); PG8_STAGE(PG8_SB(1, 0), b3, voffB);
            PG8_BAR; PG8_WAIT_L(0); PG8_MMA(0, 1, At, B1); PG8_BAR;
            PG8_LDA(At, 1, 1); PG8_STAGE(PG8_SA(1, 0), a3, voffA);
            PG8_BAR; PG8_WAIT_L(0); PG8_MMA(1, 0, At, B0); PG8_BAR; PG8_SCHED;
            PG8_STAGE(PG8_SB(1, 1), b3 + hstepB, voffB);
            PG8_WAIT_V(6); PG8_BAR; PG8_MMA(1, 1, At, B1); PG8_BAR;
        }
        E(acc, cur, wr, wc, fr, fq);
        if (!has_next) break;
        {
#pragma unroll
        for (int a = 0; a < 2; ++a)
#pragma unroll
            for (int b = 0; b < 2; ++b)
#pragma unroll
                for (int m = 0; m < 4; ++m)
#pragma unroll
                    for (int n = 0; n < 2; ++n) acc[a][b][m][n] = (f32x4){0.f, 0.f, 0.f, 0.f};
        }
        cur = nxt; cA = nA; cB = nB; ++ui;
    }
    PG8_WAIT_V(0);
    if (wr == 0) PG8_BAR;
    PG8_BAR;
#undef PG8_SA
#undef PG8_SB
#undef PG8_STAGE
#undef PG8_LDA
#undef PG8_LDB
#undef PG8_MMA
#undef PG8_WAIT_V
#undef PG8_WAIT_L
#undef PG8_BAR
#undef PG8_SCHED
}
}
using pg8::Unit;
typedef const f32x4 (&AccRef)[2][2][4][2];

struct EpiRes {
    static constexpr bool PERM = false;
    const float* base; float* out; const float* scale; const float* bias;
    __device__ __forceinline__ void operator()(AccRef acc, const Unit& u, int wr, int wc, int fr, int fq) const {
        const int row0 = u.pm * 256 + wr * 64 + fr, col0 = u.pn * 256 + wc * 32 + 4 * fq;
        f32x4 sv[2][2], bv[2][2];
#pragma unroll
        for (int bj = 0; bj < 2; ++bj)
#pragma unroll
            for (int n = 0; n < 2; ++n) {
                sv[bj][n] = scale ? *(const f32x4*)(scale + col0 + bj * 128 + n * 16) : (f32x4){1.f, 1.f, 1.f, 1.f};
                bv[bj][n] = bias ? *(const f32x4*)(bias + col0 + bj * 128 + n * 16) : (f32x4){0.f, 0.f, 0.f, 0.f}; }
#pragma unroll
        for (int ai = 0; ai < 2; ++ai)
#pragma unroll
            for (int mh = 0; mh < 2; ++mh) {
                f32x4 bs[2][2][2];
#pragma unroll
                for (int m = 0; m < 2; ++m)
#pragma unroll
                    for (int bj = 0; bj < 2; ++bj)
#pragma unroll
                        for (int n = 0; n < 2; ++n) bs[m][bj][n] = *(const f32x4*)(base + (size_t)(row0 + ai * 128 + (2 * mh + m) * 16) * D + col0 + bj * 128 + n * 16);
#pragma unroll
                for (int m = 0; m < 2; ++m)
#pragma unroll
                    for (int bj = 0; bj < 2; ++bj)
#pragma unroll
                        for (int n = 0; n < 2; ++n) *(f32x4*)(out + (size_t)(row0 + ai * 128 + (2 * mh + m) * 16) * D + col0 + bj * 128 + n * 16) = bs[m][bj][n] + sv[bj][n] * (acc[ai][bj][2 * mh + m][n] + bv[bj][n]);
                asm volatile("" ::: "memory"); }
    }
};
struct EpiGateRes {
    static constexpr bool PERM = true;
    float* x; const float* bias;
    __device__ __forceinline__ void operator()(AccRef acc, const Unit& u, int wr, int wc, int fr, int fq) const {
        const int row0 = u.pm * 256 + wr * 64 + fr, col0 = u.pn * 128 + wc * 32 + 8 * fq;
        f32x4 bv[2], bg[2];
#pragma unroll
        for (int n = 0; n < 2; ++n) { bv[n] = *(const f32x4*)(bias + col0 + 4 * n); bg[n] = *(const f32x4*)(bias + D + col0 + 4 * n); }
#pragma unroll
        for (int ai = 0; ai < 2; ++ai) {
            f32x4 xs[4][2];
#pragma unroll
            for (int m = 0; m < 4; ++m)
#pragma unroll
                for (int n = 0; n < 2; ++n) xs[m][n] = *(const f32x4*)(x + (size_t)(row0 + ai * 128 + m * 16) * D + col0 + 4 * n);
#pragma unroll
            for (int m = 0; m < 4; ++m)
#pragma unroll
                for (int n = 0; n < 2; ++n) { f32x4 xv = xs[m][n]; const f32x4 v = acc[ai][0][m][n] + bv[n], gt = acc[ai][1][m][n] + bg[n];
#pragma unroll
                    for (int j = 0; j < 4; ++j) xv[j] += v[j] * sigmoidf_(gt[j]);
                    *(f32x4*)(x + (size_t)(row0 + ai * 128 + m * 16) * D + col0 + 4 * n) = xv; }
            asm volatile("" ::: "memory"); }
    }
};
struct EpiLruIn {
    static constexpr bool PERM = true;
    bf16_t* GG; bf16_t* RP;
    __device__ __forceinline__ void operator()(AccRef acc, const Unit& u, int wr, int wc, int fr, int fq) const {
        const int row0 = u.pm * 256 + wr * 64 + fr; const bool isg = u.pn < 4;
        bf16_t* dst = isg ? GG : RP; const int col0 = (u.pn & 3) * 256 + wc * 32 + 8 * fq;
#pragma unroll
        for (int ai = 0; ai < 2; ++ai)
#pragma unroll
            for (int m = 0; m < 4; ++m) { bf16_t* rp = dst + (size_t)(row0 + ai * 128 + m * 16) * D + col0;
#pragma unroll
                for (int bj = 0; bj < 2; ++bj) { f32x4 v0 = acc[ai][bj][m][0], v1 = acc[ai][bj][m][1];
                    if (isg) {
#pragma unroll
                        for (int j = 0; j < 4; ++j) { v0[j] = gelu_tanh(v0[j]); v1[j] = gelu_tanh(v1[j]); } }
                    u32x4 w; w.x = cvt_pk_bf16(v0[0], v0[1]); w.y = cvt_pk_bf16(v0[2], v0[3]); w.z = cvt_pk_bf16(v1[0], v1[1]); w.w = cvt_pk_bf16(v1[2], v1[3]);
                    *(u32x4*)(rp + bj * 128) = w; } }
    }
};
struct EpiGates {
    static constexpr bool PERM = true;
    const bf16_t* REC; bf16_t* LA; bf16_t* BV; const float* b_a; const float* b_x; const float* lam;
    __device__ __forceinline__ void operator()(AccRef acc, const Unit& u, int wr, int wc, int fr, int fq) const {
        const int row0 = u.pm * 256 + wr * 64 + fr, col0 = u.pn * 128 + wc * 32 + 8 * fq;
        u32x4 rws[2][4];
#pragma unroll
        for (int ai = 0; ai < 2; ++ai)
#pragma unroll
            for (int m = 0; m < 4; ++m) rws[ai][m] = *(const u32x4*)(REC + (size_t)(row0 + ai * 128 + m * 16) * D + col0);
#pragma unroll
        for (int n = 0; n < 2; ++n) {
            const f32x4 ba = *(const f32x4*)(b_a + col0 + 4 * n), bx = *(const f32x4*)(b_x + col0 + 4 * n), l = *(const f32x4*)(lam + col0 + 4 * n);
            f32x4 k8;
#pragma unroll
            for (int j = 0; j < 4; ++j) k8[j] = -8.0f * __logf(1.0f + __expf(-l[j]));
#pragma unroll
            for (int ai = 0; ai < 2; ++ai)
#pragma unroll
                for (int m = 0; m < 4; ++m) { const size_t off = (size_t)(row0 + ai * 128 + m * 16) * D + col0 + 4 * n;
                    float lo[4], bo[4];
#pragma unroll
                    for (int j = 0; j < 4; ++j) { const unsigned w = rws[ai][m][2 * n + (j >> 1)]; const float rec = (j & 1) ? bfhi(w) : bflo(w);
                        const float r = sigmoidf_(acc[ai][0][m][n][j] + ba[j]), ig = sigmoidf_(acc[ai][1][m][n][j] + bx[j]);
                        const float la = k8[j] * r; const float mult = __builtin_sqrtf(1.0f - __expf(2.0f * la));
                        lo[j] = la; bo[j] = mult * ig * rec; }
                    *(u32x2*)(LA + off) = (u32x2){cvt_pk_bf16(lo[0], lo[1]), cvt_pk_bf16(lo[2], lo[3])}; *(u32x2*)(BV + off) = (u32x2){cvt_pk_bf16(bo[0], bo[1]), cvt_pk_bf16(bo[2], bo[3])}; }
        }
    }
};
struct EpiQKV {
    static constexpr bool PERM = true;
    bf16_t* QKV; const float* qg; const float* kg;
    __device__ __forceinline__ void operator()(AccRef acc, const Unit& u, int wr, int wc, int fr, int fq) const {
        const int which = u.pn >> 2, row0 = u.pm * 256 + wr * 64 + fr, col0 = (u.pn & 3) * 256 + wc * 64 + 8 * fq;
        bf16_t* dst = QKV + (size_t)which * ((size_t)T * D);
        f32x4 gv[2][2];
#pragma unroll
        for (int bj = 0; bj < 2; ++bj)
#pragma unroll
            for (int n = 0; n < 2; ++n) { const f32x4 a = *(const f32x4*)(qg + 32 * bj + 8 * fq + 4 * n), b = *(const f32x4*)(kg + 32 * bj + 8 * fq + 4 * n);
                gv[bj][n] = which == 0 ? a : (which == 1 ? b : (f32x4){1.f, 1.f, 1.f, 1.f}); }
#pragma unroll
        for (int ai = 0; ai < 2; ++ai)
#pragma unroll
            for (int m = 0; m < 4; ++m) {
                float sc = 1.0f;
                if (which < 2) { float ss = 0.f;
#pragma unroll
                    for (int bj = 0; bj < 2; ++bj)
#pragma unroll
                        for (int n = 0; n < 2; ++n) { const f32x4 v = acc[ai][bj][m][n]; ss += (v[0] * v[0] + v[1] * v[1]) + (v[2] * v[2] + v[3] * v[3]); }
                    ss += __shfl_xor(ss, 16); ss += __shfl_xor(ss, 32);
                    sc = rsqrtf(ss * (1.0f / 64.0f) + 1e-6f) * (which == 0 ? 0.125f : 1.0f); }
                bf16_t* rp = dst + (size_t)(row0 + ai * 128 + m * 16) * D + col0;
#pragma unroll
                for (int bj = 0; bj < 2; ++bj) { const f32x4 v0 = acc[ai][bj][m][0] * gv[bj][0] * sc, v1 = acc[ai][bj][m][1] * gv[bj][1] * sc;
                    u32x4 w; w.x = cvt_pk_bf16(v0[0], v0[1]); w.y = cvt_pk_bf16(v0[2], v0[3]); w.z = cvt_pk_bf16(v1[0], v1[1]); w.w = cvt_pk_bf16(v1[2], v1[3]);
                    *(u32x4*)(rp + bj * 32) = w; } }
    }
};
struct EpiFfn1 {
    static constexpr bool PERM = true;
    bf16_t* Aout; const float* cw; const float* cb; float* raw; LAS float* xch;
    __device__ __forceinline__ void operator()(AccRef acc, const Unit& u, int wr, int wc, int fr, int fq) const {
        const int clb = 32 * wc + 8 * fq;
        f32x4 cwv[2][8];
        { const float* cv = cw + 128 * u.pn + clb; const float* cg = cv + FH; const float* bp = cb + 128 * u.pn + clb;
          cwv[0][0] = *(const f32x4*)(cv); cwv[0][1] = *(const f32x4*)(cv + F2); cwv[0][2] = *(const f32x4*)(cv + 2 * F2); cwv[0][3] = *(const f32x4*)(bp);
          cwv[0][4] = *(const f32x4*)(cg); cwv[0][5] = *(const f32x4*)(cg + F2); cwv[0][6] = *(const f32x4*)(cg + 2 * F2); cwv[0][7] = *(const f32x4*)(bp + FH); }
        if (fr >= 14) {
#pragma unroll
            for (int ai = 0; ai < 2; ++ai)
#pragma unroll
                for (int bj = 0; bj < 2; ++bj)
#pragma unroll
                    for (int n = 0; n < 2; ++n) *(LAS f32x4*)(xch + ((ai * 2 + wr) * 2 + (fr - 14)) * 256 + bj * 128 + clb + 4 * n) = acc[ai][bj][3][n];
        }
        float* rawu = raw + (size_t)(u.pm * 22 + u.pn) * 1024;
        if (wr == 0 && fr < 2) {
#pragma unroll
            for (int bj = 0; bj < 2; ++bj)
#pragma unroll
                for (int n = 0; n < 2; ++n) *(f32x4*)(rawu + fr * 256 + bj * 128 + clb + 4 * n) = acc[0][bj][0][n];
        }
        if (wr == 1 && fr >= 14) {
#pragma unroll
            for (int bj = 0; bj < 2; ++bj)
#pragma unroll
                for (int n = 0; n < 2; ++n) *(f32x4*)(rawu + (fr - 12) * 256 + bj * 128 + clb + 4 * n) = acc[1][bj][3][n];
        }
        asm volatile("s_waitcnt lgkmcnt(0)" ::: "memory"); __builtin_amdgcn_s_barrier(); __builtin_amdgcn_s_barrier(); asm volatile("" ::: "memory");
        const int hc0 = 128 * u.pn + clb, row0 = u.pm * 256 + wr * 64 + fr;
#pragma unroll
        for (int n = 0; n < 2; ++n) {
            const f32x4 w0v = cwv[n][0], w1v = cwv[n][1], w2v = cwv[n][2], bvv = cwv[n][3], w0g = cwv[n][4], w1g = cwv[n][5], w2g = cwv[n][6], bvg = cwv[n][7];
#pragma unroll
            for (int ai = 0; ai < 2; ++ai) {
                if (n == 0 && ai == 0) {
                    asm volatile("" ::: "memory");
                    const float* cv = cw + hc0 + 4; const float* cg = cv + FH; const float* bp = cb + hc0 + 4;
                    cwv[1][0] = *(const f32x4*)(cv); cwv[1][1] = *(const f32x4*)(cv + F2); cwv[1][2] = *(const f32x4*)(cv + 2 * F2); cwv[1][3] = *(const f32x4*)(bp);
                    cwv[1][4] = *(const f32x4*)(cg); cwv[1][5] = *(const f32x4*)(cg + F2); cwv[1][6] = *(const f32x4*)(cg + 2 * F2); cwv[1][7] = *(const f32x4*)(bp + FH);
                    asm volatile("" ::: "memory"); }
                f32x4 hv = (f32x4){0.f, 0.f, 0.f, 0.f}, hg = hv;
                const int pb = ai * 2 + wr - 1;
                if (pb >= 0 && fr >= 14) { hv = *(const LAS f32x4*)(xch + (pb * 2 + (fr - 14)) * 256 + clb + 4 * n); hg = *(const LAS f32x4*)(xch + (pb * 2 + (fr - 14)) * 256 + 128 + clb + 4 * n); }
#pragma unroll
                for (int m = 0; m < 4; ++m) {
                    const f32x4 pv = m ? acc[ai][0][m ? m - 1 : 0][n] : hv, pg = m ? acc[ai][1][m ? m - 1 : 0][n] : hg;
                    const f32x4 cvv = acc[ai][0][m][n], cgg = acc[ai][1][m][n];
                    float o[4];
#pragma unroll
                    for (int j = 0; j < 4; ++j) {
                        float hval = bvv[j] + w2v[j] * cvv[j];
                        conv_taps(hval, cvv[j], pv[j], w1v[j], w0v[j]);
                        float hgat = bvg[j] + w2g[j] * cgg[j];
                        conv_taps(hgat, cgg[j], pg[j], w1g[j], w0g[j]);
                        o[j] = hgat * sigmoidf_(hgat) * hval; }
                    u32x2 w; w.x = cvt_pk_bf16(o[0], o[1]); w.y = cvt_pk_bf16(o[2], o[3]);
                    *(u32x2*)(Aout + (size_t)(row0 + ai * 128 + m * 16) * FH + hc0 + 4 * n) = w; } } }
    }
};

#define XB_TMO      128
#define XB_XCNT(j)  (256  + 64 * (j))
#define XB_XSUB(j)  (1280 + 64 * (j))
#define XB_XGEN(j)  (2304 + 64 * (j))
#define XB_TOP      3328
#define XB_TOPGEN   3392
#define XCD_BAR_WORDS 3456
#define XB_SPIN_CAP (1u << 24)
__device__ __forceinline__ unsigned xb_ld(unsigned* p)              { return __hip_atomic_load(p, __ATOMIC_RELAXED, __HIP_MEMORY_SCOPE_AGENT); }
__device__ __forceinline__ unsigned xb_add(unsigned* p, unsigned v) { return __hip_atomic_fetch_add(p, v, __ATOMIC_RELAXED, __HIP_MEMORY_SCOPE_AGENT); }
__device__ __forceinline__ unsigned xb_xcc_id() { return (unsigned)__builtin_amdgcn_s_getreg((3 << 11) | 20) & 0xFu; }
#define XB_SPIN(cond, bar) do { unsigned _sp = 0; while (cond) { __builtin_amdgcn_s_sleep(1); \
    if ((++_sp & 255u) == 0u) { if (xb_ld(&(bar)[XB_TMO])) break; if (_sp > XB_SPIN_CAP) { atomicAdd(&(bar)[XB_TMO], 1u); break; } } } } while (0)
struct XcdBarrier { unsigned* bar; unsigned x; volatile LAS unsigned* st; };
__device__ __forceinline__ XcdBarrier xcd_barrier_post(unsigned* bar, volatile LAS unsigned* st) {
    XcdBarrier b; b.bar = bar; b.x = xb_xcc_id(); b.st = st;
    if (threadIdx.x == 0) (void)xb_add(&bar[XB_XCNT(b.x)], 1u);
    return b;
}
__device__ __forceinline__ void xcd_barrier_complete(unsigned* bar, unsigned x, unsigned& nloc, unsigned& nx) {
    const unsigned G = gridDim.x * gridDim.y * gridDim.z;
    unsigned sum, cnt, mine, sp = 0u;
    for (;;) {
        sum = 0u; cnt = 0u; mine = 0u;
#pragma unroll
        for (unsigned j = 0; j < 16; ++j) { const unsigned c = xb_ld(&bar[XB_XCNT(j)]); sum += c; cnt += (c > 0u) ? 1u : 0u; mine = (j == x) ? c : mine; }
        if (sum == G) break;
        __builtin_amdgcn_s_sleep(1);
        if ((++sp & 255u) == 0u) { if (xb_ld(&bar[XB_TMO])) break; if (sp > XB_SPIN_CAP) { atomicAdd(&bar[XB_TMO], 1u); break; } }
    }
    nloc = mine > 0u ? mine : 1u; nx = cnt > 0u ? cnt : 1u;
}
__device__ __forceinline__ void xcd_barrier(const XcdBarrier& b) {
    asm volatile("s_waitcnt vmcnt(0) lgkmcnt(0)" ::: "memory");
    __syncthreads();
    if (threadIdx.x == 0) {
        unsigned* bar = b.bar;
        __builtin_amdgcn_s_waitcnt(0);
        unsigned nloc = b.st[0], nx = b.st[1];
        if (nloc == 0u) { xcd_barrier_complete(bar, b.x, nloc, nx); b.st[0] = nloc; b.st[1] = nx; }
        const unsigned old = xb_add(&bar[XB_XSUB(b.x)], 1u);
        const unsigned gen = old / nloc;
        if (old + 1u == (gen + 1u) * nloc) {
            __builtin_amdgcn_fence(__ATOMIC_RELEASE, "agent");
            asm volatile("s_waitcnt vmcnt(0)" ::: "memory");
            const unsigned og = xb_add(&bar[XB_TOP], 1u);
            const unsigned tg = og / nx;
            if (og + 1u == (tg + 1u) * nx) xb_add(&bar[XB_TOPGEN], 1u);
            else XB_SPIN(xb_ld(&bar[XB_TOPGEN]) == tg, bar);
            __builtin_amdgcn_fence(__ATOMIC_ACQUIRE, "agent");
            xb_add(&bar[XB_XGEN(b.x)], 1u);
            asm volatile("s_waitcnt vmcnt(0)" ::: "memory");
        } else {
            XB_SPIN(xb_ld(&bar[XB_XGEN(b.x)]) == gen, bar);
            __builtin_amdgcn_fence(__ATOMIC_ACQUIRE, "agent");
            asm volatile("s_waitcnt vmcnt(0)" ::: "memory");
        }
    }
    __syncthreads();
}

struct Job { const float* src; bf16_t* dst; int K, ld, nrows, map, hh, item0; };
constexpr int NJOBS = 33;
struct Params {
    const float* in[33]; float* out; unsigned char* ws;
    Job jobs[NJOBS]; int nitems; int pad;
};

__device__ __forceinline__ int map_col(int map, int hh, int j) {
    if (map == 0) return j;
    if (map == 1) { const int pn = j >> 8, bj = (j >> 7) & 1, i = j & 127; return bj * hh + 128 * pn + i; }
    const int pn = j >> 8, cl = j & 255, bj = cl >> 7, h4 = (cl & 127) >> 5, i = cl & 31; return 256 * pn + 64 * h4 + 32 * bj + i;
}

__device__ __forceinline__ void weights_phase(const Params& P, LAS unsigned char* lds) {
    const int tid__ = otid(); const int lane = tid__ & 63, wave = tid__ >> 6;
    LAS float* scr = (LAS float*)(lds + wave * 8448);
    const int gw = blockIdx.x * 8 + wave, ngw = gridDim.x * 8;
    for (int it = gw; it < P.nitems; it += ngw) {
        int ji = 0;
#pragma unroll 1
        for (int q = 1; q < NJOBS; ++q) if (it >= P.jobs[q].item0) ji = q;
        const Job jb = P.jobs[ji];
        const int r = it - jb.item0, nblk = jb.nrows / 32, kb = r / nblk, nb = r % nblk, k0 = 64 * kb, n0 = 32 * nb, c0 = map_col(jb.map, jb.hh, n0);
#pragma unroll 8
        for (int i = 0; i < 32; ++i) { const int kk = 2 * i + (lane >> 5); scr[kk * 33 + (lane & 31)] = jb.src[(size_t)(k0 + kk) * jb.ld + c0 + (lane & 31)]; }
        asm volatile("s_waitcnt lgkmcnt(0)" ::: "memory");
        const int c = lane & 7;
#pragma unroll
        for (int j = 0; j < 4; ++j) { const int n = (lane >> 3) + 8 * j; const LAS float* s = scr + (8 * c) * 33 + n;
            u32x4 o; o.x = cvt_pk_bf16(s[0 * 33], s[1 * 33]); o.y = cvt_pk_bf16(s[2 * 33], s[3 * 33]); o.z = cvt_pk_bf16(s[4 * 33], s[5 * 33]); o.w = cvt_pk_bf16(s[6 * 33], s[7 * 33]);
            *(u32x4*)(jb.dst + (size_t)(n0 + n) * jb.K + k0 + 8 * c) = o; }
        asm volatile("s_waitcnt lgkmcnt(0)" ::: "memory");
    }
}
__device__ __forceinline__ void rmsnorm_phase(const float* x, const float* g, bf16_t* hn) {
    const int tid__ = otid(); const int lane = tid__ & 63, wave = tid__ >> 6;
    const int gw = blockIdx.x * 8 + wave, ngw = gridDim.x * 8;
    f32x4 gv[4];
#pragma unroll
    for (int j = 0; j < 4; ++j) gv[j] = *((const f32x4*)g + lane + 64 * j);
    f32x4 v[4];
    if (gw < T) {
#pragma unroll
        for (int j = 0; j < 4; ++j) v[j] = ((const f32x4*)(x + (size_t)gw * D) + lane)[64 * j]; }
    for (int m = gw; m < T; m += ngw) {
        f32x4 vn[4];
        const int mn = (m + ngw < T) ? m + ngw : m;
#pragma unroll
        for (int j = 0; j < 4; ++j) vn[j] = ((const f32x4*)(x + (size_t)mn * D) + lane)[64 * j];
        float s = 0.f;
#pragma unroll
        for (int j = 0; j < 4; ++j) s += (v[j][0] * v[j][0] + v[j][1] * v[j][1]) + (v[j][2] * v[j][2] + v[j][3] * v[j][3]);
        const float rstd = rsqrtf(wave_sum(s) * (1.0f / D) + 1e-6f);
        u32x2* o = (u32x2*)(hn + (size_t)m * D) + lane;
#pragma unroll
        for (int j = 0; j < 4; ++j) { const f32x4 y = v[j] * rstd * gv[j]; u32x2 w; w.x = cvt_pk_bf16(y[0], y[1]); w.y = cvt_pk_bf16(y[2], y[3]); o[64 * j] = w; }
#pragma unroll
        for (int j = 0; j < 4; ++j) v[j] = vn[j];
    }
}
__device__ __forceinline__ void ld8(const bf16_t* p, float (&v)[8]) {
    const u32x4 w = *(const u32x4*)p;
#pragma unroll
    for (int i = 0; i < 4; ++i) { v[2 * i] = bflo(w[i]); v[2 * i + 1] = bfhi(w[i]); }
}
__device__ __forceinline__ void st8(bf16_t* p, const float (&v)[8]) {
    u32x4 w; w.x = cvt_pk_bf16(v[0], v[1]); w.y = cvt_pk_bf16(v[2], v[3]); w.z = cvt_pk_bf16(v[4], v[5]); w.w = cvt_pk_bf16(v[6], v[7]);
    *(u32x4*)p = w;
}
__device__ __forceinline__ void pool_phase(const bf16_t* hn, bf16_t* dd) {
    for (int gid = blockIdx.x * NTHREADS + otid(); gid < (T / 32) * 128; gid += gridDim.x * NTHREADS) {
        const int col8 = gid & 127, chunk = gid >> 7, w = 2 << (col8 >> 5), t0 = chunk * 32, pos0 = t0 & (SEQ - 1);
        const bf16_t* hp = hn + (size_t)t0 * D + col8 * 8; bf16_t* dp = dd + (size_t)t0 * D + col8 * 8;
        float s[8];
#pragma unroll
        for (int i = 0; i < 8; ++i) s[i] = 0.f;
        if (pos0) for (int k = 1; k <= w; ++k) { float v[8]; ld8(hp - (size_t)k * D, v);
#pragma unroll
            for (int i = 0; i < 8; ++i) s[i] += v[i]; }
        for (int i = 0; i < 32; ++i) {
            float cur[8]; ld8(hp + (size_t)i * D, cur); const int pos = pos0 + i;
#pragma unroll
            for (int q = 0; q < 8; ++q) s[q] += cur[q];
            if (pos >= w) { float v[8]; ld8(hp + (size_t)(i - w) * D, v);
#pragma unroll
                for (int q = 0; q < 8; ++q) s[q] -= v[q]; }
            const float inv = 1.0f / (float)(pos + 1 < w ? pos + 1 : w);
            float o[8];
#pragma unroll
            for (int q = 0; q < 8; ++q) o[q] = s[q] * inv - cur[q];
            st8(dp + (size_t)i * D, o);
        }
    }
}
__device__ __forceinline__ void lruconv_phase(const bf16_t* pre, const float* cw, const float* cb, bf16_t* rec) {
    for (int gid = blockIdx.x * NTHREADS + otid(); gid < (T / 32) * 128; gid += gridDim.x * NTHREADS) {
        const int col8 = gid & 127, chunk = gid >> 7, t0 = chunk * 32, pos0 = t0 & (SEQ - 1);
        const bf16_t* hp = pre + (size_t)t0 * D + col8 * 8; bf16_t* dp = rec + (size_t)t0 * D + col8 * 8;
        float w0[8], w1[8], w2[8], w3[8], bb[8], p3[8], p2[8], p1[8];
#pragma unroll
        for (int i = 0; i < 8; ++i) { w0[i] = cw[col8 * 8 + i]; w1[i] = cw[D + col8 * 8 + i]; w2[i] = cw[2 * D + col8 * 8 + i]; w3[i] = cw[3 * D + col8 * 8 + i]; bb[i] = cb[col8 * 8 + i]; p3[i] = 0.f; p2[i] = 0.f; p1[i] = 0.f; }
        if (pos0) { ld8(hp - 3 * (size_t)D, p3); ld8(hp - 2 * (size_t)D, p2); ld8(hp - (size_t)D, p1); }
        for (int i = 0; i < 32; ++i) {
            float cur[8], o[8]; ld8(hp + (size_t)i * D, cur);
#pragma unroll
            for (int q = 0; q < 8; ++q) { o[q] = bb[q] + w0[q] * p3[q] + w1[q] * p2[q] + w2[q] * p1[q] + w3[q] * cur[q]; p3[q] = p2[q]; p2[q] = p1[q]; p1[q] = cur[q]; }
            st8(dp + (size_t)i * D, o);
        }
    }
}
__device__ __forceinline__ void lruscan_phase(const bf16_t* LA, const bf16_t* BV, bf16_t* GG, LAS unsigned char* lds) {
    LAS float* sA = (LAS float*)lds; LAS float* sB = sA + 64 * 64;
    const int tid__ = otid(); const int c8 = tid__ & 7, tc = tid__ >> 3;
    for (int unit = blockIdx.x; unit < 256; unit += gridDim.x) {
        const int b = unit >> 4, cgp = unit & 15;
        const size_t base = ((size_t)b * SEQ + tc * 32) * D + cgp * 64 + c8 * 8;
        float sl[8], Bv[8], h[8];
#pragma unroll
        for (int q = 0; q < 8; ++q) { sl[q] = 0.f; Bv[q] = 0.f; h[q] = 0.f; }
#pragma unroll 4
        for (int i = 0; i < 32; ++i) { float la[8], bb[8]; ld8(LA + base + (size_t)i * D, la); ld8(BV + base + (size_t)i * D, bb);
#pragma unroll
            for (int q = 0; q < 8; ++q) { Bv[q] = __expf(la[q]) * Bv[q] + bb[q]; sl[q] += la[q]; } }
#pragma unroll
        for (int q = 0; q < 8; ++q) { sA[tc * 64 + c8 * 8 + q] = __expf(sl[q]); sB[tc * 64 + c8 * 8 + q] = Bv[q]; }
        __syncthreads();
        for (int j = 0; j < tc; ++j) {
            const f32x4 a0 = *(const LAS f32x4*)(sA + j * 64 + c8 * 8), a1 = *(const LAS f32x4*)(sA + j * 64 + c8 * 8 + 4), b0 = *(const LAS f32x4*)(sB + j * 64 + c8 * 8), b1 = *(const LAS f32x4*)(sB + j * 64 + c8 * 8 + 4);
#pragma unroll
            for (int q = 0; q < 4; ++q) { h[q] = a0[q] * h[q] + b0[q]; h[4 + q] = a1[q] * h[4 + q] + b1[q]; } }
#pragma unroll 4
        for (int i = 0; i < 32; ++i) { float la[8], bb[8], gg[8], y[8]; ld8(LA + base + (size_t)i * D, la); ld8(BV + base + (size_t)i * D, bb); ld8(GG + base + (size_t)i * D, gg);
#pragma unroll
            for (int q = 0; q < 8; ++q) { h[q] = __expf(la[q]) * h[q] + bb[q]; y[q] = gg[q] * h[q]; }
            st8(GG + base + (size_t)i * D, y); }
        __syncthreads();
    }
}
__device__ __forceinline__ void ffn_fix_panel(const float* raw, const float* cw, const float* cb, bf16_t* Aout, int pm) {
    if ((pm & 7) == 0) return;
    const int tid = otid();
    float x0[11][2], x1[11][2], x2[11][2], w0[11][2], w1[11][2], w2[11][2], bb[11][2];
#pragma unroll
    for (int k = 0; k < 11; ++k) {
        const int idx = tid + k * NTHREADS, hc = idx % FH, rr = idx / FH, pn = hc >> 7, cl = hc & 127;
        const float* cur = raw + (size_t)(pm * 22 + pn) * 1024; const float* prv = raw + (size_t)((pm - 1) * 22 + pn) * 1024;
#pragma unroll
        for (int part = 0; part < 2; ++part) { const int off = part * 128 + cl, col = part * FH + hc;
            x0[k][part] = cur[rr * 256 + off]; x1[k][part] = rr ? cur[off] : prv[3 * 256 + off]; x2[k][part] = rr ? prv[3 * 256 + off] : prv[2 * 256 + off];
            bb[k][part] = cb[col]; w2[k][part] = cw[2 * F2 + col]; w1[k][part] = cw[F2 + col]; w0[k][part] = cw[col]; }
    }
#pragma unroll
    for (int k = 0; k < 11; ++k) {
        const int idx = tid + k * NTHREADS, hc = idx % FH, rr = idx / FH;
        const float hv = bb[k][0] + w2[k][0] * x0[k][0] + w1[k][0] * x1[k][0] + w0[k][0] * x2[k][0];
        const float hg = bb[k][1] + w2[k][1] * x0[k][1] + w1[k][1] * x1[k][1] + w0[k][1] * x2[k][1];
        const float o = hg * sigmoidf_(hg) * hv;
        Aout[(size_t)(pm * 256 + rr) * FH + hc] = (bf16_t)(cvt_pk_bf16(o, 0.f) & 0xffffu);
    }
}

__device__ __forceinline__ void s5_phase(const Params& P, const bf16_t* hn, bf16_t* ys, LAS unsigned char* lds) {
    const int tid__ = otid(); const int lane = tid__ & 63, wave = tid__ >> 6;
    if (wave >= 4) return;
    LAS unsigned* S = (LAS unsigned*)(lds + wave * 8704);
    const float* lam_re = P.in[6]; const float* lam_im = P.in[7]; const float* log_dt = P.in[8]; const float* b_re = P.in[9]; const float* b_im = P.in[10];
    const float* c_re = P.in[11]; const float* c_im = P.in[12]; const float* dsk = P.in[13];
    const int c32 = lane & 31, hf = lane >> 5, c16 = lane & 15, q4 = lane >> 4;
    for (int unit = blockIdx.x * 4 + wave; unit < 1024; unit += gridDim.x * 4) {
        const int b = unit >> 6, g = unit & 63;
        const float dt = expf(log_dt[g]);
        float ar, ai;
        { const float lr = fminf(lam_re[g * 64 + lane], -1e-4f), li = lam_im[g * 64 + lane]; const float er = expf(lr * dt); ar = er * cosf(li * dt); ai = er * sinf(li * dt); }
        bf16x8 Bre[2], Bim[2];
#pragma unroll
        for (int pb = 0; pb < 2; ++pb) {
            const int pp = pb * 32 + c32;
            const float lr = fminf(lam_re[g * 64 + pp], -1e-4f), li = lam_im[g * 64 + pp]; const float er = expf(lr * dt);
            const float nr = er * cosf(li * dt) - 1.0f, ni = er * sinf(li * dt), dd = lr * lr + li * li;
            const float cr = (nr * lr + ni * li) / dd, ci = (ni * lr - nr * li) / dd;
            const float* br = b_re + (size_t)(g * 64 + pp) * 16 + 8 * hf; const float* bi = b_im + (size_t)(g * 64 + pp) * 16 + 8 * hf;
            unsigned wr_[4], wi_[4];
#pragma unroll
            for (int i = 0; i < 4; ++i) { const float r0 = br[2 * i], i0 = bi[2 * i], r1 = br[2 * i + 1], i1 = bi[2 * i + 1];
                wr_[i] = cvt_pk_bf16(cr * r0 - ci * i0, cr * r1 - ci * i1); wi_[i] = cvt_pk_bf16(cr * i0 + ci * r0, cr * i1 + ci * r1); }
            Bre[pb] = __builtin_bit_cast(bf16x8, (u32x4){wr_[0], wr_[1], wr_[2], wr_[3]}); Bim[pb] = __builtin_bit_cast(bf16x8, (u32x4){wi_[0], wi_[1], wi_[2], wi_[3]});
        }
        bf16x8 Cf[4];
#pragma unroll
        for (int kb = 0; kb < 4; ++kb) { const int p0 = kb * 16 + 4 * q4; const float* cr = c_re + (size_t)(g * 16 + c16) * 64 + p0; const float* ci = c_im + (size_t)(g * 16 + c16) * 64 + p0;
            Cf[kb] = __builtin_bit_cast(bf16x8, (u32x4){cvt_pk_bf16(cr[0], -ci[0]), cvt_pk_bf16(cr[1], -ci[1]), cvt_pk_bf16(cr[2], -ci[2]), cvt_pk_bf16(cr[3], -ci[3])}); }
        float dk[4];
#pragma unroll
        for (int r = 0; r < 4; ++r) dk[r] = dsk[g * 16 + 4 * q4 + r];
        float sr = 0.f, si = 0.f;
        const bf16_t* hb = hn + (size_t)b * SEQ * D + g * 16; bf16_t* yb = ys + (size_t)b * SEQ * D + g * 16;
        bf16x8 ufn = *(const bf16x8*)(hb + (size_t)c32 * D + 8 * hf);
        u32x2 uwn[2];
#pragma unroll
        for (int tb = 0; tb < 2; ++tb) uwn[tb] = *(const u32x2*)(hb + (size_t)(tb * 16 + c16) * D + 4 * q4);
        for (int c = 0; c < SEQ / 32; ++c) {
            const int t0 = c * 32;
            const bf16x8 uf = ufn; const u32x2 uwc[2] = {uwn[0], uwn[1]};
            { const int tn = (c + 1 < SEQ / 32) ? t0 + 32 : t0;
              ufn = *(const bf16x8*)(hb + (size_t)(tn + c32) * D + 8 * hf);
#pragma unroll
              for (int tb = 0; tb < 2; ++tb) uwn[tb] = *(const u32x2*)(hb + (size_t)(tn + tb * 16 + c16) * D + 4 * q4); }
            const f32x16 z16 = {0.f, 0.f, 0.f, 0.f, 0.f, 0.f, 0.f, 0.f, 0.f, 0.f, 0.f, 0.f, 0.f, 0.f, 0.f, 0.f};
            f32x16 r0 = __builtin_amdgcn_mfma_f32_32x32x16_bf16(uf, Bre[0], z16, 0, 0, 0), r1 = __builtin_amdgcn_mfma_f32_32x32x16_bf16(uf, Bre[1], z16, 0, 0, 0);
            f32x16 i0 = __builtin_amdgcn_mfma_f32_32x32x16_bf16(uf, Bim[0], z16, 0, 0, 0), i1 = __builtin_amdgcn_mfma_f32_32x32x16_bf16(uf, Bim[1], z16, 0, 0, 0);
#pragma unroll
            for (int q = 0; q < 4; ++q) {
                float xr[8], xi[8];
#pragma unroll
                for (int i = 0; i < 4; ++i) {
                    auto pr = __builtin_amdgcn_permlane32_swap(__float_as_uint(r0[4 * q + i]), __float_as_uint(r1[4 * q + i]), false, false);
                    auto pi = __builtin_amdgcn_permlane32_swap(__float_as_uint(i0[4 * q + i]), __float_as_uint(i1[4 * q + i]), false, false);
                    xr[i] = __uint_as_float(pr[0]); xr[4 + i] = __uint_as_float(pr[1]); xi[i] = __uint_as_float(pi[0]); xi[4 + i] = __uint_as_float(pi[1]); }
#pragma unroll
                for (int i = 0; i < 8; ++i) { const float nr = ar * sr - ai * si + xr[i], ni = ar * si + ai * sr + xi[i]; sr = nr; si = ni;
                    S[(8 * q + i) * 68 + lane] = cvt_pk_bf16(sr, si); }
            }
            asm volatile("" ::: "memory");
#pragma unroll
            for (int tb = 0; tb < 2; ++tb) {
                f32x4 y = (f32x4){0.f, 0.f, 0.f, 0.f};
#pragma unroll
                for (int kb = 0; kb < 4; ++kb) { const bf16x8 sf = __builtin_bit_cast(bf16x8, *(const LAS u32x4*)(S + (tb * 16 + c16) * 68 + kb * 16 + 4 * q4));
                    y = __builtin_amdgcn_mfma_f32_16x16x32_bf16(Cf[kb], sf, y, 0, 0, 0); }
                const size_t off = (size_t)(t0 + tb * 16 + c16) * D + 4 * q4;
                const u32x2 uw = uwc[tb];
                const float u0 = bflo(uw.x), u1 = bfhi(uw.x), u2 = bflo(uw.y), u3 = bfhi(uw.y);
                u32x2 w; w.x = cvt_pk_bf16(gelu_tanh(y[0] + dk[0] * u0), gelu_tanh(y[1] + dk[1] * u1)); w.y = cvt_pk_bf16(gelu_tanh(y[2] + dk[2] * u2), gelu_tanh(y[3] + dk[3] * u3));
                *(u32x2*)(yb + off) = w;
            }
        }
    }
}

__device__ __forceinline__ void attn_phase(const bf16_t* Q, const bf16_t* Kb, const bf16_t* V, bf16_t* VT, bf16_t* O, LAS unsigned char* lds) {
    const int tid__ = otid(); const int lane = tid__ & 63, wave = tid__ >> 6, c32 = lane & 31, hf = lane >> 5;
    for (int bh = blockIdx.x; bh < 256; bh += gridDim.x) {
        const int b = bh >> 4, h = bh & 15;
        bf16_t* vtw = VT + (size_t)(b * 16 + h) * 64 * SEQ;
        {
            LAS bf16_t* scr = (LAS bf16_t*)(lds + wave * 8704);
            for (int st = wave * 4; st < wave * 4 + 4; ++st) {
                const int s0 = st * 64;
#pragma unroll
                for (int j = 0; j < 8; ++j) { const int i = (lane >> 3) + 8 * j, c = lane & 7;
                    const u32x4 w = *(const u32x4*)(V + (size_t)(b * SEQ + s0 + i) * D + h * 64 + 8 * c);
                    *(LAS u32x2*)(scr + i * 68 + 8 * c) = (u32x2){w.x, w.y}; *(LAS u32x2*)(scr + i * 68 + 8 * c + 4) = (u32x2){w.z, w.w}; }
                asm volatile("s_waitcnt lgkmcnt(0)" ::: "memory");
#pragma unroll
                for (int j = 0; j < 8; ++j) { const int d = (lane >> 3) + 8 * j, c = lane & 7;
                    unsigned short e[8];
#pragma unroll
                    for (int k = 0; k < 8; ++k) e[k] = scr[(8 * c + k) * 68 + d];
                    u32x4 w; w.x = e[0] | ((unsigned)e[1] << 16); w.y = e[2] | ((unsigned)e[3] << 16); w.z = e[4] | ((unsigned)e[5] << 16); w.w = e[6] | ((unsigned)e[7] << 16);
                    *(u32x4*)(vtw + (size_t)d * SEQ + s0 + 8 * c) = w; }
                asm volatile("s_waitcnt lgkmcnt(0)" ::: "memory");
            }
            asm volatile("s_waitcnt vmcnt(0)" ::: "memory"); __syncthreads();
        }
        const bf16_t* vtb = vtw;
        for (int it = 0; it < 8; ++it) {
            const int qb = wave * 8 + it, t0 = qb * 32;
            const bf16_t* qp = Q + (size_t)(b * SEQ + t0 + c32) * D + h * 64 + 8 * hf;
            bf16x8 qf[4];
#pragma unroll
            for (int kd = 0; kd < 4; ++kd) qf[kd] = *(const bf16x8*)(qp + 16 * kd);
            f32x16 o0 = {0.f, 0.f, 0.f, 0.f, 0.f, 0.f, 0.f, 0.f, 0.f, 0.f, 0.f, 0.f, 0.f, 0.f, 0.f, 0.f}, o1 = o0;
            float R = 0.f;
            bf16x8 kfn[4];
            { const bf16_t* kp = Kb + (size_t)(b * SEQ + qb * 32 + c32) * D + h * 64 + 8 * hf;
#pragma unroll
              for (int kd = 0; kd < 4; ++kd) kfn[kd] = *(const bf16x8*)(kp + 16 * kd); }
            for (int kt = qb; kt >= 0; --kt) {
                const int s0 = kt * 32;
                f32x16 z = {0.f, 0.f, 0.f, 0.f, 0.f, 0.f, 0.f, 0.f, 0.f, 0.f, 0.f, 0.f, 0.f, 0.f, 0.f, 0.f};
#pragma unroll
                for (int kd = 0; kd < 4; ++kd) z = __builtin_amdgcn_mfma_f32_32x32x16_bf16(kfn[kd], qf[kd], z, 0, 0, 0);
                { const int sn = kt > 0 ? s0 - 32 : s0;
                  const bf16_t* kp = Kb + (size_t)(b * SEQ + sn + c32) * D + h * 64 + 8 * hf;
#pragma unroll
                  for (int kd = 0; kd < 4; ++kd) kfn[kd] = *(const bf16x8*)(kp + 16 * kd); }
                bf16x8 vf[2][2];
#pragma unroll
                for (int db = 0; db < 2; ++db)
#pragma unroll
                    for (int ks = 0; ks < 2; ++ks) { const bf16_t* vp = vtb + (size_t)(db * 32 + c32) * SEQ + s0 + 16 * ks + 4 * hf;
                        const u32x2 a = *(const u32x2*)vp, c = *(const u32x2*)(vp + 8); vf[db][ks] = __builtin_bit_cast(bf16x8, (u32x4){a.x, a.y, c.x, c.y}); }
                float L[16], lg[16];
                const bool diag = (kt == qb);
#pragma unroll
                for (int r = 0; r < 16; ++r) { const float zz = z[r]; const float sp = fmaxf(zz, 0.f) + __logf(1.0f + __expf(-fabsf(zz)));
                    const int sl = 8 * (r >> 2) + 4 * hf + (r & 3); const bool valid = !diag || (sl < c32);
                    L[r] = valid ? -sp : 0.f; lg[r] = valid ? zz - sp : -1e30f; }
                float bs[4], pbs[4];
#pragma unroll
                for (int q = 0; q < 4; ++q) { bs[q] = (L[4 * q] + L[4 * q + 1]) + (L[4 * q + 2] + L[4 * q + 3]); pbs[q] = __shfl_xor(bs[q], 32); }
                float after = R; float att[16];
#pragma unroll
                for (int q = 3; q >= 0; --q) {
                    const float off = after + (hf == 0 ? pbs[q] : 0.f);
                    const float e3 = off, e2 = e3 + L[4 * q + 3], e1 = e2 + L[4 * q + 2], e0 = e1 + L[4 * q + 1];
                    att[4 * q + 3] = __expf(lg[4 * q + 3] + e3); att[4 * q + 2] = __expf(lg[4 * q + 2] + e2); att[4 * q + 1] = __expf(lg[4 * q + 1] + e1); att[4 * q] = __expf(lg[4 * q] + e0);
                    after += bs[q] + pbs[q];
                }
                R = after;
#pragma unroll
                for (int ks = 0; ks < 2; ++ks) {
                    const bf16x8 pf = __builtin_bit_cast(bf16x8, (u32x4){cvt_pk_bf16(att[8 * ks], att[8 * ks + 1]), cvt_pk_bf16(att[8 * ks + 2], att[8 * ks + 3]), cvt_pk_bf16(att[8 * ks + 4], att[8 * ks + 5]), cvt_pk_bf16(att[8 * ks + 6], att[8 * ks + 7])});
                    o0 = __builtin_amdgcn_mfma_f32_32x32x16_bf16(vf[0][ks], pf, o0, 0, 0, 0); o1 = __builtin_amdgcn_mfma_f32_32x32x16_bf16(vf[1][ks], pf, o1, 0, 0, 0); }
                if (__all(R < -120.0f)) break;
            }
            bf16_t* op = O + (size_t)(b * SEQ + t0 + c32) * D + h * 64 + 4 * hf;
#pragma unroll
            for (int q = 0; q < 4; ++q) {
                u32x2 w0; w0.x = cvt_pk_bf16(o0[4 * q], o0[4 * q + 1]); w0.y = cvt_pk_bf16(o0[4 * q + 2], o0[4 * q + 3]); *(u32x2*)(op + 8 * q) = w0;
                u32x2 w1; w1.x = cvt_pk_bf16(o1[4 * q], o1[4 * q + 1]); w1.y = cvt_pk_bf16(o1[4 * q + 2], o1[4 * q + 3]); *(u32x2*)(op + 32 + 8 * q) = w1; }
        }
    }
}


__global__ void __launch_bounds__(NTHREADS, 2) fwd_megakernel(Params P) {
    extern __shared__ __attribute__((aligned(16))) unsigned char lds_raw[];
    LAS unsigned char* lds = (LAS unsigned char*)lds_raw;
    cg::grid_group grid = cg::this_grid();
    unsigned char* ws = P.ws;
    bf16_t* HN = (bf16_t*)(ws + WS_HN);
    bf16_t* B0 = (bf16_t*)(ws + WS_BIG); bf16_t* B1 = (bf16_t*)(ws + WS_BIG + ACT); bf16_t* B2 = (bf16_t*)(ws + WS_BIG + 2 * ACT); bf16_t* B3 = (bf16_t*)(ws + WS_BIG + 3 * ACT); bf16_t* B4 = (bf16_t*)(ws + WS_BIG + 4 * ACT);
    float* RAW = (float*)(ws + WS_RAW);
    float* X = P.out;
    const int G = gridDim.x, bx = blockIdx.x;
    pg8::StaticOrder S;
    volatile LAS unsigned* MISC = (volatile LAS unsigned*)(lds + MISC_OFF);
    if (threadIdx.x < 2) MISC[threadIdx.x] = 0u;
    __syncthreads();
    const XcdBarrier bar = xcd_barrier_post((unsigned*)ws, MISC);
    grid.sync();
#define SYNC() xcd_barrier(bar)

    weights_phase(P, lds);
    rmsnorm_phase(P.in[0], P.in[1], HN);
    SYNC();
#define FFN_BLOCK(layer, LASTSYNC) do { \
        rmsnorm_phase(X, P.in[2] + (layer) * D, HN); \
        SYNC(); \
        const float* cw = P.in[30] + (size_t)(layer) * 3 * F2; const float* cb = P.in[31] + (size_t)(layer) * F2; \
        { pg8::Gemm g{HN, (const bf16_t*)(ws + WS_WF1) + (size_t)(layer) * F2 * D, T, F2, 1024, D, D, 0, 0}; S.init(T, F2, G, bx); \
          EpiFfn1 E{B0, cw, cb, RAW, (LAS float*)(lds + XCH_OFF)}; pg8::gemm_phase(lds, g, S, E); } \
        SYNC(); \
        { pg8::Gemm g{B0, (const bf16_t*)(ws + WS_WF2) + (size_t)(layer) * D * FH, T, 1024, FH, FH, FH, 0, 0}; S.init(T, 1024, G, bx); \
          { Unit fu; int lastpm = -1; for (int i = 0; S.next(i, fu); ++i) if (fu.pm != lastpm) { ffn_fix_panel(RAW, cw, cb, B0, fu.pm); lastpm = fu.pm; } } \
          asm volatile("s_waitcnt vmcnt(0)" ::: "memory"); __syncthreads(); \
          EpiRes E{X, X, nullptr, nullptr}; pg8::gemm_phase(lds, g, S, E); } \
        if (LASTSYNC) SYNC(); } while (0)

    pool_phase(HN, B0);
    SYNC();
    { pg8::Gemm g{B0, (const bf16_t*)(ws + WS_WPOOL), T, 1024, 256, D, 256, 0, 512}; S.init(T, 1024, G, bx);
      EpiRes E{P.in[0], X, P.in[5], P.in[4]}; pg8::gemm_phase(lds, g, S, E); }
    SYNC();
    FFN_BLOCK(0, true);
    rmsnorm_phase(X, P.in[1] + 1 * D, HN);
    SYNC();
    s5_phase(P, HN, B0, lds);
    SYNC();
    { pg8::Gemm g{B0, (const bf16_t*)(ws + WS_WS5), T, 2048, 1024, D, D, 0, 0}; S.init(T, 2048, G, bx);
      EpiGateRes E{X, P.in[15]}; pg8::gemm_phase(lds, g, S, E); }
    SYNC();
    FFN_BLOCK(1, true);
    rmsnorm_phase(X, P.in[1] + 2 * D, HN);
    SYNC();
    { pg8::Gemm g{HN, (const bf16_t*)(ws + WS_WLIN), T, 2048, 1024, D, D, 0, 0}; S.init(T, 2048, G, bx);
      EpiLruIn E{B0, B1}; pg8::gemm_phase(lds, g, S, E); }
    SYNC();
    lruconv_phase(B1, P.in[17], P.in[18], B2);
    SYNC();
    { pg8::Gemm g{B2, (const bf16_t*)(ws + WS_WGATE), T, 2048, 256, D, 256, 1, 512}; S.init(T, 2048, G, bx);
      EpiGates E{B2, B3, B4, P.in[20], P.in[22], P.in[23]}; pg8::gemm_phase(lds, g, S, E); }
    SYNC();
    lruscan_phase(B3, B4, B0, lds);
    SYNC();
    { pg8::Gemm g{B0, (const bf16_t*)(ws + WS_WLOUT), T, 1024, 1024, D, D, 0, 0}; S.init(T, 1024, G, bx);
      EpiRes E{X, X, nullptr, nullptr}; pg8::gemm_phase(lds, g, S, E); }
    SYNC();
    FFN_BLOCK(2, true);
    rmsnorm_phase(X, P.in[1] + 3 * D, HN);
    SYNC();
    { pg8::Gemm g{HN, (const bf16_t*)(ws + WS_WQKV), T, 3072, 1024, D, D, 0, 0}; S.init(T, 3072, G, bx);
      EpiQKV E{B0, P.in[26], P.in[27]}; pg8::gemm_phase(lds, g, S, E); }
    SYNC();
    attn_phase(B0, B1, B2, B3, B4, lds);
    SYNC();
    { pg8::Gemm g{B4, (const bf16_t*)(ws + WS_WWO), T, 1024, 1024, D, D, 0, 0}; S.init(T, 1024, G, bx);
      EpiRes E{X, X, nullptr, nullptr}; pg8::gemm_phase(lds, g, S, E); }
    SYNC();
    FFN_BLOCK(3, false);
}

extern "C" void kernel_launch(void* const* d_in, const int* in_sizes, int n_in, void* d_out, int out_size, void* d_ws, size_t ws_size, hipStream_t stream) {
    static int grid = 0;
    if (grid == 0) {
        if (n_in != 33 || out_size != T * D || ws_size < WS_END) { fprintf(stderr, "kernel_launch: unexpected shapes (n_in %d out %d ws %zu)\n", n_in, out_size, ws_size); grid = -1; return; }
        int dev = 0, cus = 0, per_cu = 0;
        (void)hipGetDevice(&dev); (void)hipDeviceGetAttribute(&cus, hipDeviceAttributeMultiprocessorCount, dev);
        if (hipFuncSetAttribute((const void*)fwd_megakernel, hipFuncAttributeMaxDynamicSharedMemorySize, LDS_BYTES) != hipSuccess) { fprintf(stderr, "kernel_launch: hipFuncSetAttribute failed\n"); grid = -1; return; }
        (void)hipOccupancyMaxActiveBlocksPerMultiprocessor(&per_cu, (const void*)fwd_megakernel, NTHREADS, LDS_BYTES);
        (void)hipGetLastError();
        if (per_cu < 1) per_cu = 1;
        grid = cus * per_cu;
        if (grid > 256) grid = 256;
    }
    if (grid < 0) return;
    Params p; memset(&p, 0, sizeof(p));
    for (int i = 0; i < 33; ++i) p.in[i] = (const float*)d_in[i];
    p.out = (float*)d_out; p.ws = (unsigned char*)d_ws;
    unsigned char* ws = (unsigned char*)d_ws;
    int nj = 0, items = 0;
    auto add = [&](const float* src, bf16_t* dst, int K, int ld, int nrows, int map, int hh) {
        Job& j = p.jobs[nj++]; j.src = src; j.dst = dst; j.K = K; j.ld = ld; j.nrows = nrows; j.map = map; j.hh = hh; j.item0 = items; items += (K / 64) * (nrows / 32); };
    for (int l = 0; l < 4; ++l) add(p.in[29] + (size_t)l * D * F2, (bf16_t*)(ws + WS_WF1) + (size_t)l * F2 * D, 1024, F2, F2, 1, FH);
    for (int l = 0; l < 4; ++l) add(p.in[32] + (size_t)l * FH * D, (bf16_t*)(ws + WS_WF2) + (size_t)l * D * FH, FH, D, D, 0, 0);
    for (int gI = 0; gI < 4; ++gI) add(p.in[3] + (size_t)gI * 65536, (bf16_t*)(ws + WS_WPOOL) + (size_t)gI * 65536, 256, 256, 256, 0, 0);
    add(p.in[14], (bf16_t*)(ws + WS_WS5), 1024, 2048, 2048, 1, 1024);
    add(p.in[16], (bf16_t*)(ws + WS_WLIN), 1024, 2048, 2048, 0, 0);
    for (int pn = 0; pn < 8; ++pn) for (int bj = 0; bj < 2; ++bj)
        add((bj ? p.in[21] : p.in[19]) + (size_t)(pn >> 1) * 65536 + (pn & 1) * 128, (bf16_t*)(ws + WS_WGATE) + (size_t)(pn * 256 + bj * 128) * 256, 256, 256, 128, 0, 0);
    add(p.in[24], (bf16_t*)(ws + WS_WLOUT), 1024, 1024, 1024, 0, 0);
    add(p.in[25], (bf16_t*)(ws + WS_WQKV), 1024, 3072, 3072, 2, 0);
    add(p.in[28], (bf16_t*)(ws + WS_WWO), 1024, 1024, 1024, 0, 0);
    p.nitems = items;
    if (hipMemsetAsync(d_ws, 0, 16384, stream) != hipSuccess) { fprintf(stderr, "kernel_launch: memset failed\n"); return; }
    void* args[] = {&p};
    hipError_t e = hipLaunchCooperativeKernel((const void*)fwd_megakernel, dim3(grid), dim3(NTHREADS), args, LDS_BYTES, stream);
    if (e != hipSuccess) fprintf(stderr, "cooperative launch failed: %s (grid %d)\n", hipGetErrorString(e), grid);
}
```

```cpp
#include <hip/hip_runtime.h>
#include <hip/hip_cooperative_groups.h>
#include <cstdio>
#include <cstring>
namespace cg = cooperative_groups;

#define LAS __attribute__((address_space(3)))
typedef unsigned short bf16_t;
typedef short bf16x8 __attribute__((ext_vector_type(8)));
typedef short bf16x4 __attribute__((ext_vector_type(4)));
typedef float f32x4 __attribute__((ext_vector_type(4)));
typedef float f32x16 __attribute__((ext_vector_type(16)));
typedef unsigned u32x4 __attribute__((ext_vector_type(4)));
typedef unsigned u32x2 __attribute__((ext_vector_type(2)));

constexpr int T = 32768, D = 1024, SEQ = 2048, FH = 2816, F2 = 5632;
constexpr int NTHREADS = 512;
constexpr int LDS_BYTES = 147456;
constexpr int XCH_OFF = 131072, MISC_OFF = 131072 + 8192;
constexpr size_t MiB = 1u << 20;
constexpr size_t WS_WPOOL = 1 * MiB, WS_WS5 = 2 * MiB, WS_WLIN = 6 * MiB, WS_WGATE = 10 * MiB, WS_WLOUT = 11 * MiB,
                 WS_WQKV = 13 * MiB, WS_WWO = 19 * MiB, WS_WF1 = 21 * MiB, WS_WF2 = 65 * MiB,
                 WS_HN = 96 * MiB, WS_BIG = 160 * MiB, WS_RAW = 480 * MiB, WS_END = 492 * MiB;
constexpr size_t ACT = 64 * MiB;

typedef __bf16 bf16v2_t __attribute__((ext_vector_type(2)));
__device__ __forceinline__ unsigned cvt_pk_bf16(float lo, float hi) { const bf16v2_t v = {(__bf16)lo, (__bf16)hi}; return __builtin_bit_cast(unsigned, v); }
__device__ __forceinline__ float bf2f(unsigned short b) { return __uint_as_float(((unsigned)b) << 16); }
__device__ __forceinline__ float bflo(unsigned w) { return __uint_as_float(w << 16); }
__device__ __forceinline__ float bfhi(unsigned w) { return __uint_as_float(w & 0xffff0000u); }
__device__ __forceinline__ float sigmoidf_(float x) { return __builtin_amdgcn_rcpf(1.0f + __expf(-x)); }
__device__ __forceinline__ float gelu_tanh(float x) { const float k = 1.5957691216f * (x + 0.044715f * x * x * x); return x * __builtin_amdgcn_rcpf(1.0f + __expf(-k)); }
__device__ __forceinline__ float wave_sum(float v) {
#pragma unroll
    for (int o = 1; o < 64; o <<= 1) v += __shfl_xor(v, o);
    return v;
}
__device__ __forceinline__ int otid() { int t = threadIdx.x; asm volatile("" : "+v"(t)); return t; }
template <int CTRL> __device__ __forceinline__ float dpp_upd(float old, float src) {
    return __int_as_float(__builtin_amdgcn_update_dpp(__float_as_int(old), __float_as_int(src), CTRL, 0xf, 0xf, false));
}
template <int CTRL> __device__ __forceinline__ float dpp0(float src) { return __int_as_float(__builtin_amdgcn_update_dpp(0, __float_as_int(src), CTRL, 0xf, 0xf, true)); }
__device__ __forceinline__ float prev1(float prev, float cur) { const float t = dpp_upd<0x121>(0.f, prev); return dpp_upd<0x111>(t, cur); }
__device__ __forceinline__ float prev2(float prev, float cur) { const float t = dpp_upd<0x122>(0.f, prev); return dpp_upd<0x112>(t, cur); }

namespace pg8 {
constexpr int BM = 256, BK = 64, HALF = 128, HTB = HALF * BK * 2, STAGE_BYTES = 8 * HTB, NXCD = 8, WGM = 8;
__host__ __device__ __forceinline__ int lds_byte(int r, int c) { const int st = (r >> 4) * 2 + (c >> 5), rr = r & 15, cc = c & 31, ob = rr * 64 + cc * 2; return st * 1024 + (ob ^ (((ob >> 9) & 1) << 5)); }
__host__ __device__ __forceinline__ void stage_rc(int b, int& R, int& C) { const int st = b / 1024, sb = b % 1024, swz = sb ^ (((sb >> 9) & 1) << 5); R = (st >> 1) * 16 + swz / 64; C = (st & 1) * 32 + (swz % 64) / 2; }
__host__ __device__ __forceinline__ int perm32(int rho) { const int n = rho >> 4, i = rho & 15; return 8 * (i >> 2) + 4 * n + (i & 3); }
struct Unit { int pm, pn; };
struct Gemm { const bf16_t* A; const bf16_t* Bt; int M, N, K, lda, ldb, a_shift, a_step; };
struct StaticOrder {
    int nM, nN, nwg, G, c;
    __device__ __forceinline__ void init(int M, int N, int G_, int c_) { nM = M / BM; nN = N / BM; nwg = nM * nN; G = G_; c = c_; }
    __device__ __forceinline__ bool next(int i, Unit& u) const {
        const long L = (long)i * G + c; if (L >= nwg) return false;
        int wgid = (int)L; { const int q = nwg / NXCD, r = nwg % NXCD, xcd = wgid % NXCD, off = wgid / NXCD; wgid = (xcd < r ? xcd * (q + 1) : r * (q + 1) + (xcd - r) * q) + off; }
        const int nig = WGM * nN, gid = wgid / nig, fm = gid * WGM, gsz = (nM - fm) < WGM ? (nM - fm) : WGM;
        u.pm = fm + ((wgid % nig) % gsz); u.pn = (wgid % nig) / gsz; return true;
    }
};
template <class Epi>
__device__ __forceinline__ void gemm_phase(LAS unsigned char* lds, const Gemm g, const StaticOrder& S, const Epi& E) {
    int tid_ = threadIdx.x; asm volatile("" : "+v"(tid_));
    const int tid = tid_, wid = __builtin_amdgcn_readfirstlane(tid >> 6), lane = tid & 63, wr = wid >> 2, wc = wid & 3, fr = lane & 15, fq = lane >> 4;
    const int K = g.K, nt = K / BK;
    unsigned voffA[2], voffB[2];
#pragma unroll
    for (int i = 0; i < 2; ++i) { int R, C; stage_rc(tid * 16 + i * 8192, R, C); const int Rb = Epi::PERM ? ((R & ~31) + perm32(R & 31)) : R;
        const int Ra = Epi::ROWPERM ? ((R & ~63) + 4 * (R & 15) + ((R >> 4) & 3)) : R;
        voffA[i] = (unsigned)(Ra * g.lda + C) * 2u; voffB[i] = (unsigned)(Rb * g.ldb + C) * 2u; }
    const size_t kstep = (size_t)(BK * 2);
    const size_t hstepA = (size_t)HALF * g.lda * 2, hstepB = (size_t)HALF * g.ldb * 2;
    const size_t tstepA = 2 * hstepA, tstepB = 2 * hstepB;
    const unsigned ldsw = (unsigned)wid * 1024u;
    const int aoff = lds_byte(wr * 64 + fr, fq * 8), boff = lds_byte(wc * 32 + fr, fq * 8);
#define PG8_SA(b, h) (((b) * 2 + (h)) * HTB)
#define PG8_SB(b, h) ((4 + (b) * 2 + (h)) * HTB)
#define PG8_STAGE(bufoff, gbase, voff) do { _Pragma("unroll") for (int _i = 0; _i < 2; ++_i) \
        __builtin_amdgcn_global_load_lds((const unsigned*)((const char*)(gbase) + (voff)[_i]), (LAS unsigned*)(lds + (bufoff) + ldsw + _i * 8192), 16, 0, 0); } while (0)
#define PG8_LDA(dst, b, h) do { _Pragma("unroll") for (int m = 0; m < 4; ++m) _Pragma("unroll") for (int k = 0; k < 2; ++k) dst[m][k] = *(const LAS bf16x8*)(lds + PG8_SA(b, h) + aoff + m * 2048 + k * 1024); } while (0)
#define PG8_LDB(dst, b, h) do { _Pragma("unroll") for (int n = 0; n < 2; ++n) _Pragma("unroll") for (int k = 0; k < 2; ++k) dst[n][k] = *(const LAS bf16x8*)(lds + PG8_SB(b, h) + boff + n * 2048 + k * 1024); } while (0)
#define PG8_MMA(ai, bj, At, Bt) do { __builtin_amdgcn_s_setprio(1); _Pragma("unroll") for (int m = 0; m < 4; ++m) _Pragma("unroll") for (int n = 0; n < 2; ++n) _Pragma("unroll") for (int k = 0; k < 2; ++k) \
        acc[ai][bj][m][n] = __builtin_amdgcn_mfma_f32_16x16x32_bf16(Bt[n][k], At[m][k], acc[ai][bj][m][n], 0, 0, 0); __builtin_amdgcn_s_setprio(0); } while (0)
#define PG8_WAIT_V(n) asm volatile("s_waitcnt vmcnt(" #n ")" ::: "memory")
#define PG8_WAIT_L(n) asm volatile("s_waitcnt lgkmcnt(" #n ")" ::: "memory")
#define PG8_BAR __builtin_amdgcn_s_barrier()
#define PG8_SCHED __builtin_amdgcn_sched_barrier(0)
    Unit cur, nxt; int ui = 0;
    if (!S.next(0, cur)) return;
    f32x4 acc[2][2][4][2];
    {
#pragma unroll
    for (int a = 0; a < 2; ++a)
#pragma unroll
        for (int b = 0; b < 2; ++b)
#pragma unroll
            for (int m = 0; m < 4; ++m)
#pragma unroll
                for (int n = 0; n < 2; ++n) acc[a][b][m][n] = (f32x4){0.f, 0.f, 0.f, 0.f};
    }
    bf16x8 At[4][2], B0[2][2], B1[2][2];
    const char* cA = (const char*)g.A + (size_t)cur.pm * tstepA + (size_t)(cur.pn >> g.a_shift) * g.a_step; const char* cB = (const char*)g.Bt + (size_t)cur.pn * tstepB;
    PG8_STAGE(PG8_SB(0, 0), cB, voffB); PG8_STAGE(PG8_SA(0, 0), cA, voffA); PG8_STAGE(PG8_SB(0, 1), cB + hstepB, voffB); PG8_STAGE(PG8_SA(0, 1), cA + hstepA, voffA);
    if (wr == 1) PG8_BAR;
    PG8_WAIT_V(4); PG8_BAR;
    PG8_STAGE(PG8_SB(1, 0), cB + kstep, voffB); PG8_STAGE(PG8_SA(1, 0), cA + kstep, voffA); PG8_STAGE(PG8_SB(1, 1), cB + hstepB + kstep, voffB);
    PG8_WAIT_V(6); PG8_BAR;
    for (;;) {
        const bool has_next = S.next(ui + 1, nxt);
        const char* nA = has_next ? (const char*)g.A + (size_t)nxt.pm * tstepA + (size_t)(nxt.pn >> g.a_shift) * g.a_step : cA; const char* nB = has_next ? (const char*)g.Bt + (size_t)nxt.pn * tstepB : cB;
        for (int t = 0; t < nt; t += 2) {
            const bool last = (t == nt - 2);
            const char* a1 = cA + (size_t)(t + 1) * kstep;
            const char* a2 = last ? nA : cA + (size_t)(t + 2) * kstep; const char* b2 = last ? nB : cB + (size_t)(t + 2) * kstep;
            const char* a3 = a2 + kstep; const char* b3 = b2 + kstep;
            PG8_LDB(B0, 0, 0); PG8_SCHED; PG8_LDA(At, 0, 0); PG8_STAGE(PG8_SA(1, 1), a1 + hstepA, voffA);
            PG8_WAIT_L(8); PG8_BAR; PG8_WAIT_L(0); PG8_MMA(0, 0, At, B0); PG8_BAR; PG8_SCHED;
            PG8_LDB(B1, 0, 1); PG8_STAGE(PG8_SB(0, 0), b2, voffB);
            PG8_BAR; PG8_WAIT_L(0); PG8_MMA(0, 1, At, B1); PG8_BAR;
            PG8_LDA(At, 0, 1); PG8_STAGE(PG8_SA(0, 0), a2, voffA);
            PG8_BAR; PG8_WAIT_L(0); PG8_MMA(1, 0, At, B0); PG8_BAR; PG8_SCHED;
            PG8_STAGE(PG8_SB(0, 1), b2 + hstepB, voffB);
            PG8_WAIT_V(6); PG8_BAR; PG8_MMA(1, 1, At, B1); PG8_BAR;
            PG8_LDB(B0, 1, 0); PG8_SCHED; PG8_LDA(At, 1, 0); PG8_STAGE(PG8_SA(0, 1), a2 + hstepA, voffA);
            PG8_WAIT_L(8); PG8_BAR; PG8_WAIT_L(0); PG8_MMA(0, 0, At, B0); PG8_BAR; PG8_SCHED;
            PG8_LDB(B1, 1, 1); PG8_STAGE(PG8_SB(1, 0), b3, voffB);
            PG8_BAR; PG8_WAIT_L(0); PG8_MMA(0, 1, At, B1); PG8_BAR;
            PG8_LDA(At, 1, 1); PG8_STAGE(PG8_SA(1, 0), a3, voffA);
            PG8_BAR; PG8_WAIT_L(0); PG8_MMA(1, 0, At, B0); PG8_BAR; PG8_SCHED;
            PG8_STAGE(PG8_SB(1, 1), b3 + hstepB, voffB);
            PG8_WAIT_V(6); PG8_BAR; PG8_MMA(1, 1, At, B1); PG8_BAR;
        }
        E(acc, cur, wr, wc, fr, fq);
        if (!has_next) break;
        {
#pragma unroll
        for (int a = 0; a < 2; ++a)
#pragma unroll
            for (int b = 0; b < 2; ++b)
#pragma unroll
                for (int m = 0; m < 4; ++m)
#pragma unroll
                    for (int n = 0; n < 2; ++n) acc[a][b][m][n] = (f32x4){0.f, 0.f, 0.f, 0.f};
        }
        cur = nxt; cA = nA; cB = nB; ++ui;
    }
    PG8_WAIT_V(0);
    if (wr == 0) PG8_BAR;
    PG8_BAR;
#undef PG8_SA
#undef PG8_SB
#undef PG8_STAGE
#undef PG8_LDA
#undef PG8_LDB
#undef PG8_MMA
#undef PG8_WAIT_V
#undef PG8_WAIT_L
#undef PG8_BAR
#undef PG8_SCHED
}
}
using pg8::Unit;
typedef const f32x4 (&AccRef)[2][2][4][2];

struct EpiRes {
    static constexpr bool PERM = false, ROWPERM = false;
    const float* base; float* out; const float* scale; const float* bias;
    __device__ __forceinline__ void operator()(AccRef acc, const Unit& u, int wr, int wc, int fr, int fq) const {
        const int row0 = u.pm * 256 + wr * 64 + fr, col0 = u.pn * 256 + wc * 32 + 4 * fq;
        f32x4 sv[2][2], bv[2][2];
#pragma unroll
        for (int bj = 0; bj < 2; ++bj)
#pragma unroll
            for (int n = 0; n < 2; ++n) {
                sv[bj][n] = scale ? *(const f32x4*)(scale + col0 + bj * 128 + n * 16) : (f32x4){1.f, 1.f, 1.f, 1.f};
                bv[bj][n] = bias ? *(const f32x4*)(bias + col0 + bj * 128 + n * 16) : (f32x4){0.f, 0.f, 0.f, 0.f}; }
#pragma unroll
        for (int ai = 0; ai < 2; ++ai)
#pragma unroll
            for (int mh = 0; mh < 2; ++mh) {
                f32x4 bs[2][2][2];
#pragma unroll
                for (int m = 0; m < 2; ++m)
#pragma unroll
                    for (int bj = 0; bj < 2; ++bj)
#pragma unroll
                        for (int n = 0; n < 2; ++n) bs[m][bj][n] = *(const f32x4*)(base + (size_t)(row0 + ai * 128 + (2 * mh + m) * 16) * D + col0 + bj * 128 + n * 16);
#pragma unroll
                for (int m = 0; m < 2; ++m)
#pragma unroll
                    for (int bj = 0; bj < 2; ++bj)
#pragma unroll
                        for (int n = 0; n < 2; ++n) *(f32x4*)(out + (size_t)(row0 + ai * 128 + (2 * mh + m) * 16) * D + col0 + bj * 128 + n * 16) = bs[m][bj][n] + sv[bj][n] * (acc[ai][bj][2 * mh + m][n] + bv[bj][n]);
                asm volatile("" ::: "memory"); }
    }
};
struct EpiGateRes {
    static constexpr bool PERM = true, ROWPERM = false;
    float* x; const float* bias;
    __device__ __forceinline__ void operator()(AccRef acc, const Unit& u, int wr, int wc, int fr, int fq) const {
        const int row0 = u.pm * 256 + wr * 64 + fr, col0 = u.pn * 128 + wc * 32 + 8 * fq;
        f32x4 bv[2], bg[2];
#pragma unroll
        for (int n = 0; n < 2; ++n) { bv[n] = *(const f32x4*)(bias + col0 + 4 * n); bg[n] = *(const f32x4*)(bias + D + col0 + 4 * n); }
#pragma unroll
        for (int ai = 0; ai < 2; ++ai) {
            f32x4 xs[4][2];
#pragma unroll
            for (int m = 0; m < 4; ++m)
#pragma unroll
                for (int n = 0; n < 2; ++n) xs[m][n] = *(const f32x4*)(x + (size_t)(row0 + ai * 128 + m * 16) * D + col0 + 4 * n);
#pragma unroll
            for (int m = 0; m < 4; ++m)
#pragma unroll
                for (int n = 0; n < 2; ++n) { f32x4 xv = xs[m][n]; const f32x4 v = acc[ai][0][m][n] + bv[n], gt = acc[ai][1][m][n] + bg[n];
#pragma unroll
                    for (int j = 0; j < 4; ++j) xv[j] += v[j] * sigmoidf_(gt[j]);
                    *(f32x4*)(x + (size_t)(row0 + ai * 128 + m * 16) * D + col0 + 4 * n) = xv; }
            asm volatile("" ::: "memory"); }
    }
};
struct EpiLruIn {
    static constexpr bool PERM = true, ROWPERM = false;
    bf16_t* GG; bf16_t* RP;
    __device__ __forceinline__ void operator()(AccRef acc, const Unit& u, int wr, int wc, int fr, int fq) const {
        const int row0 = u.pm * 256 + wr * 64 + fr; const bool isg = u.pn < 4;
        bf16_t* dst = isg ? GG : RP; const int col0 = (u.pn & 3) * 256 + wc * 32 + 8 * fq;
#pragma unroll
        for (int ai = 0; ai < 2; ++ai)
#pragma unroll
            for (int m = 0; m < 4; ++m) { bf16_t* rp = dst + (size_t)(row0 + ai * 128 + m * 16) * D + col0;
#pragma unroll
                for (int bj = 0; bj < 2; ++bj) { f32x4 v0 = acc[ai][bj][m][0], v1 = acc[ai][bj][m][1];
                    if (isg) {
#pragma unroll
                        for (int j = 0; j < 4; ++j) { v0[j] = gelu_tanh(v0[j]); v1[j] = gelu_tanh(v1[j]); } }
                    u32x4 w; w.x = cvt_pk_bf16(v0[0], v0[1]); w.y = cvt_pk_bf16(v0[2], v0[3]); w.z = cvt_pk_bf16(v1[0], v1[1]); w.w = cvt_pk_bf16(v1[2], v1[3]);
                    *(u32x4*)(rp + bj * 128) = w; } }
    }
};
struct EpiGates {
    static constexpr bool PERM = true, ROWPERM = false;
    const bf16_t* REC; bf16_t* LA; bf16_t* BV; const float* b_a; const float* b_x; const float* lam;
    __device__ __forceinline__ void operator()(AccRef acc, const Unit& u, int wr, int wc, int fr, int fq) const {
        const int row0 = u.pm * 256 + wr * 64 + fr, col0 = u.pn * 128 + wc * 32 + 8 * fq;
        u32x4 rws[2][4];
#pragma unroll
        for (int ai = 0; ai < 2; ++ai)
#pragma unroll
            for (int m = 0; m < 4; ++m) rws[ai][m] = *(const u32x4*)(REC + (size_t)(row0 + ai * 128 + m * 16) * D + col0);
#pragma unroll
        for (int n = 0; n < 2; ++n) {
            const f32x4 ba = *(const f32x4*)(b_a + col0 + 4 * n), bx = *(const f32x4*)(b_x + col0 + 4 * n), l = *(const f32x4*)(lam + col0 + 4 * n);
            f32x4 k8;
#pragma unroll
            for (int j = 0; j < 4; ++j) k8[j] = -8.0f * __logf(1.0f + __expf(-l[j]));
#pragma unroll
            for (int ai = 0; ai < 2; ++ai)
#pragma unroll
                for (int m = 0; m < 4; ++m) { const size_t off = (size_t)(row0 + ai * 128 + m * 16) * D + col0 + 4 * n;
                    float lo[4], bo[4];
#pragma unroll
                    for (int j = 0; j < 4; ++j) { const unsigned w = rws[ai][m][2 * n + (j >> 1)]; const float rec = (j & 1) ? bfhi(w) : bflo(w);
                        const float r = sigmoidf_(acc[ai][0][m][n][j] + ba[j]), ig = sigmoidf_(acc[ai][1][m][n][j] + bx[j]);
                        const float la = k8[j] * r; const float mult = __builtin_sqrtf(1.0f - __expf(2.0f * la));
                        lo[j] = la; bo[j] = mult * ig * rec; }
                    *(u32x2*)(LA + off) = (u32x2){cvt_pk_bf16(lo[0], lo[1]), cvt_pk_bf16(lo[2], lo[3])}; *(u32x2*)(BV + off) = (u32x2){cvt_pk_bf16(bo[0], bo[1]), cvt_pk_bf16(bo[2], bo[3])}; }
        }
    }
};
struct EpiQKV {
    static constexpr bool PERM = true, ROWPERM = false;
    bf16_t* QKV; const float* qg; const float* kg;
    __device__ __forceinline__ void operator()(AccRef acc, const Unit& u, int wr, int wc, int fr, int fq) const {
        const int which = u.pn >> 2, row0 = u.pm * 256 + wr * 64 + fr, col0 = (u.pn & 3) * 256 + wc * 64 + 8 * fq;
        bf16_t* dst = QKV + (size_t)which * ((size_t)T * D);
        f32x4 gv[2][2];
#pragma unroll
        for (int bj = 0; bj < 2; ++bj)
#pragma unroll
            for (int n = 0; n < 2; ++n) { const f32x4 a = *(const f32x4*)(qg + 32 * bj + 8 * fq + 4 * n), b = *(const f32x4*)(kg + 32 * bj + 8 * fq + 4 * n);
                gv[bj][n] = which == 0 ? a : (which == 1 ? b : (f32x4){1.f, 1.f, 1.f, 1.f}); }
#pragma unroll
        for (int ai = 0; ai < 2; ++ai)
#pragma unroll
            for (int m = 0; m < 4; ++m) {
                float sc = 1.0f;
                if (which < 2) { float ss = 0.f;
#pragma unroll
                    for (int bj = 0; bj < 2; ++bj)
#pragma unroll
                        for (int n = 0; n < 2; ++n) { const f32x4 v = acc[ai][bj][m][n]; ss += (v[0] * v[0] + v[1] * v[1]) + (v[2] * v[2] + v[3] * v[3]); }
                    ss += __shfl_xor(ss, 16); ss += __shfl_xor(ss, 32);
                    sc = rsqrtf(ss * (1.0f / 64.0f) + 1e-6f) * (which == 0 ? 0.125f : 1.0f); }
                bf16_t* rp = dst + (size_t)(row0 + ai * 128 + m * 16) * D + col0;
#pragma unroll
                for (int bj = 0; bj < 2; ++bj) { const f32x4 v0 = acc[ai][bj][m][0] * gv[bj][0] * sc, v1 = acc[ai][bj][m][1] * gv[bj][1] * sc;
                    u32x4 w; w.x = cvt_pk_bf16(v0[0], v0[1]); w.y = cvt_pk_bf16(v0[2], v0[3]); w.z = cvt_pk_bf16(v1[0], v1[1]); w.w = cvt_pk_bf16(v1[2], v1[3]);
                    *(u32x4*)(rp + bj * 32) = w; } }
    }
};
struct EpiFfn1 {
    static constexpr bool PERM = true, ROWPERM = true;
    bf16_t* Aout; const float* cw; const float* cb; float* raw; LAS float* xch;
    __device__ __forceinline__ void operator()(AccRef acc, const Unit& u, int wr, int wc, int fr, int fq) const {
        const int clb = 32 * wc + 8 * fq;
        f32x4 cwv[2][8];
        { const float* cv = cw + 128 * u.pn + clb; const float* cg = cv + FH; const float* bp = cb + 128 * u.pn + clb;
          cwv[0][0] = *(const f32x4*)(cv); cwv[0][1] = *(const f32x4*)(cv + F2); cwv[0][2] = *(const f32x4*)(cv + 2 * F2); cwv[0][3] = *(const f32x4*)(bp);
          cwv[0][4] = *(const f32x4*)(cg); cwv[0][5] = *(const f32x4*)(cg + F2); cwv[0][6] = *(const f32x4*)(cg + 2 * F2); cwv[0][7] = *(const f32x4*)(bp + FH); }
        if (fr == 15) {
#pragma unroll
            for (int ai = 0; ai < 2; ++ai)
#pragma unroll
                for (int bj = 0; bj < 2; ++bj)
#pragma unroll
                    for (int n = 0; n < 2; ++n) { *(LAS f32x4*)(xch + ((ai * 2 + wr) * 2 + 0) * 256 + bj * 128 + clb + 4 * n) = acc[ai][bj][2][n]; *(LAS f32x4*)(xch + ((ai * 2 + wr) * 2 + 1) * 256 + bj * 128 + clb + 4 * n) = acc[ai][bj][3][n]; }
        }
        float* rawu = raw + (size_t)(u.pm * 22 + u.pn) * 1024;
        if (wr == 0 && fr == 0) {
#pragma unroll
            for (int bj = 0; bj < 2; ++bj)
#pragma unroll
                for (int n = 0; n < 2; ++n) { *(f32x4*)(rawu + 0 * 256 + bj * 128 + clb + 4 * n) = acc[0][bj][0][n]; *(f32x4*)(rawu + 1 * 256 + bj * 128 + clb + 4 * n) = acc[0][bj][1][n]; }
        }
        if (wr == 1 && fr == 15) {
#pragma unroll
            for (int bj = 0; bj < 2; ++bj)
#pragma unroll
                for (int n = 0; n < 2; ++n) { *(f32x4*)(rawu + 2 * 256 + bj * 128 + clb + 4 * n) = acc[1][bj][2][n]; *(f32x4*)(rawu + 3 * 256 + bj * 128 + clb + 4 * n) = acc[1][bj][3][n]; }
        }
        asm volatile("s_waitcnt lgkmcnt(0)" ::: "memory"); __builtin_amdgcn_s_barrier(); __builtin_amdgcn_s_barrier(); asm volatile("" ::: "memory");
        const int hc0 = 128 * u.pn + clb, row0 = u.pm * 256 + wr * 64 + 4 * fr;
#pragma unroll
        for (int n = 0; n < 2; ++n) {
            const f32x4 w0v = cwv[n][0], w1v = cwv[n][1], w2v = cwv[n][2], bvv = cwv[n][3], w0g = cwv[n][4], w1g = cwv[n][5], w2g = cwv[n][6], bvg = cwv[n][7];
#pragma unroll
            for (int ai = 0; ai < 2; ++ai) {
                if (n == 0 && ai == 0) {
                    asm volatile("" ::: "memory");
                    const float* cv = cw + hc0 + 4; const float* cg = cv + FH; const float* bp = cb + hc0 + 4;
                    cwv[1][0] = *(const f32x4*)(cv); cwv[1][1] = *(const f32x4*)(cv + F2); cwv[1][2] = *(const f32x4*)(cv + 2 * F2); cwv[1][3] = *(const f32x4*)(bp);
                    cwv[1][4] = *(const f32x4*)(cg); cwv[1][5] = *(const f32x4*)(cg + F2); cwv[1][6] = *(const f32x4*)(cg + 2 * F2); cwv[1][7] = *(const f32x4*)(bp + FH);
                    asm volatile("" ::: "memory"); }
                f32x4 h2v = (f32x4){0.f, 0.f, 0.f, 0.f}, h3v = h2v, h2g = h2v, h3g = h2v;
                const int pb = ai * 2 + wr - 1;
                if (pb >= 0 && fr == 0) { const LAS float* xp = xch + (pb * 2) * 256 + clb + 4 * n;
                    h2v = *(const LAS f32x4*)(xp); h3v = *(const LAS f32x4*)(xp + 256); h2g = *(const LAS f32x4*)(xp + 128); h3g = *(const LAS f32x4*)(xp + 256 + 128); }
                float o[4][4];
#pragma unroll
                for (int j = 0; j < 4; ++j) {
                    const float v0 = acc[ai][0][0][n][j], v1 = acc[ai][0][1][n][j], v2 = acc[ai][0][2][n][j], v3 = acc[ai][0][3][n][j];
                    const float g0 = acc[ai][1][0][n][j], g1 = acc[ai][1][1][n][j], g2 = acc[ai][1][2][n][j], g3 = acc[ai][1][3][n][j];
                    const float pv3 = dpp_upd<0x111>(h3v[j], v3), pv2 = dpp_upd<0x111>(h2v[j], v2), pg3 = dpp_upd<0x111>(h3g[j], g3), pg2 = dpp_upd<0x111>(h2g[j], g2);
                    const float hv0 = bvv[j] + w2v[j] * v0 + w1v[j] * pv3 + w0v[j] * pv2, hv1 = bvv[j] + w2v[j] * v1 + w1v[j] * v0 + w0v[j] * pv3;
                    const float hv2 = bvv[j] + w2v[j] * v2 + w1v[j] * v1 + w0v[j] * v0, hv3 = bvv[j] + w2v[j] * v3 + w1v[j] * v2 + w0v[j] * v1;
                    const float hg0 = bvg[j] + w2g[j] * g0 + w1g[j] * pg3 + w0g[j] * pg2, hg1 = bvg[j] + w2g[j] * g1 + w1g[j] * g0 + w0g[j] * pg3;
                    const float hg2 = bvg[j] + w2g[j] * g2 + w1g[j] * g1 + w0g[j] * g0, hg3 = bvg[j] + w2g[j] * g3 + w1g[j] * g2 + w0g[j] * g1;
                    o[0][j] = hg0 * sigmoidf_(hg0) * hv0; o[1][j] = hg1 * sigmoidf_(hg1) * hv1; o[2][j] = hg2 * sigmoidf_(hg2) * hv2; o[3][j] = hg3 * sigmoidf_(hg3) * hv3; }
#pragma unroll
                for (int m = 0; m < 4; ++m) { u32x2 w; w.x = cvt_pk_bf16(o[m][0], o[m][1]); w.y = cvt_pk_bf16(o[m][2], o[m][3]);
                    *(u32x2*)(Aout + (size_t)(row0 + ai * 128 + m) * FH + hc0 + 4 * n) = w; } } }
    }
};

#define XB_TMO      128
#define XB_XCNT(j)  (256  + 64 * (j))
#define XB_XSUB(j)  (1280 + 64 * (j))
#define XB_XGEN(j)  (2304 + 64 * (j))
#define XB_TOP      3328
#define XB_TOPGEN   3392
#define XCD_BAR_WORDS 3456
#define XB_SPIN_CAP (1u << 24)
__device__ __forceinline__ unsigned xb_ld(unsigned* p)              { return __hip_atomic_load(p, __ATOMIC_RELAXED, __HIP_MEMORY_SCOPE_AGENT); }
__device__ __forceinline__ unsigned xb_add(unsigned* p, unsigned v) { return __hip_atomic_fetch_add(p, v, __ATOMIC_RELAXED, __HIP_MEMORY_SCOPE_AGENT); }
__device__ __forceinline__ unsigned xb_xcc_id() { return (unsigned)__builtin_amdgcn_s_getreg((3 << 11) | 20) & 0xFu; }
#define XB_SPIN(cond, bar) do { unsigned _sp = 0; while (cond) { __builtin_amdgcn_s_sleep(1); \
    if ((++_sp & 255u) == 0u) { if (xb_ld(&(bar)[XB_TMO])) break; if (_sp > XB_SPIN_CAP) { atomicAdd(&(bar)[XB_TMO], 1u); break; } } } } while (0)
struct XcdBarrier { unsigned* bar; unsigned x; volatile LAS unsigned* st; };
__device__ __forceinline__ XcdBarrier xcd_barrier_post(unsigned* bar, volatile LAS unsigned* st) {
    XcdBarrier b; b.bar = bar; b.x = xb_xcc_id(); b.st = st;
    if (threadIdx.x == 0) (void)xb_add(&bar[XB_XCNT(b.x)], 1u);
    return b;
}
__device__ __forceinline__ void xcd_barrier_complete(unsigned* bar, unsigned x, unsigned& nloc, unsigned& nx) {
    const unsigned G = gridDim.x * gridDim.y * gridDim.z;
    unsigned sum, cnt, mine, sp = 0u;
    for (;;) {
        sum = 0u; cnt = 0u; mine = 0u;
#pragma unroll
        for (unsigned j = 0; j < 16; ++j) { const unsigned c = xb_ld(&bar[XB_XCNT(j)]); sum += c; cnt += (c > 0u) ? 1u : 0u; mine = (j == x) ? c : mine; }
        if (sum == G) break;
        __builtin_amdgcn_s_sleep(1);
        if ((++sp & 255u) == 0u) { if (xb_ld(&bar[XB_TMO])) break; if (sp > XB_SPIN_CAP) { atomicAdd(&bar[XB_TMO], 1u); break; } }
    }
    nloc = mine > 0u ? mine : 1u; nx = cnt > 0u ? cnt : 1u;
}
__device__ __forceinline__ void xcd_barrier(const XcdBarrier& b) {
    asm volatile("s_waitcnt vmcnt(0) lgkmcnt(0)" ::: "memory");
    __syncthreads();
    if (threadIdx.x == 0) {
        unsigned* bar = b.bar;
        __builtin_amdgcn_s_waitcnt(0);
        unsigned nloc = b.st[0], nx = b.st[1];
        if (nloc == 0u) { xcd_barrier_complete(bar, b.x, nloc, nx); b.st[0] = nloc; b.st[1] = nx; }
        const unsigned old = xb_add(&bar[XB_XSUB(b.x)], 1u);
        const unsigned gen = old / nloc;
        if (old + 1u == (gen + 1u) * nloc) {
            __builtin_amdgcn_fence(__ATOMIC_RELEASE, "agent");
            asm volatile("s_waitcnt vmcnt(0)" ::: "memory");
            const unsigned og = xb_add(&bar[XB_TOP], 1u);
            const unsigned tg = og / nx;
            if (og + 1u == (tg + 1u) * nx) xb_add(&bar[XB_TOPGEN], 1u);
            else XB_SPIN(xb_ld(&bar[XB_TOPGEN]) == tg, bar);
            __builtin_amdgcn_fence(__ATOMIC_ACQUIRE, "agent");
            xb_add(&bar[XB_XGEN(b.x)], 1u);
            asm volatile("s_waitcnt vmcnt(0)" ::: "memory");
        } else {
            XB_SPIN(xb_ld(&bar[XB_XGEN(b.x)]) == gen, bar);
            __builtin_amdgcn_fence(__ATOMIC_ACQUIRE, "agent");
            asm volatile("s_waitcnt vmcnt(0)" ::: "memory");
        }
    }
    __syncthreads();
}

struct Job { const float* src; bf16_t* dst; int K, ld, nrows, map, hh, item0; };
constexpr int NJOBS = 33;
struct Params {
    const float* in[33]; float* out; unsigned char* ws;
    Job jobs[NJOBS]; int nitems; int pad;
};

__device__ __forceinline__ int map_col(int map, int hh, int j) {
    if (map == 0) return j;
    if (map == 1) { const int pn = j >> 8, bj = (j >> 7) & 1, i = j & 127; return bj * hh + 128 * pn + i; }
    const int pn = j >> 8, cl = j & 255, bj = cl >> 7, h4 = (cl & 127) >> 5, i = cl & 31; return 256 * pn + 64 * h4 + 32 * bj + i;
}

__device__ __forceinline__ void weights_phase(const Params& P, LAS unsigned char* lds) {
    const int tid__ = otid(); const int lane = tid__ & 63, wave = tid__ >> 6;
    LAS float* scr = (LAS float*)(lds + wave * 8448);
    const int gw = blockIdx.x * 8 + wave, ngw = gridDim.x * 8;
    for (int it = gw; it < P.nitems; it += ngw) {
        int ji = 0;
#pragma unroll 1
        for (int q = 1; q < NJOBS; ++q) if (it >= P.jobs[q].item0) ji = q;
        const Job jb = P.jobs[ji];
        const int r = it - jb.item0, nblk = jb.nrows / 32, kb = r / nblk, nb = r % nblk, k0 = 64 * kb, n0 = 32 * nb, c0 = map_col(jb.map, jb.hh, n0);
#pragma unroll 8
        for (int i = 0; i < 32; ++i) { const int kk = 2 * i + (lane >> 5); scr[kk * 33 + (lane & 31)] = jb.src[(size_t)(k0 + kk) * jb.ld + c0 + (lane & 31)]; }
        asm volatile("s_waitcnt lgkmcnt(0)" ::: "memory");
        const int c = lane & 7;
#pragma unroll
        for (int j = 0; j < 4; ++j) { const int n = (lane >> 3) + 8 * j; const LAS float* s = scr + (8 * c) * 33 + n;
            u32x4 o; o.x = cvt_pk_bf16(s[0 * 33], s[1 * 33]); o.y = cvt_pk_bf16(s[2 * 33], s[3 * 33]); o.z = cvt_pk_bf16(s[4 * 33], s[5 * 33]); o.w = cvt_pk_bf16(s[6 * 33], s[7 * 33]);
            *(u32x4*)(jb.dst + (size_t)(n0 + n) * jb.K + k0 + 8 * c) = o; }
        asm volatile("s_waitcnt lgkmcnt(0)" ::: "memory");
    }
}
__device__ __forceinline__ void rmsnorm_phase(const float* x, const float* g, bf16_t* hn) {
    const int tid__ = otid(); const int lane = tid__ & 63, wave = tid__ >> 6;
    const int gw = blockIdx.x * 8 + wave, ngw = gridDim.x * 8;
    f32x4 gv[4];
#pragma unroll
    for (int j = 0; j < 4; ++j) gv[j] = *((const f32x4*)g + lane + 64 * j);
    f32x4 v[4];
    if (gw < T) {
#pragma unroll
        for (int j = 0; j < 4; ++j) v[j] = ((const f32x4*)(x + (size_t)gw * D) + lane)[64 * j]; }
    for (int m = gw; m < T; m += ngw) {
        f32x4 vn[4];
        const int mn = (m + ngw < T) ? m + ngw : m;
#pragma unroll
        for (int j = 0; j < 4; ++j) vn[j] = ((const f32x4*)(x + (size_t)mn * D) + lane)[64 * j];
        float s = 0.f;
#pragma unroll
        for (int j = 0; j < 4; ++j) s += (v[j][0] * v[j][0] + v[j][1] * v[j][1]) + (v[j][2] * v[j][2] + v[j][3] * v[j][3]);
        const float rstd = rsqrtf(wave_sum(s) * (1.0f / D) + 1e-6f);
        u32x2* o = (u32x2*)(hn + (size_t)m * D) + lane;
#pragma unroll
        for (int j = 0; j < 4; ++j) { const f32x4 y = v[j] * rstd * gv[j]; u32x2 w; w.x = cvt_pk_bf16(y[0], y[1]); w.y = cvt_pk_bf16(y[2], y[3]); o[64 * j] = w; }
#pragma unroll
        for (int j = 0; j < 4; ++j) v[j] = vn[j];
    }
}
__device__ __forceinline__ void ld8(const bf16_t* p, float (&v)[8]) {
    const u32x4 w = *(const u32x4*)p;
#pragma unroll
    for (int i = 0; i < 4; ++i) { v[2 * i] = bflo(w[i]); v[2 * i + 1] = bfhi(w[i]); }
}
__device__ __forceinline__ void st8(bf16_t* p, const float (&v)[8]) {
    u32x4 w; w.x = cvt_pk_bf16(v[0], v[1]); w.y = cvt_pk_bf16(v[2], v[3]); w.z = cvt_pk_bf16(v[4], v[5]); w.w = cvt_pk_bf16(v[6], v[7]);
    *(u32x4*)p = w;
}
__device__ __forceinline__ void pool_phase(const bf16_t* hn, bf16_t* dd) {
    for (int gid = blockIdx.x * NTHREADS + otid(); gid < (T / 32) * 128; gid += gridDim.x * NTHREADS) {
        const int col8 = gid & 127, chunk = gid >> 7, w = 2 << (col8 >> 5), t0 = chunk * 32, pos0 = t0 & (SEQ - 1);
        const bf16_t* hp = hn + (size_t)t0 * D + col8 * 8; bf16_t* dp = dd + (size_t)t0 * D + col8 * 8;
        float s[8];
#pragma unroll
        for (int i = 0; i < 8; ++i) s[i] = 0.f;
        if (pos0) for (int k = 1; k <= w; ++k) { float v[8]; ld8(hp - (size_t)k * D, v);
#pragma unroll
            for (int i = 0; i < 8; ++i) s[i] += v[i]; }
        for (int i = 0; i < 32; ++i) {
            float cur[8]; ld8(hp + (size_t)i * D, cur); const int pos = pos0 + i;
#pragma unroll
            for (int q = 0; q < 8; ++q) s[q] += cur[q];
            if (pos >= w) { float v[8]; ld8(hp + (size_t)(i - w) * D, v);
#pragma unroll
                for (int q = 0; q < 8; ++q) s[q] -= v[q]; }
            const float inv = 1.0f / (float)(pos + 1 < w ? pos + 1 : w);
            float o[8];
#pragma unroll
            for (int q = 0; q < 8; ++q) o[q] = s[q] * inv - cur[q];
            st8(dp + (size_t)i * D, o);
        }
    }
}
__device__ __forceinline__ void lruconv_phase(const bf16_t* pre, const float* cw, const float* cb, bf16_t* rec) {
    for (int gid = blockIdx.x * NTHREADS + otid(); gid < (T / 32) * 128; gid += gridDim.x * NTHREADS) {
        const int col8 = gid & 127, chunk = gid >> 7, t0 = chunk * 32, pos0 = t0 & (SEQ - 1);
        const bf16_t* hp = pre + (size_t)t0 * D + col8 * 8; bf16_t* dp = rec + (size_t)t0 * D + col8 * 8;
        float w0[8], w1[8], w2[8], w3[8], bb[8], p3[8], p2[8], p1[8];
#pragma unroll
        for (int i = 0; i < 8; ++i) { w0[i] = cw[col8 * 8 + i]; w1[i] = cw[D + col8 * 8 + i]; w2[i] = cw[2 * D + col8 * 8 + i]; w3[i] = cw[3 * D + col8 * 8 + i]; bb[i] = cb[col8 * 8 + i]; p3[i] = 0.f; p2[i] = 0.f; p1[i] = 0.f; }
        if (pos0) { ld8(hp - 3 * (size_t)D, p3); ld8(hp - 2 * (size_t)D, p2); ld8(hp - (size_t)D, p1); }
        for (int i = 0; i < 32; ++i) {
            float cur[8], o[8]; ld8(hp + (size_t)i * D, cur);
#pragma unroll
            for (int q = 0; q < 8; ++q) { o[q] = bb[q] + w0[q] * p3[q] + w1[q] * p2[q] + w2[q] * p1[q] + w3[q] * cur[q]; p3[q] = p2[q]; p2[q] = p1[q]; p1[q] = cur[q]; }
            st8(dp + (size_t)i * D, o);
        }
    }
}
__device__ __forceinline__ void lruscan_phase(const bf16_t* LA, const bf16_t* BV, bf16_t* GG, LAS unsigned char* lds) {
    LAS float* sA = (LAS float*)lds; LAS float* sB = sA + 64 * 64;
    const int tid__ = otid(); const int c8 = tid__ & 7, tc = tid__ >> 3;
    for (int unit = blockIdx.x; unit < 256; unit += gridDim.x) {
        const int b = unit >> 4, cgp = unit & 15;
        const size_t base = ((size_t)b * SEQ + tc * 32) * D + cgp * 64 + c8 * 8;
        float sl[8], Bv[8], h[8];
#pragma unroll
        for (int q = 0; q < 8; ++q) { sl[q] = 0.f; Bv[q] = 0.f; h[q] = 0.f; }
#pragma unroll 4
        for (int i = 0; i < 32; ++i) { float la[8], bb[8]; ld8(LA + base + (size_t)i * D, la); ld8(BV + base + (size_t)i * D, bb);
#pragma unroll
            for (int q = 0; q < 8; ++q) { Bv[q] = __expf(la[q]) * Bv[q] + bb[q]; sl[q] += la[q]; } }
#pragma unroll
        for (int q = 0; q < 8; ++q) { sA[tc * 64 + c8 * 8 + q] = __expf(sl[q]); sB[tc * 64 + c8 * 8 + q] = Bv[q]; }
        __syncthreads();
        for (int j = 0; j < tc; ++j) {
            const f32x4 a0 = *(const LAS f32x4*)(sA + j * 64 + c8 * 8), a1 = *(const LAS f32x4*)(sA + j * 64 + c8 * 8 + 4), b0 = *(const LAS f32x4*)(sB + j * 64 + c8 * 8), b1 = *(const LAS f32x4*)(sB + j * 64 + c8 * 8 + 4);
#pragma unroll
            for (int q = 0; q < 4; ++q) { h[q] = a0[q] * h[q] + b0[q]; h[4 + q] = a1[q] * h[4 + q] + b1[q]; } }
#pragma unroll 4
        for (int i = 0; i < 32; ++i) { float la[8], bb[8], gg[8], y[8]; ld8(LA + base + (size_t)i * D, la); ld8(BV + base + (size_t)i * D, bb); ld8(GG + base + (size_t)i * D, gg);
#pragma unroll
            for (int q = 0; q < 8; ++q) { h[q] = __expf(la[q]) * h[q] + bb[q]; y[q] = gg[q] * h[q]; }
            st8(GG + base + (size_t)i * D, y); }
        __syncthreads();
    }
}
__device__ __forceinline__ void ffn_fix_panel(const float* raw, const float* cw, const float* cb, bf16_t* Aout, int pm) {
    if ((pm & 7) == 0) return;
    const int tid = otid();
    float x0[11][2], x1[11][2], x2[11][2], w0[11][2], w1[11][2], w2[11][2], bb[11][2];
#pragma unroll
    for (int k = 0; k < 11; ++k) {
        const int idx = tid + k * NTHREADS, hc = idx % FH, rr = idx / FH, pn = hc >> 7, cl = hc & 127;
        const float* cur = raw + (size_t)(pm * 22 + pn) * 1024; const float* prv = raw + (size_t)((pm - 1) * 22 + pn) * 1024;
#pragma unroll
        for (int part = 0; part < 2; ++part) { const int off = part * 128 + cl, col = part * FH + hc;
            x0[k][part] = cur[rr * 256 + off]; x1[k][part] = rr ? cur[off] : prv[3 * 256 + off]; x2[k][part] = rr ? prv[3 * 256 + off] : prv[2 * 256 + off];
            bb[k][part] = cb[col]; w2[k][part] = cw[2 * F2 + col]; w1[k][part] = cw[F2 + col]; w0[k][part] = cw[col]; }
    }
#pragma unroll
    for (int k = 0; k < 11; ++k) {
        const int idx = tid + k * NTHREADS, hc = idx % FH, rr = idx / FH;
        const float hv = bb[k][0] + w2[k][0] * x0[k][0] + w1[k][0] * x1[k][0] + w0[k][0] * x2[k][0];
        const float hg = bb[k][1] + w2[k][1] * x0[k][1] + w1[k][1] * x1[k][1] + w0[k][1] * x2[k][1];
        const float o = hg * sigmoidf_(hg) * hv;
        Aout[(size_t)(pm * 256 + rr) * FH + hc] = (bf16_t)(cvt_pk_bf16(o, 0.f) & 0xffffu);
    }
}

__device__ __forceinline__ void s5_phase(const Params& P, const bf16_t* hn, bf16_t* ys, LAS unsigned char* lds) {
    const int tid__ = otid(); const int lane = tid__ & 63, wave = tid__ >> 6;
    if (wave >= 4) return;
    LAS unsigned* S = (LAS unsigned*)(lds + wave * 8704);
    const float* lam_re = P.in[6]; const float* lam_im = P.in[7]; const float* log_dt = P.in[8]; const float* b_re = P.in[9]; const float* b_im = P.in[10];
    const float* c_re = P.in[11]; const float* c_im = P.in[12]; const float* dsk = P.in[13];
    const int c32 = lane & 31, hf = lane >> 5, c16 = lane & 15, q4 = lane >> 4;
    for (int unit = blockIdx.x * 4 + wave; unit < 1024; unit += gridDim.x * 4) {
        const int b = unit >> 6, g = unit & 63;
        const float dt = expf(log_dt[g]);
        float ar, ai;
        { const float lr = fminf(lam_re[g * 64 + lane], -1e-4f), li = lam_im[g * 64 + lane]; const float er = expf(lr * dt); ar = er * cosf(li * dt); ai = er * sinf(li * dt); }
        bf16x8 Bre[2], Bim[2];
#pragma unroll
        for (int pb = 0; pb < 2; ++pb) {
            const int pp = pb * 32 + c32;
            const float lr = fminf(lam_re[g * 64 + pp], -1e-4f), li = lam_im[g * 64 + pp]; const float er = expf(lr * dt);
            const float nr = er * cosf(li * dt) - 1.0f, ni = er * sinf(li * dt), dd = lr * lr + li * li;
            const float cr = (nr * lr + ni * li) / dd, ci = (ni * lr - nr * li) / dd;
            const float* br = b_re + (size_t)(g * 64 + pp) * 16 + 8 * hf; const float* bi = b_im + (size_t)(g * 64 + pp) * 16 + 8 * hf;
            unsigned wr_[4], wi_[4];
#pragma unroll
            for (int i = 0; i < 4; ++i) { const float r0 = br[2 * i], i0 = bi[2 * i], r1 = br[2 * i + 1], i1 = bi[2 * i + 1];
                wr_[i] = cvt_pk_bf16(cr * r0 - ci * i0, cr * r1 - ci * i1); wi_[i] = cvt_pk_bf16(cr * i0 + ci * r0, cr * i1 + ci * r1); }
            Bre[pb] = __builtin_bit_cast(bf16x8, (u32x4){wr_[0], wr_[1], wr_[2], wr_[3]}); Bim[pb] = __builtin_bit_cast(bf16x8, (u32x4){wi_[0], wi_[1], wi_[2], wi_[3]});
        }
        bf16x8 Cf[4];
#pragma unroll
        for (int kb = 0; kb < 4; ++kb) { const int p0 = kb * 16 + 4 * q4; const float* cr = c_re + (size_t)(g * 16 + c16) * 64 + p0; const float* ci = c_im + (size_t)(g * 16 + c16) * 64 + p0;
            Cf[kb] = __builtin_bit_cast(bf16x8, (u32x4){cvt_pk_bf16(cr[0], -ci[0]), cvt_pk_bf16(cr[1], -ci[1]), cvt_pk_bf16(cr[2], -ci[2]), cvt_pk_bf16(cr[3], -ci[3])}); }
        float dk[4];
#pragma unroll
        for (int r = 0; r < 4; ++r) dk[r] = dsk[g * 16 + 4 * q4 + r];
        float sr = 0.f, si = 0.f;
        const bf16_t* hb = hn + (size_t)b * SEQ * D + g * 16; bf16_t* yb = ys + (size_t)b * SEQ * D + g * 16;
        bf16x8 ufn = *(const bf16x8*)(hb + (size_t)c32 * D + 8 * hf);
        u32x2 uwn[2];
#pragma unroll
        for (int tb = 0; tb < 2; ++tb) uwn[tb] = *(const u32x2*)(hb + (size_t)(tb * 16 + c16) * D + 4 * q4);
        for (int c = 0; c < SEQ / 32; ++c) {
            const int t0 = c * 32;
            const bf16x8 uf = ufn; const u32x2 uwc[2] = {uwn[0], uwn[1]};
            { const int tn = (c + 1 < SEQ / 32) ? t0 + 32 : t0;
              ufn = *(const bf16x8*)(hb + (size_t)(tn + c32) * D + 8 * hf);
#pragma unroll
              for (int tb = 0; tb < 2; ++tb) uwn[tb] = *(const u32x2*)(hb + (size_t)(tn + tb * 16 + c16) * D + 4 * q4); }
            const f32x16 z16 = {0.f, 0.f, 0.f, 0.f, 0.f, 0.f, 0.f, 0.f, 0.f, 0.f, 0.f, 0.f, 0.f, 0.f, 0.f, 0.f};
            f32x16 r0 = __builtin_amdgcn_mfma_f32_32x32x16_bf16(uf, Bre[0], z16, 0, 0, 0), r1 = __builtin_amdgcn_mfma_f32_32x32x16_bf16(uf, Bre[1], z16, 0, 0, 0);
            f32x16 i0 = __builtin_amdgcn_mfma_f32_32x32x16_bf16(uf, Bim[0], z16, 0, 0, 0), i1 = __builtin_amdgcn_mfma_f32_32x32x16_bf16(uf, Bim[1], z16, 0, 0, 0);
#pragma unroll
            for (int q = 0; q < 4; ++q) {
                float xr[8], xi[8];
#pragma unroll
                for (int i = 0; i < 4; ++i) {
                    auto pr = __builtin_amdgcn_permlane32_swap(__float_as_uint(r0[4 * q + i]), __float_as_uint(r1[4 * q + i]), false, false);
                    auto pi = __builtin_amdgcn_permlane32_swap(__float_as_uint(i0[4 * q + i]), __float_as_uint(i1[4 * q + i]), false, false);
                    xr[i] = __uint_as_float(pr[0]); xr[4 + i] = __uint_as_float(pr[1]); xi[i] = __uint_as_float(pi[0]); xi[4 + i] = __uint_as_float(pi[1]); }
#pragma unroll
                for (int i = 0; i < 8; ++i) { const float nr = ar * sr - ai * si + xr[i], ni = ar * si + ai * sr + xi[i]; sr = nr; si = ni;
                    S[(8 * q + i) * 68 + lane] = cvt_pk_bf16(sr, si); }
            }
            asm volatile("" ::: "memory");
#pragma unroll
            for (int tb = 0; tb < 2; ++tb) {
                f32x4 y = (f32x4){0.f, 0.f, 0.f, 0.f};
#pragma unroll
                for (int kb = 0; kb < 4; ++kb) { const bf16x8 sf = __builtin_bit_cast(bf16x8, *(const LAS u32x4*)(S + (tb * 16 + c16) * 68 + kb * 16 + 4 * q4));
                    y = __builtin_amdgcn_mfma_f32_16x16x32_bf16(Cf[kb], sf, y, 0, 0, 0); }
                const size_t off = (size_t)(t0 + tb * 16 + c16) * D + 4 * q4;
                const u32x2 uw = uwc[tb];
                const float u0 = bflo(uw.x), u1 = bfhi(uw.x), u2 = bflo(uw.y), u3 = bfhi(uw.y);
                u32x2 w; w.x = cvt_pk_bf16(gelu_tanh(y[0] + dk[0] * u0), gelu_tanh(y[1] + dk[1] * u1)); w.y = cvt_pk_bf16(gelu_tanh(y[2] + dk[2] * u2), gelu_tanh(y[3] + dk[3] * u3));
                *(u32x2*)(yb + off) = w;
            }
        }
    }
}

__device__ __forceinline__ void attn_phase(const bf16_t* Q, const bf16_t* Kb, const bf16_t* V, bf16_t* VT, bf16_t* O, LAS unsigned char* lds) {
    const int tid__ = otid(); const int lane = tid__ & 63, wave = tid__ >> 6, c32 = lane & 31, hf = lane >> 5;
    for (int bh = blockIdx.x; bh < 256; bh += gridDim.x) {
        const int b = bh >> 4, h = bh & 15;
        bf16_t* vtw = VT + (size_t)(b * 16 + h) * 64 * SEQ;
        {
            LAS bf16_t* scr = (LAS bf16_t*)(lds + wave * 8704);
            for (int st = wave * 4; st < wave * 4 + 4; ++st) {
                const int s0 = st * 64;
#pragma unroll
                for (int j = 0; j < 8; ++j) { const int i = (lane >> 3) + 8 * j, c = lane & 7;
                    const u32x4 w = *(const u32x4*)(V + (size_t)(b * SEQ + s0 + i) * D + h * 64 + 8 * c);
                    *(LAS u32x2*)(scr + i * 68 + 8 * c) = (u32x2){w.x, w.y}; *(LAS u32x2*)(scr + i * 68 + 8 * c + 4) = (u32x2){w.z, w.w}; }
                asm volatile("s_waitcnt lgkmcnt(0)" ::: "memory");
#pragma unroll
                for (int j = 0; j < 8; ++j) { const int d = (lane >> 3) + 8 * j, c = lane & 7;
                    unsigned short e[8];
#pragma unroll
                    for (int k = 0; k < 8; ++k) e[k] = scr[(8 * c + k) * 68 + d];
                    u32x4 w; w.x = e[0] | ((unsigned)e[1] << 16); w.y = e[2] | ((unsigned)e[3] << 16); w.z = e[4] | ((unsigned)e[5] << 16); w.w = e[6] | ((unsigned)e[7] << 16);
                    *(u32x4*)(vtw + (size_t)d * SEQ + s0 + 8 * c) = w; }
                asm volatile("s_waitcnt lgkmcnt(0)" ::: "memory");
            }
            asm volatile("s_waitcnt vmcnt(0)" ::: "memory"); __syncthreads();
        }
        const bf16_t* vtb = vtw;
        for (int it = 0; it < 8; ++it) {
            const int qb = wave * 8 + it, t0 = qb * 32;
            const bf16_t* qp = Q + (size_t)(b * SEQ + t0 + c32) * D + h * 64 + 8 * hf;
            bf16x8 qf[4];
#pragma unroll
            for (int kd = 0; kd < 4; ++kd) qf[kd] = *(const bf16x8*)(qp + 16 * kd);
            f32x16 o0 = {0.f, 0.f, 0.f, 0.f, 0.f, 0.f, 0.f, 0.f, 0.f, 0.f, 0.f, 0.f, 0.f, 0.f, 0.f, 0.f}, o1 = o0;
            float R = 0.f;
            bf16x8 kfn[4];
            { const bf16_t* kp = Kb + (size_t)(b * SEQ + qb * 32 + c32) * D + h * 64 + 8 * hf;
#pragma unroll
              for (int kd = 0; kd < 4; ++kd) kfn[kd] = *(const bf16x8*)(kp + 16 * kd); }
            for (int kt = qb; kt >= 0; --kt) {
                const int s0 = kt * 32;
                f32x16 z = {0.f, 0.f, 0.f, 0.f, 0.f, 0.f, 0.f, 0.f, 0.f, 0.f, 0.f, 0.f, 0.f, 0.f, 0.f, 0.f};
#pragma unroll
                for (int kd = 0; kd < 4; ++kd) z = __builtin_amdgcn_mfma_f32_32x32x16_bf16(kfn[kd], qf[kd], z, 0, 0, 0);
                { const int sn = kt > 0 ? s0 - 32 : s0;
                  const bf16_t* kp = Kb + (size_t)(b * SEQ + sn + c32) * D + h * 64 + 8 * hf;
#pragma unroll
                  for (int kd = 0; kd < 4; ++kd) kfn[kd] = *(const bf16x8*)(kp + 16 * kd); }
                bf16x8 vf[2][2];
#pragma unroll
                for (int db = 0; db < 2; ++db)
#pragma unroll
                    for (int ks = 0; ks < 2; ++ks) { const bf16_t* vp = vtb + (size_t)(db * 32 + c32) * SEQ + s0 + 16 * ks + 4 * hf;
                        const u32x2 a = *(const u32x2*)vp, c = *(const u32x2*)(vp + 8); vf[db][ks] = __builtin_bit_cast(bf16x8, (u32x4){a.x, a.y, c.x, c.y}); }
                float L[16], lg[16];
                const bool diag = (kt == qb);
#pragma unroll
                for (int r = 0; r < 16; ++r) { const float zz = z[r]; const float sp = fmaxf(zz, 0.f) + __logf(1.0f + __expf(-fabsf(zz)));
                    const int sl = 8 * (r >> 2) + 4 * hf + (r & 3); const bool valid = !diag || (sl < c32);
                    L[r] = valid ? -sp : 0.f; lg[r] = valid ? zz - sp : -1e30f; }
                float bs[4], pbs[4];
#pragma unroll
                for (int q = 0; q < 4; ++q) { bs[q] = (L[4 * q] + L[4 * q + 1]) + (L[4 * q + 2] + L[4 * q + 3]); pbs[q] = __shfl_xor(bs[q], 32); }
                float after = R; float att[16];
#pragma unroll
                for (int q = 3; q >= 0; --q) {
                    const float off = after + (hf == 0 ? pbs[q] : 0.f);
                    const float e3 = off, e2 = e3 + L[4 * q + 3], e1 = e2 + L[4 * q + 2], e0 = e1 + L[4 * q + 1];
                    att[4 * q + 3] = __expf(lg[4 * q + 3] + e3); att[4 * q + 2] = __expf(lg[4 * q + 2] + e2); att[4 * q + 1] = __expf(lg[4 * q + 1] + e1); att[4 * q] = __expf(lg[4 * q] + e0);
                    after += bs[q] + pbs[q];
                }
                R = after;
#pragma unroll
                for (int ks = 0; ks < 2; ++ks) {
                    const bf16x8 pf = __builtin_bit_cast(bf16x8, (u32x4){cvt_pk_bf16(att[8 * ks], att[8 * ks + 1]), cvt_pk_bf16(att[8 * ks + 2], att[8 * ks + 3]), cvt_pk_bf16(att[8 * ks + 4], att[8 * ks + 5]), cvt_pk_bf16(att[8 * ks + 6], att[8 * ks + 7])});
                    o0 = __builtin_amdgcn_mfma_f32_32x32x16_bf16(vf[0][ks], pf, o0, 0, 0, 0); o1 = __builtin_amdgcn_mfma_f32_32x32x16_bf16(vf[1][ks], pf, o1, 0, 0, 0); }
                if (__all(R < -120.0f)) break;
            }
            bf16_t* op = O + (size_t)(b * SEQ + t0 + c32) * D + h * 64 + 4 * hf;
#pragma unroll
            for (int q = 0; q < 4; ++q) {
                u32x2 w0; w0.x = cvt_pk_bf16(o0[4 * q], o0[4 * q + 1]); w0.y = cvt_pk_bf16(o0[4 * q + 2], o0[4 * q + 3]); *(u32x2*)(op + 8 * q) = w0;
                u32x2 w1; w1.x = cvt_pk_bf16(o1[4 * q], o1[4 * q + 1]); w1.y = cvt_pk_bf16(o1[4 * q + 2], o1[4 * q + 3]); *(u32x2*)(op + 32 + 8 * q) = w1; }
        }
    }
}


__global__ void __launch_bounds__(NTHREADS, 2) fwd_megakernel(Params P) {
    extern __shared__ __attribute__((aligned(16))) unsigned char lds_raw[];
    LAS unsigned char* lds = (LAS unsigned char*)lds_raw;
    cg::grid_group grid = cg::this_grid();
    unsigned char* ws = P.ws;
    bf16_t* HN = (bf16_t*)(ws + WS_HN);
    bf16_t* B0 = (bf16_t*)(ws + WS_BIG); bf16_t* B1 = (bf16_t*)(ws + WS_BIG + ACT); bf16_t* B2 = (bf16_t*)(ws + WS_BIG + 2 * ACT); bf16_t* B3 = (bf16_t*)(ws + WS_BIG + 3 * ACT); bf16_t* B4 = (bf16_t*)(ws + WS_BIG + 4 * ACT);
    float* RAW = (float*)(ws + WS_RAW);
    float* X = P.out;
    const int G = gridDim.x, bx = blockIdx.x;
    pg8::StaticOrder S;
    volatile LAS unsigned* MISC = (volatile LAS unsigned*)(lds + MISC_OFF);
    if (threadIdx.x < 2) MISC[threadIdx.x] = 0u;
    __syncthreads();
    const XcdBarrier bar = xcd_barrier_post((unsigned*)ws, MISC);
    grid.sync();
#define SYNC() xcd_barrier(bar)

    weights_phase(P, lds);
    rmsnorm_phase(P.in[0], P.in[1], HN);
    SYNC();
#define FFN_BLOCK(layer, LASTSYNC) do { \
        rmsnorm_phase(X, P.in[2] + (layer) * D, HN); \
        SYNC(); \
        const float* cw = P.in[30] + (size_t)(layer) * 3 * F2; const float* cb = P.in[31] + (size_t)(layer) * F2; \
        { pg8::Gemm g{HN, (const bf16_t*)(ws + WS_WF1) + (size_t)(layer) * F2 * D, T, F2, 1024, D, D, 0, 0}; S.init(T, F2, G, bx); \
          EpiFfn1 E{B0, cw, cb, RAW, (LAS float*)(lds + XCH_OFF)}; pg8::gemm_phase(lds, g, S, E); } \
        SYNC(); \
        { pg8::Gemm g{B0, (const bf16_t*)(ws + WS_WF2) + (size_t)(layer) * D * FH, T, 1024, FH, FH, FH, 0, 0}; S.init(T, 1024, G, bx); \
          { Unit fu; int lastpm = -1; for (int i = 0; S.next(i, fu); ++i) if (fu.pm != lastpm) { ffn_fix_panel(RAW, cw, cb, B0, fu.pm); lastpm = fu.pm; } } \
          asm volatile("s_waitcnt vmcnt(0)" ::: "memory"); __syncthreads(); \
          EpiRes E{X, X, nullptr, nullptr}; pg8::gemm_phase(lds, g, S, E); } \
        if (LASTSYNC) SYNC(); } while (0)

    pool_phase(HN, B0);
    SYNC();
    { pg8::Gemm g{B0, (const bf16_t*)(ws + WS_WPOOL), T, 1024, 256, D, 256, 0, 512}; S.init(T, 1024, G, bx);
      EpiRes E{P.in[0], X, P.in[5], P.in[4]}; pg8::gemm_phase(lds, g, S, E); }
    SYNC();
    FFN_BLOCK(0, true);
    rmsnorm_phase(X, P.in[1] + 1 * D, HN);
    SYNC();
    s5_phase(P, HN, B0, lds);
    SYNC();
    { pg8::Gemm g{B0, (const bf16_t*)(ws + WS_WS5), T, 2048, 1024, D, D, 0, 0}; S.init(T, 2048, G, bx);
      EpiGateRes E{X, P.in[15]}; pg8::gemm_phase(lds, g, S, E); }
    SYNC();
    FFN_BLOCK(1, true);
    rmsnorm_phase(X, P.in[1] + 2 * D, HN);
    SYNC();
    { pg8::Gemm g{HN, (const bf16_t*)(ws + WS_WLIN), T, 2048, 1024, D, D, 0, 0}; S.init(T, 2048, G, bx);
      EpiLruIn E{B0, B1}; pg8::gemm_phase(lds, g, S, E); }
    SYNC();
    lruconv_phase(B1, P.in[17], P.in[18], B2);
    SYNC();
    { pg8::Gemm g{B2, (const bf16_t*)(ws + WS_WGATE), T, 2048, 256, D, 256, 1, 512}; S.init(T, 2048, G, bx);
      EpiGates E{B2, B3, B4, P.in[20], P.in[22], P.in[23]}; pg8::gemm_phase(lds, g, S, E); }
    SYNC();
    lruscan_phase(B3, B4, B0, lds);
    SYNC();
    { pg8::Gemm g{B0, (const bf16_t*)(ws + WS_WLOUT), T, 1024, 1024, D, D, 0, 0}; S.init(T, 1024, G, bx);
      EpiRes E{X, X, nullptr, nullptr}; pg8::gemm_phase(lds, g, S, E); }
    SYNC();
    FFN_BLOCK(2, true);
    rmsnorm_phase(X, P.in[1] + 3 * D, HN);
    SYNC();
    { pg8::Gemm g{HN, (const bf16_t*)(ws + WS_WQKV), T, 3072, 1024, D, D, 0, 0}; S.init(T, 3072, G, bx);
      EpiQKV E{B0, P.in[26], P.in[27]}; pg8::gemm_phase(lds, g, S, E); }
    SYNC();
    attn_phase(B0, B1, B2, B3, B4, lds);
    SYNC();
    { pg8::Gemm g{B4, (const bf16_t*)(ws + WS_WWO), T, 1024, 1024, D, D, 0, 0}; S.init(T, 1024, G, bx);
      EpiRes E{X, X, nullptr, nullptr}; pg8::gemm_phase(lds, g, S, E); }
    SYNC();
    FFN_BLOCK(3, false);
}

extern "C" void kernel_launch(void* const* d_in, const int* in_sizes, int n_in, void* d_out, int out_size, void* d_ws, size_t ws_size, hipStream_t stream) {
    static int grid = 0;
    if (grid == 0) {
        if (n_in != 33 || out_size != T * D || ws_size < WS_END) { fprintf(stderr, "kernel_launch: unexpected shapes (n_in %d out %d ws %zu)\n", n_in, out_size, ws_size); grid = -1; return; }
        int dev = 0, cus = 0, per_cu = 0;
        (void)hipGetDevice(&dev); (void)hipDeviceGetAttribute(&cus, hipDeviceAttributeMultiprocessorCount, dev);
        if (hipFuncSetAttribute((const void*)fwd_megakernel, hipFuncAttributeMaxDynamicSharedMemorySize, LDS_BYTES) != hipSuccess) { fprintf(stderr, "kernel_launch: hipFuncSetAttribute failed\n"); grid = -1; return; }
        (void)hipOccupancyMaxActiveBlocksPerMultiprocessor(&per_cu, (const void*)fwd_megakernel, NTHREADS, LDS_BYTES);
        (void)hipGetLastError();
        if (per_cu < 1) per_cu = 1;
        grid = cus * per_cu;
        if (grid > 256) grid = 256;
    }
    if (grid < 0) return;
    Params p; memset(&p, 0, sizeof(p));
    for (int i = 0; i < 33; ++i) p.in[i] = (const float*)d_in[i];
    p.out = (float*)d_out; p.ws = (unsigned char*)d_ws;
    unsigned char* ws = (unsigned char*)d_ws;
    int nj = 0, items = 0;
    auto add = [&](const float* src, bf16_t* dst, int K, int ld, int nrows, int map, int hh) {
        Job& j = p.jobs[nj++]; j.src = src; j.dst = dst; j.K = K; j.ld = ld; j.nrows = nrows; j.map = map; j.hh = hh; j.item0 = items; items += (K / 64) * (nrows / 32); };
    for (int l = 0; l < 4; ++l) add(p.in[29] + (size_t)l * D * F2, (bf16_t*)(ws + WS_WF1) + (size_t)l * F2 * D, 1024, F2, F2, 1, FH);
    for (int l = 0; l < 4; ++l) add(p.in[32] + (size_t)l * FH * D, (bf16_t*)(ws + WS_WF2) + (size_t)l * D * FH, FH, D, D, 0, 0);
    for (int gI = 0; gI < 4; ++gI) add(p.in[3] + (size_t)gI * 65536, (bf16_t*)(ws + WS_WPOOL) + (size_t)gI * 65536, 256, 256, 256, 0, 0);
    add(p.in[14], (bf16_t*)(ws + WS_WS5), 1024, 2048, 2048, 1, 1024);
    add(p.in[16], (bf16_t*)(ws + WS_WLIN), 1024, 2048, 2048, 0, 0);
    for (int pn = 0; pn < 8; ++pn) for (int bj = 0; bj < 2; ++bj)
        add((bj ? p.in[21] : p.in[19]) + (size_t)(pn >> 1) * 65536 + (pn & 1) * 128, (bf16_t*)(ws + WS_WGATE) + (size_t)(pn * 256 + bj * 128) * 256, 256, 256, 128, 0, 0);
    add(p.in[24], (bf16_t*)(ws + WS_WLOUT), 1024, 1024, 1024, 0, 0);
    add(p.in[25], (bf16_t*)(ws + WS_WQKV), 1024, 3072, 3072, 2, 0);
    add(p.in[28], (bf16_t*)(ws + WS_WWO), 1024, 1024, 1024, 0, 0);
    p.nitems = items;
    if (hipMemsetAsync(d_ws, 0, 16384, stream) != hipSuccess) { fprintf(stderr, "kernel_launch: memset failed\n"); return; }
    void* args[] = {&p};
    hipError_t e = hipLaunchCooperativeKernel((const void*)fwd_megakernel, dim3(grid), dim3(NTHREADS), args, LDS_BYTES, stream);
    if (e != hipSuccess) fprintf(stderr, "cooperative launch failed: %s (grid %d)\n", hipGetErrorString(e), grid);
}
```

```cpp
#include <hip/hip_runtime.h>
#include <hip/hip_cooperative_groups.h>
#include <cstdio>
#include <cstring>
namespace cg = cooperative_groups;

#define LAS __attribute__((address_space(3)))
typedef unsigned short bf16_t;
typedef short bf16x8 __attribute__((ext_vector_type(8)));
typedef short bf16x4 __attribute__((ext_vector_type(4)));
typedef float f32x4 __attribute__((ext_vector_type(4)));
typedef float f32x16 __attribute__((ext_vector_type(16)));
typedef unsigned u32x4 __attribute__((ext_vector_type(4)));
typedef unsigned u32x2 __attribute__((ext_vector_type(2)));

constexpr int T = 32768, D = 1024, SEQ = 2048, FH = 2816, F2 = 5632;
constexpr int NTHREADS = 512;
constexpr int LDS_BYTES = 147456;
constexpr int XCH_OFF = 131072, MISC_OFF = 131072 + 12288;
constexpr size_t MiB = 1u << 20;
constexpr size_t WS_WPOOL = 1 * MiB, WS_WS5 = 2 * MiB, WS_WLIN = 6 * MiB, WS_WGATE = 10 * MiB, WS_WLOUT = 11 * MiB,
                 WS_WQKV = 13 * MiB, WS_WWO = 19 * MiB, WS_WF1 = 21 * MiB, WS_WF2 = 65 * MiB,
                 WS_HN = 96 * MiB, WS_BIG = 160 * MiB, WS_RAW = 480 * MiB, WS_RAWL = 492 * MiB, WS_END = 496 * MiB;
constexpr size_t ACT = 64 * MiB;

typedef __bf16 bf16v2_t __attribute__((ext_vector_type(2)));
__device__ __forceinline__ unsigned cvt_pk_bf16(float lo, float hi) { const bf16v2_t v = {(__bf16)lo, (__bf16)hi}; return __builtin_bit_cast(unsigned, v); }
__device__ __forceinline__ float bf2f(unsigned short b) { return __uint_as_float(((unsigned)b) << 16); }
__device__ __forceinline__ float bflo(unsigned w) { return __uint_as_float(w << 16); }
__device__ __forceinline__ float bfhi(unsigned w) { return __uint_as_float(w & 0xffff0000u); }
__device__ __forceinline__ float sigmoidf_(float x) { return __builtin_amdgcn_rcpf(1.0f + __expf(-x)); }
__device__ __forceinline__ float gelu_tanh(float x) { const float k = 1.5957691216f * (x + 0.044715f * x * x * x); return x * __builtin_amdgcn_rcpf(1.0f + __expf(-k)); }
__device__ __forceinline__ float wave_sum(float v) {
#pragma unroll
    for (int o = 1; o < 64; o <<= 1) v += __shfl_xor(v, o);
    return v;
}
__device__ __forceinline__ int otid() { int t = threadIdx.x; asm volatile("" : "+v"(t)); return t; }
template <int CTRL> __device__ __forceinline__ float dpp_upd(float old, float src) {
    return __int_as_float(__builtin_amdgcn_update_dpp(__float_as_int(old), __float_as_int(src), CTRL, 0xf, 0xf, false));
}
template <int CTRL> __device__ __forceinline__ float dpp0(float src) { return __int_as_float(__builtin_amdgcn_update_dpp(0, __float_as_int(src), CTRL, 0xf, 0xf, true)); }
__device__ __forceinline__ float prev1(float prev, float cur) { const float t = dpp_upd<0x121>(0.f, prev); return dpp_upd<0x111>(t, cur); }
__device__ __forceinline__ float prev2(float prev, float cur) { const float t = dpp_upd<0x122>(0.f, prev); return dpp_upd<0x112>(t, cur); }

namespace pg8 {
constexpr int BM = 256, BK = 64, HALF = 128, HTB = HALF * BK * 2, STAGE_BYTES = 8 * HTB, NXCD = 8, WGM = 8;
__host__ __device__ __forceinline__ int lds_byte(int r, int c) { const int st = (r >> 4) * 2 + (c >> 5), rr = r & 15, cc = c & 31, ob = rr * 64 + cc * 2; return st * 1024 + (ob ^ (((ob >> 9) & 1) << 5)); }
__host__ __device__ __forceinline__ void stage_rc(int b, int& R, int& C) { const int st = b / 1024, sb = b % 1024, swz = sb ^ (((sb >> 9) & 1) << 5); R = (st >> 1) * 16 + swz / 64; C = (st & 1) * 32 + (swz % 64) / 2; }
__host__ __device__ __forceinline__ int perm32(int rho) { const int n = rho >> 4, i = rho & 15; return 8 * (i >> 2) + 4 * n + (i & 3); }
struct Unit { int pm, pn; };
struct Gemm { const bf16_t* A; const bf16_t* Bt; int M, N, K, lda, ldb, a_shift, a_step; };
struct StaticOrder {
    int nM, nN, nwg, G, c;
    __device__ __forceinline__ void init(int M, int N, int G_, int c_) { nM = M / BM; nN = N / BM; nwg = nM * nN; G = G_; c = c_; }
    __device__ __forceinline__ bool next(int i, Unit& u) const {
        const long L = (long)i * G + c; if (L >= nwg) return false;
        int wgid = (int)L; { const int q = nwg / NXCD, r = nwg % NXCD, xcd = wgid % NXCD, off = wgid / NXCD; wgid = (xcd < r ? xcd * (q + 1) : r * (q + 1) + (xcd - r) * q) + off; }
        const int nig = WGM * nN, gid = wgid / nig, fm = gid * WGM, gsz = (nM - fm) < WGM ? (nM - fm) : WGM;
        u.pm = fm + ((wgid % nig) % gsz); u.pn = (wgid % nig) / gsz; return true;
    }
};
template <class Epi>
__device__ __forceinline__ void gemm_phase(LAS unsigned char* lds, const Gemm g, const StaticOrder& S, const Epi& E) {
    int tid_ = threadIdx.x; asm volatile("" : "+v"(tid_));
    const int tid = tid_, wid = __builtin_amdgcn_readfirstlane(tid >> 6), lane = tid & 63, wr = wid >> 2, wc = wid & 3, fr = lane & 15, fq = lane >> 4;
    const int K = g.K, nt = K / BK;
    unsigned voffA[2], voffB[2];
#pragma unroll
    for (int i = 0; i < 2; ++i) { int R, C; stage_rc(tid * 16 + i * 8192, R, C); const int Rb = Epi::PERM ? ((R & ~31) + perm32(R & 31)) : R;
        const int Ra = Epi::ROWPERM ? ((R & ~63) + 4 * (R & 15) + ((R >> 4) & 3)) : R;
        voffA[i] = (unsigned)(Ra * g.lda + C) * 2u; voffB[i] = (unsigned)(Rb * g.ldb + C) * 2u; }
    const size_t kstep = (size_t)(BK * 2);
    const size_t hstepA = (size_t)HALF * g.lda * 2, hstepB = (size_t)HALF * g.ldb * 2;
    const size_t tstepA = 2 * hstepA, tstepB = 2 * hstepB;
    const unsigned ldsw = (unsigned)wid * 1024u;
    const int aoff = lds_byte(wr * 64 + fr, fq * 8), boff = lds_byte(wc * 32 + fr, fq * 8);
#define PG8_SA(b, h) (((b) * 2 + (h)) * HTB)
#define PG8_SB(b, h) ((4 + (b) * 2 + (h)) * HTB)
#define PG8_STAGE(bufoff, gbase, voff) do { _Pragma("unroll") for (int _i = 0; _i < 2; ++_i) \
        __builtin_amdgcn_global_load_lds((const unsigned*)((const char*)(gbase) + (voff)[_i]), (LAS unsigned*)(lds + (bufoff) + ldsw + _i * 8192), 16, 0, 0); } while (0)
#define PG8_LDA(dst, b, h) do { _Pragma("unroll") for (int m = 0; m < 4; ++m) _Pragma("unroll") for (int k = 0; k < 2; ++k) dst[m][k] = *(const LAS bf16x8*)(lds + PG8_SA(b, h) + aoff + m * 2048 + k * 1024); } while (0)
#define PG8_LDB(dst, b, h) do { _Pragma("unroll") for (int n = 0; n < 2; ++n) _Pragma("unroll") for (int k = 0; k < 2; ++k) dst[n][k] = *(const LAS bf16x8*)(lds + PG8_SB(b, h) + boff + n * 2048 + k * 1024); } while (0)
#define PG8_MMA(ai, bj, At, Bt) do { __builtin_amdgcn_s_setprio(1); _Pragma("unroll") for (int m = 0; m < 4; ++m) _Pragma("unroll") for (int n = 0; n < 2; ++n) _Pragma("unroll") for (int k = 0; k < 2; ++k) \
        acc[ai][bj][m][n] = __builtin_amdgcn_mfma_f32_16x16x32_bf16(Bt[n][k], At[m][k], acc[ai][bj][m][n], 0, 0, 0); __builtin_amdgcn_s_setprio(0); } while (0)
#define PG8_WAIT_V(n) asm volatile("s_waitcnt vmcnt(" #n ")" ::: "memory")
#define PG8_WAIT_L(n) asm volatile("s_waitcnt lgkmcnt(" #n ")" ::: "memory")
#define PG8_BAR __builtin_amdgcn_s_barrier()
#define PG8_SCHED __builtin_amdgcn_sched_barrier(0)
    Unit cur, nxt; int ui = 0;
    if (!S.next(0, cur)) return;
    f32x4 acc[2][2][4][2];
    {
#pragma unroll
    for (int a = 0; a < 2; ++a)
#pragma unroll
        for (int b = 0; b < 2; ++b)
#pragma unroll
            for (int m = 0; m < 4; ++m)
#pragma unroll
                for (int n = 0; n < 2; ++n) acc[a][b][m][n] = (f32x4){0.f, 0.f, 0.f, 0.f};
    }
    bf16x8 At[4][2], B0[2][2], B1[2][2];
    const char* cA = (const char*)g.A + (size_t)cur.pm * tstepA + (size_t)(cur.pn >> g.a_shift) * g.a_step; const char* cB = (const char*)g.Bt + (size_t)cur.pn * tstepB;
    PG8_STAGE(PG8_SB(0, 0), cB, voffB); PG8_STAGE(PG8_SA(0, 0), cA, voffA); PG8_STAGE(PG8_SB(0, 1), cB + hstepB, voffB); PG8_STAGE(PG8_SA(0, 1), cA + hstepA, voffA);
    if (wr == 1) PG8_BAR;
    PG8_WAIT_V(4); PG8_BAR;
    PG8_STAGE(PG8_SB(1, 0), cB + kstep, voffB); PG8_STAGE(PG8_SA(1, 0), cA + kstep, voffA); PG8_STAGE(PG8_SB(1, 1), cB + hstepB + kstep, voffB);
    PG8_WAIT_V(6); PG8_BAR;
    for (;;) {
        const bool has_next = S.next(ui + 1, nxt);
        const char* nA = has_next ? (const char*)g.A + (size_t)nxt.pm * tstepA + (size_t)(nxt.pn >> g.a_shift) * g.a_step : cA; const char* nB = has_next ? (const char*)g.Bt + (size_t)nxt.pn * tstepB : cB;
        for (int t = 0; t < nt; t += 2) {
            const bool last = (t == nt - 2);
            const char* a1 = cA + (size_t)(t + 1) * kstep;
            const char* a2 = last ? nA : cA + (size_t)(t + 2) * kstep; const char* b2 = last ? nB : cB + (size_t)(t + 2) * kstep;
            const char* a3 = a2 + kstep; const char* b3 = b2 + kstep;
            PG8_LDB(B0, 0, 0); PG8_SCHED; PG8_LDA(At, 0, 0); PG8_STAGE(PG8_SA(1, 1), a1 + hstepA, voffA);
            PG8_WAIT_L(8); PG8_BAR; PG8_WAIT_L(0); PG8_MMA(0, 0, At, B0); PG8_BAR; PG8_SCHED;
            PG8_LDB(B1, 0, 1); PG8_STAGE(PG8_SB(0, 0), b2, voffB);
            PG8_BAR; PG8_WAIT_L(0); PG8_MMA(0, 1, At, B1); PG8_BAR;
            PG8_LDA(At, 0, 1); PG8_STAGE(PG8_SA(0, 0), a2, voffA);
            PG8_BAR; PG8_WAIT_L(0); PG8_MMA(1, 0, At, B0); PG8_BAR; PG8_SCHED;
            PG8_STAGE(PG8_SB(0, 1), b2 + hstepB, voffB);
            PG8_WAIT_V(6); PG8_BAR; PG8_MMA(1, 1, At, B1); PG8_BAR;
            PG8_LDB(B0, 1, 0); PG8_SCHED; PG8_LDA(At, 1, 0); PG8_STAGE(PG8_SA(0, 1), a2 + hstepA, voffA);
            PG8_WAIT_L(8); PG8_BAR; PG8_WAIT_L(0); PG8_MMA(0, 0, At, B0); PG8_BAR; PG8_SCHED;
            PG8_LDB(B1, 1, 1); PG8_STAGE(PG8_SB(1, 0), b3, voffB);
            PG8_BAR; PG8_WAIT_L(0); PG8_MMA(0, 1, At, B1); PG8_BAR;
            PG8_LDA(At, 1, 1); PG8_STAGE(PG8_SA(1, 0), a3, voffA);
            PG8_BAR; PG8_WAIT_L(0); PG8_MMA(1, 0, At, B0); PG8_BAR; PG8_SCHED;
            PG8_STAGE(PG8_SB(1, 1), b3 + hstepB, voffB);
            PG8_WAIT_V(6); PG8_BAR; PG8_MMA(1, 1, At, B1); PG8_BAR;
        }
        E(acc, cur, wr, wc, fr, fq);
        if (!has_next) break;
        {
#pragma unroll
        for (int a = 0; a < 2; ++a)
#pragma unroll
            for (int b = 0; b < 2; ++b)
#pragma unroll
                for (int m = 0; m < 4; ++m)
#pragma unroll
                    for (int n = 0; n < 2; ++n) acc[a][b][m][n] = (f32x4){0.f, 0.f, 0.f, 0.f};
        }
        cur = nxt; cA = nA; cB = nB; ++ui;
    }
    PG8_WAIT_V(0);
    if (wr == 0) PG8_BAR;
    PG8_BAR;
#undef PG8_SA
#undef PG8_SB
#undef PG8_STAGE
#undef PG8_LDA
#undef PG8_LDB
#undef PG8_MMA
#undef PG8_WAIT_V
#undef PG8_WAIT_L
#undef PG8_BAR
#undef PG8_SCHED
}
}
using pg8::Unit;
typedef const f32x4 (&AccRef)[2][2][4][2];

struct EpiRes {
    static constexpr bool PERM = false, ROWPERM = false;
    const float* base; float* out; const float* scale; const float* bias;
    __device__ __forceinline__ void operator()(AccRef acc, const Unit& u, int wr, int wc, int fr, int fq) const {
        const int row0 = u.pm * 256 + wr * 64 + fr, col0 = u.pn * 256 + wc * 32 + 4 * fq;
        f32x4 sv[2][2], bv[2][2];
#pragma unroll
        for (int bj = 0; bj < 2; ++bj)
#pragma unroll
            for (int n = 0; n < 2; ++n) {
                sv[bj][n] = scale ? *(const f32x4*)(scale + col0 + bj * 128 + n * 16) : (f32x4){1.f, 1.f, 1.f, 1.f};
                bv[bj][n] = bias ? *(const f32x4*)(bias + col0 + bj * 128 + n * 16) : (f32x4){0.f, 0.f, 0.f, 0.f}; }
#pragma unroll
        for (int ai = 0; ai < 2; ++ai)
#pragma unroll
            for (int mh = 0; mh < 2; ++mh) {
                f32x4 bs[2][2][2];
#pragma unroll
                for (int m = 0; m < 2; ++m)
#pragma unroll
                    for (int bj = 0; bj < 2; ++bj)
#pragma unroll
                        for (int n = 0; n < 2; ++n) bs[m][bj][n] = *(const f32x4*)(base + (size_t)(row0 + ai * 128 + (2 * mh + m) * 16) * D + col0 + bj * 128 + n * 16);
#pragma unroll
                for (int m = 0; m < 2; ++m)
#pragma unroll
                    for (int bj = 0; bj < 2; ++bj)
#pragma unroll
                        for (int n = 0; n < 2; ++n) *(f32x4*)(out + (size_t)(row0 + ai * 128 + (2 * mh + m) * 16) * D + col0 + bj * 128 + n * 16) = bs[m][bj][n] + sv[bj][n] * (acc[ai][bj][2 * mh + m][n] + bv[bj][n]);
                asm volatile("" ::: "memory"); }
    }
};
struct EpiGateRes {
    static constexpr bool PERM = true, ROWPERM = false;
    float* x; const float* bias;
    __device__ __forceinline__ void operator()(AccRef acc, const Unit& u, int wr, int wc, int fr, int fq) const {
        const int row0 = u.pm * 256 + wr * 64 + fr, col0 = u.pn * 128 + wc * 32 + 8 * fq;
        f32x4 bv[2], bg[2];
#pragma unroll
        for (int n = 0; n < 2; ++n) { bv[n] = *(const f32x4*)(bias + col0 + 4 * n); bg[n] = *(const f32x4*)(bias + D + col0 + 4 * n); }
#pragma unroll
        for (int ai = 0; ai < 2; ++ai) {
            f32x4 xs[4][2];
#pragma unroll
            for (int m = 0; m < 4; ++m)
#pragma unroll
                for (int n = 0; n < 2; ++n) xs[m][n] = *(const f32x4*)(x + (size_t)(row0 + ai * 128 + m * 16) * D + col0 + 4 * n);
#pragma unroll
            for (int m = 0; m < 4; ++m)
#pragma unroll
                for (int n = 0; n < 2; ++n) { f32x4 xv = xs[m][n]; const f32x4 v = acc[ai][0][m][n] + bv[n], gt = acc[ai][1][m][n] + bg[n];
#pragma unroll
                    for (int j = 0; j < 4; ++j) xv[j] += v[j] * sigmoidf_(gt[j]);
                    *(f32x4*)(x + (size_t)(row0 + ai * 128 + m * 16) * D + col0 + 4 * n) = xv; }
            asm volatile("" ::: "memory"); }
    }
};
struct EpiLruIn {
    static constexpr bool PERM = true, ROWPERM = true;
    bf16_t* GG; bf16_t* REC; const float* cw; const float* cb; float* rawl; LAS float* xch;
    __device__ __forceinline__ void operator()(AccRef acc, const Unit& u, int wr, int wc, int fr, int fq) const {
        const int row0 = u.pm * 256 + wr * 64 + 4 * fr, clb = wc * 32 + 8 * fq, col0 = (u.pn & 3) * 256 + clb;
        if (u.pn < 4) {
#pragma unroll
            for (int ai = 0; ai < 2; ++ai)
#pragma unroll
                for (int m = 0; m < 4; ++m) { bf16_t* rp = GG + (size_t)(row0 + ai * 128 + m) * D + col0;
#pragma unroll
                    for (int bj = 0; bj < 2; ++bj) { f32x4 v0 = acc[ai][bj][m][0], v1 = acc[ai][bj][m][1];
#pragma unroll
                        for (int j = 0; j < 4; ++j) { v0[j] = gelu_tanh(v0[j]); v1[j] = gelu_tanh(v1[j]); }
                        u32x4 w; w.x = cvt_pk_bf16(v0[0], v0[1]); w.y = cvt_pk_bf16(v0[2], v0[3]); w.z = cvt_pk_bf16(v1[0], v1[1]); w.w = cvt_pk_bf16(v1[2], v1[3]);
                        *(u32x4*)(rp + bj * 128) = w; } }
            return;
        }
        if (fr == 15) {
#pragma unroll
            for (int ai = 0; ai < 2; ++ai)
#pragma unroll
                for (int bj = 0; bj < 2; ++bj)
#pragma unroll
                    for (int n = 0; n < 2; ++n)
#pragma unroll
                        for (int q = 0; q < 3; ++q) *(LAS f32x4*)(xch + ((ai * 2 + wr) * 3 + q) * 256 + bj * 128 + clb + 4 * n) = acc[ai][bj][1 + q][n];
        }
        float* rawu = rawl + (size_t)(u.pm * 4 + (u.pn - 4)) * 6 * 256;
        if (wr == 0 && fr == 0) {
#pragma unroll
            for (int bj = 0; bj < 2; ++bj)
#pragma unroll
                for (int n = 0; n < 2; ++n)
#pragma unroll
                    for (int q = 0; q < 3; ++q) *(f32x4*)(rawu + q * 256 + bj * 128 + clb + 4 * n) = acc[0][bj][q][n];
        }
        if (wr == 1 && fr == 15) {
#pragma unroll
            for (int bj = 0; bj < 2; ++bj)
#pragma unroll
                for (int n = 0; n < 2; ++n)
#pragma unroll
                    for (int q = 0; q < 3; ++q) *(f32x4*)(rawu + (3 + q) * 256 + bj * 128 + clb + 4 * n) = acc[1][bj][1 + q][n];
        }
        asm volatile("s_waitcnt lgkmcnt(0)" ::: "memory"); __builtin_amdgcn_s_barrier(); __builtin_amdgcn_s_barrier(); asm volatile("" ::: "memory");
#pragma unroll
        for (int bj = 0; bj < 2; ++bj)
#pragma unroll
            for (int n = 0; n < 2; ++n) {
                const int c0 = col0 + bj * 128 + 4 * n;
                const f32x4 w0 = *(const f32x4*)(cw + c0), w1 = *(const f32x4*)(cw + D + c0), w2 = *(const f32x4*)(cw + 2 * D + c0), w3 = *(const f32x4*)(cw + 3 * D + c0), bb = *(const f32x4*)(cb + c0);
#pragma unroll
                for (int ai = 0; ai < 2; ++ai) {
                    f32x4 h1 = (f32x4){0.f, 0.f, 0.f, 0.f}, h2 = h1, h3 = h1;
                    const int pb = ai * 2 + wr - 1;
                    if (pb >= 0 && fr == 0) { const LAS float* xp = xch + (pb * 3) * 256 + bj * 128 + clb + 4 * n; h1 = *(const LAS f32x4*)(xp); h2 = *(const LAS f32x4*)(xp + 256); h3 = *(const LAS f32x4*)(xp + 512); }
                    float o[4][4];
#pragma unroll
                    for (int j = 0; j < 4; ++j) {
                        const float v0 = acc[ai][bj][0][n][j], v1 = acc[ai][bj][1][n][j], v2 = acc[ai][bj][2][n][j], v3 = acc[ai][bj][3][n][j];
                        const float p3 = dpp_upd<0x111>(h3[j], v3), p2 = dpp_upd<0x111>(h2[j], v2), p1 = dpp_upd<0x111>(h1[j], v1);
                        o[0][j] = bb[j] + w3[j] * v0 + w2[j] * p3 + w1[j] * p2 + w0[j] * p1;
                        o[1][j] = bb[j] + w3[j] * v1 + w2[j] * v0 + w1[j] * p3 + w0[j] * p2;
                        o[2][j] = bb[j] + w3[j] * v2 + w2[j] * v1 + w1[j] * v0 + w0[j] * p3;
                        o[3][j] = bb[j] + w3[j] * v3 + w2[j] * v2 + w1[j] * v1 + w0[j] * v0; }
#pragma unroll
                    for (int m = 0; m < 4; ++m) *(u32x2*)(REC + (size_t)(row0 + ai * 128 + m) * D + c0) = (u32x2){cvt_pk_bf16(o[m][0], o[m][1]), cvt_pk_bf16(o[m][2], o[m][3])};
                }
            }
    }
};
struct EpiGates {
    static constexpr bool PERM = true, ROWPERM = false;
    const bf16_t* REC; bf16_t* LA; bf16_t* BV; const float* b_a; const float* b_x; const float* lam;
    __device__ __forceinline__ void operator()(AccRef acc, const Unit& u, int wr, int wc, int fr, int fq) const {
        const int row0 = u.pm * 256 + wr * 64 + fr, col0 = u.pn * 128 + wc * 32 + 8 * fq;
        u32x4 rws[2][4];
#pragma unroll
        for (int ai = 0; ai < 2; ++ai)
#pragma unroll
            for (int m = 0; m < 4; ++m) rws[ai][m] = *(const u32x4*)(REC + (size_t)(row0 + ai * 128 + m * 16) * D + col0);
#pragma unroll
        for (int n = 0; n < 2; ++n) {
            const f32x4 ba = *(const f32x4*)(b_a + col0 + 4 * n), bx = *(const f32x4*)(b_x + col0 + 4 * n), l = *(const f32x4*)(lam + col0 + 4 * n);
            f32x4 k8;
#pragma unroll
            for (int j = 0; j < 4; ++j) k8[j] = -8.0f * __logf(1.0f + __expf(-l[j]));
#pragma unroll
            for (int ai = 0; ai < 2; ++ai)
#pragma unroll
                for (int m = 0; m < 4; ++m) { const size_t off = (size_t)(row0 + ai * 128 + m * 16) * D + col0 + 4 * n;
                    float lo[4], bo[4];
#pragma unroll
                    for (int j = 0; j < 4; ++j) { const unsigned w = rws[ai][m][2 * n + (j >> 1)]; const float rec = (j & 1) ? bfhi(w) : bflo(w);
                        const float r = sigmoidf_(acc[ai][0][m][n][j] + ba[j]), ig = sigmoidf_(acc[ai][1][m][n][j] + bx[j]);
                        const float la = k8[j] * r; const float mult = __builtin_sqrtf(1.0f - __expf(2.0f * la));
                        lo[j] = la; bo[j] = mult * ig * rec; }
                    *(u32x2*)(LA + off) = (u32x2){cvt_pk_bf16(lo[0], lo[1]), cvt_pk_bf16(lo[2], lo[3])}; *(u32x2*)(BV + off) = (u32x2){cvt_pk_bf16(bo[0], bo[1]), cvt_pk_bf16(bo[2], bo[3])}; }
        }
    }
};
struct EpiQKV {
    static constexpr bool PERM = true, ROWPERM = false;
    bf16_t* QKV; const float* qg; const float* kg;
    __device__ __forceinline__ void operator()(AccRef acc, const Unit& u, int wr, int wc, int fr, int fq) const {
        const int which = u.pn >> 2, row0 = u.pm * 256 + wr * 64 + fr, col0 = (u.pn & 3) * 256 + wc * 64 + 8 * fq;
        bf16_t* dst = QKV + (size_t)which * ((size_t)T * D);
        f32x4 gv[2][2];
#pragma unroll
        for (int bj = 0; bj < 2; ++bj)
#pragma unroll
            for (int n = 0; n < 2; ++n) { const f32x4 a = *(const f32x4*)(qg + 32 * bj + 8 * fq + 4 * n), b = *(const f32x4*)(kg + 32 * bj + 8 * fq + 4 * n);
                gv[bj][n] = which == 0 ? a : (which == 1 ? b : (f32x4){1.f, 1.f, 1.f, 1.f}); }
#pragma unroll
        for (int ai = 0; ai < 2; ++ai)
#pragma unroll
            for (int m = 0; m < 4; ++m) {
                float sc = 1.0f;
                if (which < 2) { float ss = 0.f;
#pragma unroll
                    for (int bj = 0; bj < 2; ++bj)
#pragma unroll
                        for (int n = 0; n < 2; ++n) { const f32x4 v = acc[ai][bj][m][n]; ss += (v[0] * v[0] + v[1] * v[1]) + (v[2] * v[2] + v[3] * v[3]); }
                    ss += __shfl_xor(ss, 16); ss += __shfl_xor(ss, 32);
                    sc = rsqrtf(ss * (1.0f / 64.0f) + 1e-6f) * (which == 0 ? 0.125f : 1.0f); }
                bf16_t* rp = dst + (size_t)(row0 + ai * 128 + m * 16) * D + col0;
#pragma unroll
                for (int bj = 0; bj < 2; ++bj) { const f32x4 v0 = acc[ai][bj][m][0] * gv[bj][0] * sc, v1 = acc[ai][bj][m][1] * gv[bj][1] * sc;
                    u32x4 w; w.x = cvt_pk_bf16(v0[0], v0[1]); w.y = cvt_pk_bf16(v0[2], v0[3]); w.z = cvt_pk_bf16(v1[0], v1[1]); w.w = cvt_pk_bf16(v1[2], v1[3]);
                    *(u32x4*)(rp + bj * 32) = w; } }
    }
};
struct EpiFfn1 {
    static constexpr bool PERM = true, ROWPERM = true;
    bf16_t* Aout; const float* cw; const float* cb; float* raw; LAS float* xch;
    __device__ __forceinline__ void operator()(AccRef acc, const Unit& u, int wr, int wc, int fr, int fq) const {
        const int clb = 32 * wc + 8 * fq;
        f32x4 cwv[2][8];
        { const float* cv = cw + 128 * u.pn + clb; const float* cg = cv + FH; const float* bp = cb + 128 * u.pn + clb;
          cwv[0][0] = *(const f32x4*)(cv); cwv[0][1] = *(const f32x4*)(cv + F2); cwv[0][2] = *(const f32x4*)(cv + 2 * F2); cwv[0][3] = *(const f32x4*)(bp);
          cwv[0][4] = *(const f32x4*)(cg); cwv[0][5] = *(const f32x4*)(cg + F2); cwv[0][6] = *(const f32x4*)(cg + 2 * F2); cwv[0][7] = *(const f32x4*)(bp + FH); }
        if (fr == 15) {
#pragma unroll
            for (int ai = 0; ai < 2; ++ai)
#pragma unroll
                for (int bj = 0; bj < 2; ++bj)
#pragma unroll
                    for (int n = 0; n < 2; ++n) { *(LAS f32x4*)(xch + ((ai * 2 + wr) * 2 + 0) * 256 + bj * 128 + clb + 4 * n) = acc[ai][bj][2][n]; *(LAS f32x4*)(xch + ((ai * 2 + wr) * 2 + 1) * 256 + bj * 128 + clb + 4 * n) = acc[ai][bj][3][n]; }
        }
        float* rawu = raw + (size_t)(u.pm * 22 + u.pn) * 1024;
        if (wr == 0 && fr == 0) {
#pragma unroll
            for (int bj = 0; bj < 2; ++bj)
#pragma unroll
                for (int n = 0; n < 2; ++n) { *(f32x4*)(rawu + 0 * 256 + bj * 128 + clb + 4 * n) = acc[0][bj][0][n]; *(f32x4*)(rawu + 1 * 256 + bj * 128 + clb + 4 * n) = acc[0][bj][1][n]; }
        }
        if (wr == 1 && fr == 15) {
#pragma unroll
            for (int bj = 0; bj < 2; ++bj)
#pragma unroll
                for (int n = 0; n < 2; ++n) { *(f32x4*)(rawu + 2 * 256 + bj * 128 + clb + 4 * n) = acc[1][bj][2][n]; *(f32x4*)(rawu + 3 * 256 + bj * 128 + clb + 4 * n) = acc[1][bj][3][n]; }
        }
        asm volatile("s_waitcnt lgkmcnt(0)" ::: "memory"); __builtin_amdgcn_s_barrier(); __builtin_amdgcn_s_barrier(); asm volatile("" ::: "memory");
        const int hc0 = 128 * u.pn + clb, row0 = u.pm * 256 + wr * 64 + 4 * fr;
#pragma unroll
        for (int n = 0; n < 2; ++n) {
            const f32x4 w0v = cwv[n][0], w1v = cwv[n][1], w2v = cwv[n][2], bvv = cwv[n][3], w0g = cwv[n][4], w1g = cwv[n][5], w2g = cwv[n][6], bvg = cwv[n][7];
#pragma unroll
            for (int ai = 0; ai < 2; ++ai) {
                if (n == 0 && ai == 0) {
                    asm volatile("" ::: "memory");
                    const float* cv = cw + hc0 + 4; const float* cg = cv + FH; const float* bp = cb + hc0 + 4;
                    cwv[1][0] = *(const f32x4*)(cv); cwv[1][1] = *(const f32x4*)(cv + F2); cwv[1][2] = *(const f32x4*)(cv + 2 * F2); cwv[1][3] = *(const f32x4*)(bp);
                    cwv[1][4] = *(const f32x4*)(cg); cwv[1][5] = *(const f32x4*)(cg + F2); cwv[1][6] = *(const f32x4*)(cg + 2 * F2); cwv[1][7] = *(const f32x4*)(bp + FH);
                    asm volatile("" ::: "memory"); }
                f32x4 h2v = (f32x4){0.f, 0.f, 0.f, 0.f}, h3v = h2v, h2g = h2v, h3g = h2v;
                const int pb = ai * 2 + wr - 1;
                if (pb >= 0 && fr == 0) { const LAS float* xp = xch + (pb * 2) * 256 + clb + 4 * n;
                    h2v = *(const LAS f32x4*)(xp); h3v = *(const LAS f32x4*)(xp + 256); h2g = *(const LAS f32x4*)(xp + 128); h3g = *(const LAS f32x4*)(xp + 256 + 128); }
                float o[4][4];
#pragma unroll
                for (int j = 0; j < 4; ++j) {
                    const float v0 = acc[ai][0][0][n][j], v1 = acc[ai][0][1][n][j], v2 = acc[ai][0][2][n][j], v3 = acc[ai][0][3][n][j];
                    const float g0 = acc[ai][1][0][n][j], g1 = acc[ai][1][1][n][j], g2 = acc[ai][1][2][n][j], g3 = acc[ai][1][3][n][j];
                    const float pv3 = dpp_upd<0x111>(h3v[j], v3), pv2 = dpp_upd<0x111>(h2v[j], v2), pg3 = dpp_upd<0x111>(h3g[j], g3), pg2 = dpp_upd<0x111>(h2g[j], g2);
                    const float hv0 = bvv[j] + w2v[j] * v0 + w1v[j] * pv3 + w0v[j] * pv2, hv1 = bvv[j] + w2v[j] * v1 + w1v[j] * v0 + w0v[j] * pv3;
                    const float hv2 = bvv[j] + w2v[j] * v2 + w1v[j] * v1 + w0v[j] * v0, hv3 = bvv[j] + w2v[j] * v3 + w1v[j] * v2 + w0v[j] * v1;
                    const float hg0 = bvg[j] + w2g[j] * g0 + w1g[j] * pg3 + w0g[j] * pg2, hg1 = bvg[j] + w2g[j] * g1 + w1g[j] * g0 + w0g[j] * pg3;
                    const float hg2 = bvg[j] + w2g[j] * g2 + w1g[j] * g1 + w0g[j] * g0, hg3 = bvg[j] + w2g[j] * g3 + w1g[j] * g2 + w0g[j] * g1;
                    o[0][j] = hg0 * sigmoidf_(hg0) * hv0; o[1][j] = hg1 * sigmoidf_(hg1) * hv1; o[2][j] = hg2 * sigmoidf_(hg2) * hv2; o[3][j] = hg3 * sigmoidf_(hg3) * hv3; }
#pragma unroll
                for (int m = 0; m < 4; ++m) { u32x2 w; w.x = cvt_pk_bf16(o[m][0], o[m][1]); w.y = cvt_pk_bf16(o[m][2], o[m][3]);
                    *(u32x2*)(Aout + (size_t)(row0 + ai * 128 + m) * FH + hc0 + 4 * n) = w; } } }
    }
};

#define XB_TMO      128
#define XB_XCNT(j)  (256  + 64 * (j))
#define XB_XSUB(j)  (1280 + 64 * (j))
#define XB_XGEN(j)  (2304 + 64 * (j))
#define XB_TOP      3328
#define XB_TOPGEN   3392
#define XCD_BAR_WORDS 3456
#define XB_SPIN_CAP (1u << 24)
__device__ __forceinline__ unsigned xb_ld(unsigned* p)              { return __hip_atomic_load(p, __ATOMIC_RELAXED, __HIP_MEMORY_SCOPE_AGENT); }
__device__ __forceinline__ unsigned xb_add(unsigned* p, unsigned v) { return __hip_atomic_fetch_add(p, v, __ATOMIC_RELAXED, __HIP_MEMORY_SCOPE_AGENT); }
__device__ __forceinline__ unsigned xb_xcc_id() { return (unsigned)__builtin_amdgcn_s_getreg((3 << 11) | 20) & 0xFu; }
#define XB_SPIN(cond, bar) do { unsigned _sp = 0; while (cond) { __builtin_amdgcn_s_sleep(1); \
    if ((++_sp & 255u) == 0u) { if (xb_ld(&(bar)[XB_TMO])) break; if (_sp > XB_SPIN_CAP) { atomicAdd(&(bar)[XB_TMO], 1u); break; } } } } while (0)
struct XcdBarrier { unsigned* bar; unsigned x; volatile LAS unsigned* st; };
__device__ __forceinline__ XcdBarrier xcd_barrier_post(unsigned* bar, volatile LAS unsigned* st) {
    XcdBarrier b; b.bar = bar; b.x = xb_xcc_id(); b.st = st;
    if (threadIdx.x == 0) (void)xb_add(&bar[XB_XCNT(b.x)], 1u);
    return b;
}
__device__ __forceinline__ void xcd_barrier_complete(unsigned* bar, unsigned x, unsigned& nloc, unsigned& nx) {
    const unsigned G = gridDim.x * gridDim.y * gridDim.z;
    unsigned sum, cnt, mine, sp = 0u;
    for (;;) {
        sum = 0u; cnt = 0u; mine = 0u;
#pragma unroll
        for (unsigned j = 0; j < 16; ++j) { const unsigned c = xb_ld(&bar[XB_XCNT(j)]); sum += c; cnt += (c > 0u) ? 1u : 0u; mine = (j == x) ? c : mine; }
        if (sum == G) break;
        __builtin_amdgcn_s_sleep(1);
        if ((++sp & 255u) == 0u) { if (xb_ld(&bar[XB_TMO])) break; if (sp > XB_SPIN_CAP) { atomicAdd(&bar[XB_TMO], 1u); break; } }
    }
    nloc = mine > 0u ? mine : 1u; nx = cnt > 0u ? cnt : 1u;
}
__device__ __forceinline__ void xcd_barrier(const XcdBarrier& b) {
    asm volatile("s_waitcnt vmcnt(0) lgkmcnt(0)" ::: "memory");
    __syncthreads();
    if (threadIdx.x == 0) {
        unsigned* bar = b.bar;
        __builtin_amdgcn_s_waitcnt(0);
        unsigned nloc = b.st[0], nx = b.st[1];
        if (nloc == 0u) { xcd_barrier_complete(bar, b.x, nloc, nx); b.st[0] = nloc; b.st[1] = nx; }
        const unsigned old = xb_add(&bar[XB_XSUB(b.x)], 1u);
        const unsigned gen = old / nloc;
        if (old + 1u == (gen + 1u) * nloc) {
            __builtin_amdgcn_fence(__ATOMIC_RELEASE, "agent");
            asm volatile("s_waitcnt vmcnt(0)" ::: "memory");
            const unsigned og = xb_add(&bar[XB_TOP], 1u);
            const unsigned tg = og / nx;
            if (og + 1u == (tg + 1u) * nx) xb_add(&bar[XB_TOPGEN], 1u);
            else XB_SPIN(xb_ld(&bar[XB_TOPGEN]) == tg, bar);
            __builtin_amdgcn_fence(__ATOMIC_ACQUIRE, "agent");
            xb_add(&bar[XB_XGEN(b.x)], 1u);
            asm volatile("s_waitcnt vmcnt(0)" ::: "memory");
        } else {
            XB_SPIN(xb_ld(&bar[XB_XGEN(b.x)]) == gen, bar);
            __builtin_amdgcn_fence(__ATOMIC_ACQUIRE, "agent");
            asm volatile("s_waitcnt vmcnt(0)" ::: "memory");
        }
    }
    __syncthreads();
}

struct Job { const float* src; bf16_t* dst; int K, ld, nrows, map, hh, item0; };
constexpr int NJOBS = 33;
struct Params {
    const float* in[33]; float* out; unsigned char* ws;
    Job jobs[NJOBS]; int nitems; int nitems_a;
};

__device__ __forceinline__ int map_col(int map, int hh, int j) {
    if (map == 0) return j;
    if (map == 1) { const int pn = j >> 8, bj = (j >> 7) & 1, i = j & 127; return bj * hh + 128 * pn + i; }
    const int pn = j >> 8, cl = j & 255, bj = cl >> 7, h4 = (cl & 127) >> 5, i = cl & 31; return 256 * pn + 64 * h4 + 32 * bj + i;
}

__device__ __forceinline__ void weights_phase(const Params& P, LAS float* scr, int lane, int it0, int it1, int w, int nw) {
    for (int it = it0 + w; it < it1; it += nw) {
        int ji = 0;
#pragma unroll 1
        for (int q = 1; q < NJOBS; ++q) if (it >= P.jobs[q].item0) ji = q;
        const Job jb = P.jobs[ji];
        const int r = it - jb.item0, nblk = jb.nrows / 32, kb = r / nblk, nb = r % nblk, k0 = 64 * kb, n0 = 32 * nb, c0 = map_col(jb.map, jb.hh, n0);
#pragma unroll 8
        for (int i = 0; i < 32; ++i) { const int kk = 2 * i + (lane >> 5); scr[kk * 33 + (lane & 31)] = jb.src[(size_t)(k0 + kk) * jb.ld + c0 + (lane & 31)]; }
        asm volatile("s_waitcnt lgkmcnt(0)" ::: "memory");
        const int c = lane & 7;
#pragma unroll
        for (int j = 0; j < 4; ++j) { const int n = (lane >> 3) + 8 * j; const LAS float* s = scr + (8 * c) * 33 + n;
            u32x4 o; o.x = cvt_pk_bf16(s[0 * 33], s[1 * 33]); o.y = cvt_pk_bf16(s[2 * 33], s[3 * 33]); o.z = cvt_pk_bf16(s[4 * 33], s[5 * 33]); o.w = cvt_pk_bf16(s[6 * 33], s[7 * 33]);
            *(u32x4*)(jb.dst + (size_t)(n0 + n) * jb.K + k0 + 8 * c) = o; }
        asm volatile("s_waitcnt lgkmcnt(0)" ::: "memory");
    }
}
__device__ __forceinline__ void rmsnorm_phase(const float* x, const float* g, bf16_t* hn) {
    const int tid__ = otid(); const int lane = tid__ & 63, wave = tid__ >> 6;
    const int gw = blockIdx.x * 8 + wave, ngw = gridDim.x * 8;
    f32x4 gv[4];
#pragma unroll
    for (int j = 0; j < 4; ++j) gv[j] = *((const f32x4*)g + lane + 64 * j);
    f32x4 v[4];
    if (gw < T) {
#pragma unroll
        for (int j = 0; j < 4; ++j) v[j] = ((const f32x4*)(x + (size_t)gw * D) + lane)[64 * j]; }
    for (int m = gw; m < T; m += ngw) {
        f32x4 vn[4];
        const int mn = (m + ngw < T) ? m + ngw : m;
#pragma unroll
        for (int j = 0; j < 4; ++j) vn[j] = ((const f32x4*)(x + (size_t)mn * D) + lane)[64 * j];
        float s = 0.f;
#pragma unroll
        for (int j = 0; j < 4; ++j) s += (v[j][0] * v[j][0] + v[j][1] * v[j][1]) + (v[j][2] * v[j][2] + v[j][3] * v[j][3]);
        const float rstd = rsqrtf(wave_sum(s) * (1.0f / D) + 1e-6f);
        u32x2* o = (u32x2*)(hn + (size_t)m * D) + lane;
#pragma unroll
        for (int j = 0; j < 4; ++j) { const f32x4 y = v[j] * rstd * gv[j]; u32x2 w; w.x = cvt_pk_bf16(y[0], y[1]); w.y = cvt_pk_bf16(y[2], y[3]); o[64 * j] = w; }
#pragma unroll
        for (int j = 0; j < 4; ++j) v[j] = vn[j];
    }
}
__device__ __forceinline__ void ld8(const bf16_t* p, float (&v)[8]) {
    const u32x4 w = *(const u32x4*)p;
#pragma unroll
    for (int i = 0; i < 4; ++i) { v[2 * i] = bflo(w[i]); v[2 * i + 1] = bfhi(w[i]); }
}
__device__ __forceinline__ void st8(bf16_t* p, const float (&v)[8]) {
    u32x4 w; w.x = cvt_pk_bf16(v[0], v[1]); w.y = cvt_pk_bf16(v[2], v[3]); w.z = cvt_pk_bf16(v[4], v[5]); w.w = cvt_pk_bf16(v[6], v[7]);
    *(u32x4*)p = w;
}
__device__ __forceinline__ void pool_phase(const bf16_t* hn, bf16_t* dd) {
    for (int gid = blockIdx.x * NTHREADS + otid(); gid < (T / 32) * 128; gid += gridDim.x * NTHREADS) {
        const int col8 = gid & 127, chunk = gid >> 7, w = 2 << (col8 >> 5), t0 = chunk * 32, pos0 = t0 & (SEQ - 1);
        const bf16_t* hp = hn + (size_t)t0 * D + col8 * 8; bf16_t* dp = dd + (size_t)t0 * D + col8 * 8;
        float s[8];
#pragma unroll
        for (int i = 0; i < 8; ++i) s[i] = 0.f;
        if (pos0) for (int k = 1; k <= w; ++k) { float v[8]; ld8(hp - (size_t)k * D, v);
#pragma unroll
            for (int i = 0; i < 8; ++i) s[i] += v[i]; }
        for (int i = 0; i < 32; ++i) {
            float cur[8]; ld8(hp + (size_t)i * D, cur); const int pos = pos0 + i;
#pragma unroll
            for (int q = 0; q < 8; ++q) s[q] += cur[q];
            if (pos >= w) { float v[8]; ld8(hp + (size_t)(i - w) * D, v);
#pragma unroll
                for (int q = 0; q < 8; ++q) s[q] -= v[q]; }
            const float inv = 1.0f / (float)(pos + 1 < w ? pos + 1 : w);
            float o[8];
#pragma unroll
            for (int q = 0; q < 8; ++q) o[q] = s[q] * inv - cur[q];
            st8(dp + (size_t)i * D, o);
        }
    }
}
__device__ __forceinline__ void lru_fix_panel(const float* rawl, const float* cw, const float* cb, bf16_t* REC, int pm) {
    if ((pm & 7) == 0) return;
    const int tid = otid();
    float x[6][4], w[6][4], bb[6];
#pragma unroll
    for (int k = 0; k < 6; ++k) {
        const int idx = tid + k * NTHREADS, c = idx & 1023, rr = idx >> 10, pnl = c >> 8, cl = c & 255;
        const float* cur = rawl + (size_t)(pm * 4 + pnl) * 6 * 256 + cl; const float* prv = rawl + (size_t)((pm - 1) * 4 + pnl) * 6 * 256 + cl;
#pragma unroll
        for (int d = 0; d < 4; ++d) { const int q = rr - d; x[k][d] = q >= 0 ? cur[q * 256] : prv[(6 + q) * 256]; w[k][d] = cw[(3 - d) * D + c]; }
        bb[k] = cb[c];
    }
#pragma unroll
    for (int k = 0; k < 6; ++k) {
        const int idx = tid + k * NTHREADS, c = idx & 1023, rr = idx >> 10;
        const float o = bb[k] + w[k][0] * x[k][0] + w[k][1] * x[k][1] + w[k][2] * x[k][2] + w[k][3] * x[k][3];
        REC[(size_t)(pm * 256 + rr) * D + c] = (bf16_t)(cvt_pk_bf16(o, 0.f) & 0xffffu);
    }
}
__device__ __forceinline__ void lruscan_phase(const bf16_t* LA, const bf16_t* BV, bf16_t* GG, LAS unsigned char* lds) {
    LAS float* sA = (LAS float*)lds; LAS float* sB = sA + 64 * 64;
    const int tid__ = otid(); const int c8 = tid__ & 7, tc = tid__ >> 3;
    for (int unit = blockIdx.x; unit < 256; unit += gridDim.x) {
        const int b = unit >> 4, cgp = unit & 15;
        const size_t base = ((size_t)b * SEQ + tc * 32) * D + cgp * 64 + c8 * 8;
        float sl[8], Bv[8], h[8];
#pragma unroll
        for (int q = 0; q < 8; ++q) { sl[q] = 0.f; Bv[q] = 0.f; h[q] = 0.f; }
#pragma unroll 4
        for (int i = 0; i < 32; ++i) { float la[8], bb[8]; ld8(LA + base + (size_t)i * D, la); ld8(BV + base + (size_t)i * D, bb);
#pragma unroll
            for (int q = 0; q < 8; ++q) { Bv[q] = __expf(la[q]) * Bv[q] + bb[q]; sl[q] += la[q]; } }
#pragma unroll
        for (int q = 0; q < 8; ++q) { sA[tc * 64 + c8 * 8 + q] = __expf(sl[q]); sB[tc * 64 + c8 * 8 + q] = Bv[q]; }
        __syncthreads();
        for (int j = 0; j < tc; ++j) {
            const f32x4 a0 = *(const LAS f32x4*)(sA + j * 64 + c8 * 8), a1 = *(const LAS f32x4*)(sA + j * 64 + c8 * 8 + 4), b0 = *(const LAS f32x4*)(sB + j * 64 + c8 * 8), b1 = *(const LAS f32x4*)(sB + j * 64 + c8 * 8 + 4);
#pragma unroll
            for (int q = 0; q < 4; ++q) { h[q] = a0[q] * h[q] + b0[q]; h[4 + q] = a1[q] * h[4 + q] + b1[q]; } }
#pragma unroll 4
        for (int i = 0; i < 32; ++i) { float la[8], bb[8], gg[8], y[8]; ld8(LA + base + (size_t)i * D, la); ld8(BV + base + (size_t)i * D, bb); ld8(GG + base + (size_t)i * D, gg);
#pragma unroll
            for (int q = 0; q < 8; ++q) { h[q] = __expf(la[q]) * h[q] + bb[q]; y[q] = gg[q] * h[q]; }
            st8(GG + base + (size_t)i * D, y); }
        __syncthreads();
    }
}
__device__ __forceinline__ void ffn_fix_panel(const float* raw, const float* cw, const float* cb, bf16_t* Aout, int pm) {
    if ((pm & 7) == 0) return;
    const int tid = otid();
    float x0[11][2], x1[11][2], x2[11][2], w0[11][2], w1[11][2], w2[11][2], bb[11][2];
#pragma unroll
    for (int k = 0; k < 11; ++k) {
        const int idx = tid + k * NTHREADS, hc = idx % FH, rr = idx / FH, pn = hc >> 7, cl = hc & 127;
        const float* cur = raw + (size_t)(pm * 22 + pn) * 1024; const float* prv = raw + (size_t)((pm - 1) * 22 + pn) * 1024;
#pragma unroll
        for (int part = 0; part < 2; ++part) { const int off = part * 128 + cl, col = part * FH + hc;
            x0[k][part] = cur[rr * 256 + off]; x1[k][part] = rr ? cur[off] : prv[3 * 256 + off]; x2[k][part] = rr ? prv[3 * 256 + off] : prv[2 * 256 + off];
            bb[k][part] = cb[col]; w2[k][part] = cw[2 * F2 + col]; w1[k][part] = cw[F2 + col]; w0[k][part] = cw[col]; }
    }
#pragma unroll
    for (int k = 0; k < 11; ++k) {
        const int idx = tid + k * NTHREADS, hc = idx % FH, rr = idx / FH;
        const float hv = bb[k][0] + w2[k][0] * x0[k][0] + w1[k][0] * x1[k][0] + w0[k][0] * x2[k][0];
        const float hg = bb[k][1] + w2[k][1] * x0[k][1] + w1[k][1] * x1[k][1] + w0[k][1] * x2[k][1];
        const float o = hg * sigmoidf_(hg) * hv;
        Aout[(size_t)(pm * 256 + rr) * FH + hc] = (bf16_t)(cvt_pk_bf16(o, 0.f) & 0xffffu);
    }
}

__device__ __forceinline__ void s5_phase(const Params& P, const bf16_t* hn, bf16_t* ys, LAS unsigned char* lds) {
    const int tid__ = otid(); const int lane = tid__ & 63, wave = tid__ >> 6;
    if (wave >= 4) { weights_phase(P, (LAS float*)(lds + 65536 + (wave - 4) * 8448), lane, P.nitems_a, P.nitems, blockIdx.x * 4 + (wave - 4), gridDim.x * 4); return; }
    LAS unsigned* S = (LAS unsigned*)(lds + wave * 8704);
    const float* lam_re = P.in[6]; const float* lam_im = P.in[7]; const float* log_dt = P.in[8]; const float* b_re = P.in[9]; const float* b_im = P.in[10];
    const float* c_re = P.in[11]; const float* c_im = P.in[12]; const float* dsk = P.in[13];
    const int c32 = lane & 31, hf = lane >> 5, c16 = lane & 15, q4 = lane >> 4;
    for (int unit = blockIdx.x * 4 + wave; unit < 1024; unit += gridDim.x * 4) {
        const int b = unit >> 6, g = unit & 63;
        const float dt = expf(log_dt[g]);
        float ar, ai;
        { const float lr = fminf(lam_re[g * 64 + lane], -1e-4f), li = lam_im[g * 64 + lane]; const float er = expf(lr * dt); ar = er * cosf(li * dt); ai = er * sinf(li * dt); }
        bf16x8 Bre[2], Bim[2];
#pragma unroll
        for (int pb = 0; pb < 2; ++pb) {
            const int pp = pb * 32 + c32;
            const float lr = fminf(lam_re[g * 64 + pp], -1e-4f), li = lam_im[g * 64 + pp]; const float er = expf(lr * dt);
            const float nr = er * cosf(li * dt) - 1.0f, ni = er * sinf(li * dt), dd = lr * lr + li * li;
            const float cr = (nr * lr + ni * li) / dd, ci = (ni * lr - nr * li) / dd;
            const float* br = b_re + (size_t)(g * 64 + pp) * 16 + 8 * hf; const float* bi = b_im + (size_t)(g * 64 + pp) * 16 + 8 * hf;
            unsigned wr_[4], wi_[4];
#pragma unroll
            for (int i = 0; i < 4; ++i) { const float r0 = br[2 * i], i0 = bi[2 * i], r1 = br[2 * i + 1], i1 = bi[2 * i + 1];
                wr_[i] = cvt_pk_bf16(cr * r0 - ci * i0, cr * r1 - ci * i1); wi_[i] = cvt_pk_bf16(cr * i0 + ci * r0, cr * i1 + ci * r1); }
            Bre[pb] = __builtin_bit_cast(bf16x8, (u32x4){wr_[0], wr_[1], wr_[2], wr_[3]}); Bim[pb] = __builtin_bit_cast(bf16x8, (u32x4){wi_[0], wi_[1], wi_[2], wi_[3]});
        }
        bf16x8 Cf[4];
#pragma unroll
        for (int kb = 0; kb < 4; ++kb) { const int p0 = kb * 16 + 4 * q4; const float* cr = c_re + (size_t)(g * 16 + c16) * 64 + p0; const float* ci = c_im + (size_t)(g * 16 + c16) * 64 + p0;
            Cf[kb] = __builtin_bit_cast(bf16x8, (u32x4){cvt_pk_bf16(cr[0], -ci[0]), cvt_pk_bf16(cr[1], -ci[1]), cvt_pk_bf16(cr[2], -ci[2]), cvt_pk_bf16(cr[3], -ci[3])}); }
        float dk[4];
#pragma unroll
        for (int r = 0; r < 4; ++r) dk[r] = dsk[g * 16 + 4 * q4 + r];
        float sr = 0.f, si = 0.f;
        const bf16_t* hb = hn + (size_t)b * SEQ * D + g * 16; bf16_t* yb = ys + (size_t)b * SEQ * D + g * 16;
        bf16x8 ufn = *(const bf16x8*)(hb + (size_t)c32 * D + 8 * hf);
        u32x2 uwn[2];
#pragma unroll
        for (int tb = 0; tb < 2; ++tb) uwn[tb] = *(const u32x2*)(hb + (size_t)(tb * 16 + c16) * D + 4 * q4);
        for (int c = 0; c < SEQ / 32; ++c) {
            const int t0 = c * 32;
            const bf16x8 uf = ufn; const u32x2 uwc[2] = {uwn[0], uwn[1]};
            { const int tn = (c + 1 < SEQ / 32) ? t0 + 32 : t0;
              ufn = *(const bf16x8*)(hb + (size_t)(tn + c32) * D + 8 * hf);
#pragma unroll
              for (int tb = 0; tb < 2; ++tb) uwn[tb] = *(const u32x2*)(hb + (size_t)(tn + tb * 16 + c16) * D + 4 * q4); }
            const f32x16 z16 = {0.f, 0.f, 0.f, 0.f, 0.f, 0.f, 0.f, 0.f, 0.f, 0.f, 0.f, 0.f, 0.f, 0.f, 0.f, 0.f};
            f32x16 r0 = __builtin_amdgcn_mfma_f32_32x32x16_bf16(uf, Bre[0], z16, 0, 0, 0), r1 = __builtin_amdgcn_mfma_f32_32x32x16_bf16(uf, Bre[1], z16, 0, 0, 0);
            f32x16 i0 = __builtin_amdgcn_mfma_f32_32x32x16_bf16(uf, Bim[0], z16, 0, 0, 0), i1 = __builtin_amdgcn_mfma_f32_32x32x16_bf16(uf, Bim[1], z16, 0, 0, 0);
#pragma unroll
            for (int q = 0; q < 4; ++q) {
                float xr[8], xi[8];
#pragma unroll
                for (int i = 0; i < 4; ++i) {
                    auto pr = __builtin_amdgcn_permlane32_swap(__float_as_uint(r0[4 * q + i]), __float_as_uint(r1[4 * q + i]), false, false);
                    auto pi = __builtin_amdgcn_permlane32_swap(__float_as_uint(i0[4 * q + i]), __float_as_uint(i1[4 * q + i]), false, false);
                    xr[i] = __uint_as_float(pr[0]); xr[4 + i] = __uint_as_float(pr[1]); xi[i] = __uint_as_float(pi[0]); xi[4 + i] = __uint_as_float(pi[1]); }
#pragma unroll
                for (int i = 0; i < 8; ++i) { const float nr = ar * sr - ai * si + xr[i], ni = ar * si + ai * sr + xi[i]; sr = nr; si = ni;
                    S[(8 * q + i) * 68 + lane] = cvt_pk_bf16(sr, si); }
            }
            asm volatile("" ::: "memory");
#pragma unroll
            for (int tb = 0; tb < 2; ++tb) {
                f32x4 y = (f32x4){0.f, 0.f, 0.f, 0.f};
#pragma unroll
                for (int kb = 0; kb < 4; ++kb) { const bf16x8 sf = __builtin_bit_cast(bf16x8, *(const LAS u32x4*)(S + (tb * 16 + c16) * 68 + kb * 16 + 4 * q4));
                    y = __builtin_amdgcn_mfma_f32_16x16x32_bf16(Cf[kb], sf, y, 0, 0, 0); }
                const size_t off = (size_t)(t0 + tb * 16 + c16) * D + 4 * q4;
                const u32x2 uw = uwc[tb];
                const float u0 = bflo(uw.x), u1 = bfhi(uw.x), u2 = bflo(uw.y), u3 = bfhi(uw.y);
                u32x2 w; w.x = cvt_pk_bf16(gelu_tanh(y[0] + dk[0] * u0), gelu_tanh(y[1] + dk[1] * u1)); w.y = cvt_pk_bf16(gelu_tanh(y[2] + dk[2] * u2), gelu_tanh(y[3] + dk[3] * u3));
                *(u32x2*)(yb + off) = w;
            }
        }
    }
}

__device__ __forceinline__ void attn_phase(const bf16_t* Q, const bf16_t* Kb, const bf16_t* V, bf16_t* VT, bf16_t* O, LAS unsigned char* lds) {
    const int tid__ = otid(); const int lane = tid__ & 63, wave = tid__ >> 6, c32 = lane & 31, hf = lane >> 5;
    for (int bh = blockIdx.x; bh < 256; bh += gridDim.x) {
        const int b = bh >> 4, h = bh & 15;
        bf16_t* vtw = VT + (size_t)(b * 16 + h) * 64 * SEQ;
        {
            LAS bf16_t* scr = (LAS bf16_t*)(lds + wave * 8704);
            for (int st = wave * 4; st < wave * 4 + 4; ++st) {
                const int s0 = st * 64;
#pragma unroll
                for (int j = 0; j < 8; ++j) { const int i = (lane >> 3) + 8 * j, c = lane & 7;
                    const u32x4 w = *(const u32x4*)(V + (size_t)(b * SEQ + s0 + i) * D + h * 64 + 8 * c);
                    *(LAS u32x2*)(scr + i * 68 + 8 * c) = (u32x2){w.x, w.y}; *(LAS u32x2*)(scr + i * 68 + 8 * c + 4) = (u32x2){w.z, w.w}; }
                asm volatile("s_waitcnt lgkmcnt(0)" ::: "memory");
#pragma unroll
                for (int j = 0; j < 8; ++j) { const int d = (lane >> 3) + 8 * j, c = lane & 7;
                    unsigned short e[8];
#pragma unroll
                    for (int k = 0; k < 8; ++k) e[k] = scr[(8 * c + k) * 68 + d];
                    u32x4 w; w.x = e[0] | ((unsigned)e[1] << 16); w.y = e[2] | ((unsigned)e[3] << 16); w.z = e[4] | ((unsigned)e[5] << 16); w.w = e[6] | ((unsigned)e[7] << 16);
                    *(u32x4*)(vtw + (size_t)d * SEQ + s0 + 8 * c) = w; }
                asm volatile("s_waitcnt lgkmcnt(0)" ::: "memory");
            }
            asm volatile("s_waitcnt vmcnt(0)" ::: "memory"); __syncthreads();
        }
        const bf16_t* vtb = vtw;
        for (int it = 0; it < 8; ++it) {
            const int qb = wave * 8 + it, t0 = qb * 32;
            const bf16_t* qp = Q + (size_t)(b * SEQ + t0 + c32) * D + h * 64 + 8 * hf;
            bf16x8 qf[4];
#pragma unroll
            for (int kd = 0; kd < 4; ++kd) qf[kd] = *(const bf16x8*)(qp + 16 * kd);
            f32x16 o0 = {0.f, 0.f, 0.f, 0.f, 0.f, 0.f, 0.f, 0.f, 0.f, 0.f, 0.f, 0.f, 0.f, 0.f, 0.f, 0.f}, o1 = o0;
            float R = 0.f;
            bf16x8 kfn[4];
            { const bf16_t* kp = Kb + (size_t)(b * SEQ + qb * 32 + c32) * D + h * 64 + 8 * hf;
#pragma unroll
              for (int kd = 0; kd < 4; ++kd) kfn[kd] = *(const bf16x8*)(kp + 16 * kd); }
            for (int kt = qb; kt >= 0; --kt) {
                const int s0 = kt * 32;
                f32x16 z = {0.f, 0.f, 0.f, 0.f, 0.f, 0.f, 0.f, 0.f, 0.f, 0.f, 0.f, 0.f, 0.f, 0.f, 0.f, 0.f};
#pragma unroll
                for (int kd = 0; kd < 4; ++kd) z = __builtin_amdgcn_mfma_f32_32x32x16_bf16(kfn[kd], qf[kd], z, 0, 0, 0);
                { const int sn = kt > 0 ? s0 - 32 : s0;
                  const bf16_t* kp = Kb + (size_t)(b * SEQ + sn + c32) * D + h * 64 + 8 * hf;
#pragma unroll
                  for (int kd = 0; kd < 4; ++kd) kfn[kd] = *(const bf16x8*)(kp + 16 * kd); }
                bf16x8 vf[2][2];
#pragma unroll
                for (int db = 0; db < 2; ++db)
#pragma unroll
                    for (int ks = 0; ks < 2; ++ks) { const bf16_t* vp = vtb + (size_t)(db * 32 + c32) * SEQ + s0 + 16 * ks + 4 * hf;
                        const u32x2 a = *(const u32x2*)vp, c = *(const u32x2*)(vp + 8); vf[db][ks] = __builtin_bit_cast(bf16x8, (u32x4){a.x, a.y, c.x, c.y}); }
                float L[16], lg[16];
                const bool diag = (kt == qb);
#pragma unroll
                for (int r = 0; r < 16; ++r) { const float zz = z[r]; const float sp = fmaxf(zz, 0.f) + __logf(1.0f + __expf(-fabsf(zz)));
                    const int sl = 8 * (r >> 2) + 4 * hf + (r & 3); const bool valid = !diag || (sl < c32);
                    L[r] = valid ? -sp : 0.f; lg[r] = valid ? zz - sp : -1e30f; }
                float bs[4], pbs[4];
#pragma unroll
                for (int q = 0; q < 4; ++q) { bs[q] = (L[4 * q] + L[4 * q + 1]) + (L[4 * q + 2] + L[4 * q + 3]); pbs[q] = __shfl_xor(bs[q], 32); }
                float after = R; float att[16];
#pragma unroll
                for (int q = 3; q >= 0; --q) {
                    const float off = after + (hf == 0 ? pbs[q] : 0.f);
                    const float e3 = off, e2 = e3 + L[4 * q + 3], e1 = e2 + L[4 * q + 2], e0 = e1 + L[4 * q + 1];
                    att[4 * q + 3] = __expf(lg[4 * q + 3] + e3); att[4 * q + 2] = __expf(lg[4 * q + 2] + e2); att[4 * q + 1] = __expf(lg[4 * q + 1] + e1); att[4 * q] = __expf(lg[4 * q] + e0);
                    after += bs[q] + pbs[q];
                }
                R = after;
#pragma unroll
                for (int ks = 0; ks < 2; ++ks) {
                    const bf16x8 pf = __builtin_bit_cast(bf16x8, (u32x4){cvt_pk_bf16(att[8 * ks], att[8 * ks + 1]), cvt_pk_bf16(att[8 * ks + 2], att[8 * ks + 3]), cvt_pk_bf16(att[8 * ks + 4], att[8 * ks + 5]), cvt_pk_bf16(att[8 * ks + 6], att[8 * ks + 7])});
                    o0 = __builtin_amdgcn_mfma_f32_32x32x16_bf16(vf[0][ks], pf, o0, 0, 0, 0); o1 = __builtin_amdgcn_mfma_f32_32x32x16_bf16(vf[1][ks], pf, o1, 0, 0, 0); }
                if (__all(R < -120.0f)) break;
            }
            bf16_t* op = O + (size_t)(b * SEQ + t0 + c32) * D + h * 64 + 4 * hf;
#pragma unroll
            for (int q = 0; q < 4; ++q) {
                u32x2 w0; w0.x = cvt_pk_bf16(o0[4 * q], o0[4 * q + 1]); w0.y = cvt_pk_bf16(o0[4 * q + 2], o0[4 * q + 3]); *(u32x2*)(op + 8 * q) = w0;
                u32x2 w1; w1.x = cvt_pk_bf16(o1[4 * q], o1[4 * q + 1]); w1.y = cvt_pk_bf16(o1[4 * q + 2], o1[4 * q + 3]); *(u32x2*)(op + 32 + 8 * q) = w1; }
        }
    }
}


__global__ void __launch_bounds__(NTHREADS, 2) fwd_megakernel(Params P) {
    extern __shared__ __attribute__((aligned(16))) unsigned char lds_raw[];
    LAS unsigned char* lds = (LAS unsigned char*)lds_raw;
    cg::grid_group grid = cg::this_grid();
    unsigned char* ws = P.ws;
    bf16_t* HN = (bf16_t*)(ws + WS_HN);
    bf16_t* B0 = (bf16_t*)(ws + WS_BIG); bf16_t* B1 = (bf16_t*)(ws + WS_BIG + ACT); bf16_t* B2 = (bf16_t*)(ws + WS_BIG + 2 * ACT); bf16_t* B3 = (bf16_t*)(ws + WS_BIG + 3 * ACT); bf16_t* B4 = (bf16_t*)(ws + WS_BIG + 4 * ACT);
    float* RAW = (float*)(ws + WS_RAW);
    float* X = P.out;
    const int G = gridDim.x, bx = blockIdx.x;
    pg8::StaticOrder S;
    volatile LAS unsigned* MISC = (volatile LAS unsigned*)(lds + MISC_OFF);
    if (threadIdx.x < 2) MISC[threadIdx.x] = 0u;
    __syncthreads();
    const XcdBarrier bar = xcd_barrier_post((unsigned*)ws, MISC);
    grid.sync();
#define SYNC() xcd_barrier(bar)

    { const int tid__ = otid(); const int lane = tid__ & 63, wave = tid__ >> 6;
      weights_phase(P, (LAS float*)(lds + wave * 8448), lane, 0, P.nitems_a, blockIdx.x * 8 + wave, gridDim.x * 8); }
    rmsnorm_phase(P.in[0], P.in[1], HN);
    SYNC();
#define FFN_BLOCK(layer, LASTSYNC) do { \
        rmsnorm_phase(X, P.in[2] + (layer) * D, HN); \
        SYNC(); \
        const float* cw = P.in[30] + (size_t)(layer) * 3 * F2; const float* cb = P.in[31] + (size_t)(layer) * F2; \
        { pg8::Gemm g{HN, (const bf16_t*)(ws + WS_WF1) + (size_t)(layer) * F2 * D, T, F2, 1024, D, D, 0, 0}; S.init(T, F2, G, bx); \
          EpiFfn1 E{B0, cw, cb, RAW, (LAS float*)(lds + XCH_OFF)}; pg8::gemm_phase(lds, g, S, E); } \
        SYNC(); \
        { pg8::Gemm g{B0, (const bf16_t*)(ws + WS_WF2) + (size_t)(layer) * D * FH, T, 1024, FH, FH, FH, 0, 0}; S.init(T, 1024, G, bx); \
          { Unit fu; int lastpm = -1; for (int i = 0; S.next(i, fu); ++i) if (fu.pm != lastpm) { ffn_fix_panel(RAW, cw, cb, B0, fu.pm); lastpm = fu.pm; } } \
          asm volatile("s_waitcnt vmcnt(0)" ::: "memory"); __syncthreads(); \
          EpiRes E{X, X, nullptr, nullptr}; pg8::gemm_phase(lds, g, S, E); } \
        if (LASTSYNC) SYNC(); } while (0)

    pool_phase(HN, B0);
    SYNC();
    { pg8::Gemm g{B0, (const bf16_t*)(ws + WS_WPOOL), T, 1024, 256, D, 256, 0, 512}; S.init(T, 1024, G, bx);
      EpiRes E{P.in[0], X, P.in[5], P.in[4]}; pg8::gemm_phase(lds, g, S, E); }
    SYNC();
    FFN_BLOCK(0, true);
    rmsnorm_phase(X, P.in[1] + 1 * D, HN);
    SYNC();
    s5_phase(P, HN, B0, lds);
    SYNC();
    { pg8::Gemm g{B0, (const bf16_t*)(ws + WS_WS5), T, 2048, 1024, D, D, 0, 0}; S.init(T, 2048, G, bx);
      EpiGateRes E{X, P.in[15]}; pg8::gemm_phase(lds, g, S, E); }
    SYNC();
    FFN_BLOCK(1, true);
    rmsnorm_phase(X, P.in[1] + 2 * D, HN);
    SYNC();
    { pg8::Gemm g{HN, (const bf16_t*)(ws + WS_WLIN), T, 2048, 1024, D, D, 0, 0}; S.init(T, 2048, G, bx);
      EpiLruIn E{B0, B2, P.in[17], P.in[18], (float*)(ws + WS_RAWL), (LAS float*)(lds + XCH_OFF)}; pg8::gemm_phase(lds, g, S, E); }
    SYNC();
    { pg8::Gemm g{B2, (const bf16_t*)(ws + WS_WGATE), T, 2048, 256, D, 256, 1, 512}; S.init(T, 2048, G, bx);
      { Unit fu; int lastpm = -1; for (int i = 0; S.next(i, fu); ++i) if (fu.pm != lastpm) { lru_fix_panel((const float*)(ws + WS_RAWL), P.in[17], P.in[18], B2, fu.pm); lastpm = fu.pm; } }
      asm volatile("s_waitcnt vmcnt(0)" ::: "memory"); __syncthreads();
      EpiGates E{B2, B3, B4, P.in[20], P.in[22], P.in[23]}; pg8::gemm_phase(lds, g, S, E); }
    SYNC();
    lruscan_phase(B3, B4, B0, lds);
    SYNC();
    { pg8::Gemm g{B0, (const bf16_t*)(ws + WS_WLOUT), T, 1024, 1024, D, D, 0, 0}; S.init(T, 1024, G, bx);
      EpiRes E{X, X, nullptr, nullptr}; pg8::gemm_phase(lds, g, S, E); }
    SYNC();
    FFN_BLOCK(2, true);
    rmsnorm_phase(X, P.in[1] + 3 * D, HN);
    SYNC();
    { pg8::Gemm g{HN, (const bf16_t*)(ws + WS_WQKV), T, 3072, 1024, D, D, 0, 0}; S.init(T, 3072, G, bx);
      EpiQKV E{B0, P.in[26], P.in[27]}; pg8::gemm_phase(lds, g, S, E); }
    SYNC();
    attn_phase(B0, B1, B2, B3, B4, lds);
    SYNC();
    { pg8::Gemm g{B4, (const bf16_t*)(ws + WS_WWO), T, 1024, 1024, D, D, 0, 0}; S.init(T, 1024, G, bx);
      EpiRes E{X, X, nullptr, nullptr}; pg8::gemm_phase(lds, g, S, E); }
    SYNC();
    FFN_BLOCK(3, false);
}

extern "C" void kernel_launch(void* const* d_in, const int* in_sizes, int n_in, void* d_out, int out_size, void* d_ws, size_t ws_size, hipStream_t stream) {
    static int grid = 0;
    if (grid == 0) {
        if (n_in != 33 || out_size != T * D || ws_size < WS_END) { fprintf(stderr, "kernel_launch: unexpected shapes (n_in %d out %d ws %zu)\n", n_in, out_size, ws_size); grid = -1; return; }
        int dev = 0, cus = 0, per_cu = 0;
        (void)hipGetDevice(&dev); (void)hipDeviceGetAttribute(&cus, hipDeviceAttributeMultiprocessorCount, dev);
        if (hipFuncSetAttribute((const void*)fwd_megakernel, hipFuncAttributeMaxDynamicSharedMemorySize, LDS_BYTES) != hipSuccess) { fprintf(stderr, "kernel_launch: hipFuncSetAttribute failed\n"); grid = -1; return; }
        (void)hipOccupancyMaxActiveBlocksPerMultiprocessor(&per_cu, (const void*)fwd_megakernel, NTHREADS, LDS_BYTES);
        (void)hipGetLastError();
        if (per_cu < 1) per_cu = 1;
        grid = cus * per_cu;
        if (grid > 256) grid = 256;
    }
    if (grid < 0) return;
    Params p; memset(&p, 0, sizeof(p));
    for (int i = 0; i < 33; ++i) p.in[i] = (const float*)d_in[i];
    p.out = (float*)d_out; p.ws = (unsigned char*)d_ws;
    unsigned char* ws = (unsigned char*)d_ws;
    int nj = 0, items = 0;
    auto add = [&](const float* src, bf16_t* dst, int K, int ld, int nrows, int map, int hh) {
        Job& j = p.jobs[nj++]; j.src = src; j.dst = dst; j.K = K; j.ld = ld; j.nrows = nrows; j.map = map; j.hh = hh; j.item0 = items; items += (K / 64) * (nrows / 32); };
    for (int l = 0; l < 2; ++l) add(p.in[29] + (size_t)l * D * F2, (bf16_t*)(ws + WS_WF1) + (size_t)l * F2 * D, 1024, F2, F2, 1, FH);
    for (int l = 0; l < 2; ++l) add(p.in[32] + (size_t)l * FH * D, (bf16_t*)(ws + WS_WF2) + (size_t)l * D * FH, FH, D, D, 0, 0);
    for (int gI = 0; gI < 4; ++gI) add(p.in[3] + (size_t)gI * 65536, (bf16_t*)(ws + WS_WPOOL) + (size_t)gI * 65536, 256, 256, 256, 0, 0);
    add(p.in[14], (bf16_t*)(ws + WS_WS5), 1024, 2048, 2048, 1, 1024);
    p.nitems_a = items;
    for (int l = 2; l < 4; ++l) add(p.in[29] + (size_t)l * D * F2, (bf16_t*)(ws + WS_WF1) + (size_t)l * F2 * D, 1024, F2, F2, 1, FH);
    for (int l = 2; l < 4; ++l) add(p.in[32] + (size_t)l * FH * D, (bf16_t*)(ws + WS_WF2) + (size_t)l * D * FH, FH, D, D, 0, 0);
    add(p.in[16], (bf16_t*)(ws + WS_WLIN), 1024, 2048, 2048, 0, 0);
    for (int pn = 0; pn < 8; ++pn) for (int bj = 0; bj < 2; ++bj)
        add((bj ? p.in[21] : p.in[19]) + (size_t)(pn >> 1) * 65536 + (pn & 1) * 128, (bf16_t*)(ws + WS_WGATE) + (size_t)(pn * 256 + bj * 128) * 256, 256, 256, 128, 0, 0);
    add(p.in[24], (bf16_t*)(ws + WS_WLOUT), 1024, 1024, 1024, 0, 0);
    add(p.in[25], (bf16_t*)(ws + WS_WQKV), 1024, 3072, 3072, 2, 0);
    add(p.in[28], (bf16_t*)(ws + WS_WWO), 1024, 1024, 1024, 0, 0);
    p.nitems = items;
    if (hipMemsetAsync(d_ws, 0, 16384, stream) != hipSuccess) { fprintf(stderr, "kernel_launch: memset failed\n"); return; }
    void* args[] = {&p};
    hipError_t e = hipLaunchCooperativeKernel((const void*)fwd_megakernel, dim3(grid), dim3(NTHREADS), args, LDS_BYTES, stream);
    if (e != hipSuccess) fprintf(stderr, "cooperative launch failed: %s (grid %d)\n", hipGetErrorString(e), grid);
}
```

```cpp
#include <hip/hip_runtime.h>
#include <hip/hip_cooperative_groups.h>
#include <cstdio>
#include <cstring>
namespace cg = cooperative_groups;

#define LAS __attribute__((address_space(3)))
typedef unsigned short bf16_t;
typedef short bf16x8 __attribute__((ext_vector_type(8)));
typedef short bf16x4 __attribute__((ext_vector_type(4)));
typedef float f32x4 __attribute__((ext_vector_type(4)));
typedef float f32x16 __attribute__((ext_vector_type(16)));
typedef unsigned u32x4 __attribute__((ext_vector_type(4)));
typedef unsigned u32x2 __attribute__((ext_vector_type(2)));

constexpr int T = 32768, D = 1024, SEQ = 2048, FH = 2816, F2 = 5632;
constexpr int NTHREADS = 512;
constexpr int LDS_BYTES = 147456;
constexpr int XCH_OFF = 131072, MISC_OFF = 131072 + 12288;
constexpr size_t MiB = 1u << 20;
constexpr size_t WS_WPOOL = 1 * MiB, WS_WS5 = 2 * MiB, WS_WLIN = 6 * MiB, WS_WGATE = 10 * MiB, WS_WLOUT = 11 * MiB,
                 WS_WQKV = 13 * MiB, WS_WWO = 19 * MiB, WS_WF1 = 21 * MiB, WS_WF2 = 65 * MiB,
                 WS_HN = 96 * MiB, WS_BIG = 160 * MiB, WS_RAW = 480 * MiB, WS_RAWL = 492 * MiB, WS_END = 496 * MiB;
constexpr size_t ACT = 64 * MiB;

typedef __bf16 bf16v2_t __attribute__((ext_vector_type(2)));
__device__ __forceinline__ unsigned cvt_pk_bf16(float lo, float hi) { const bf16v2_t v = {(__bf16)lo, (__bf16)hi}; return __builtin_bit_cast(unsigned, v); }
__device__ __forceinline__ float bf2f(unsigned short b) { return __uint_as_float(((unsigned)b) << 16); }
__device__ __forceinline__ float bflo(unsigned w) { return __uint_as_float(w << 16); }
__device__ __forceinline__ float bfhi(unsigned w) { return __uint_as_float(w & 0xffff0000u); }
__device__ __forceinline__ float sigmoidf_(float x) { return __builtin_amdgcn_rcpf(1.0f + __expf(-x)); }
__device__ __forceinline__ float gelu_tanh(float x) { const float k = 1.5957691216f * (x + 0.044715f * x * x * x); return x * __builtin_amdgcn_rcpf(1.0f + __expf(-k)); }
__device__ __forceinline__ float wave_sum(float v) {
#pragma unroll
    for (int o = 1; o < 64; o <<= 1) v += __shfl_xor(v, o);
    return v;
}
__device__ __forceinline__ int otid() { int t = threadIdx.x; asm volatile("" : "+v"(t)); return t; }
template <int CTRL> __device__ __forceinline__ float dpp_upd(float old, float src) {
    return __int_as_float(__builtin_amdgcn_update_dpp(__float_as_int(old), __float_as_int(src), CTRL, 0xf, 0xf, false));
}
template <int CTRL> __device__ __forceinline__ float dpp0(float src) { return __int_as_float(__builtin_amdgcn_update_dpp(0, __float_as_int(src), CTRL, 0xf, 0xf, true)); }
__device__ __forceinline__ float prev1(float prev, float cur) { const float t = dpp_upd<0x121>(0.f, prev); return dpp_upd<0x111>(t, cur); }
__device__ __forceinline__ float prev2(float prev, float cur) { const float t = dpp_upd<0x122>(0.f, prev); return dpp_upd<0x112>(t, cur); }

namespace pg8 {
constexpr int BM = 256, BK = 64, HALF = 128, HTB = HALF * BK * 2, STAGE_BYTES = 8 * HTB, NXCD = 8, WGM = 8;
__host__ __device__ __forceinline__ int lds_byte(int r, int c) { const int st = (r >> 4) * 2 + (c >> 5), rr = r & 15, cc = c & 31, ob = rr * 64 + cc * 2; return st * 1024 + (ob ^ (((ob >> 9) & 1) << 5)); }
__host__ __device__ __forceinline__ void stage_rc(int b, int& R, int& C) { const int st = b / 1024, sb = b % 1024, swz = sb ^ (((sb >> 9) & 1) << 5); R = (st >> 1) * 16 + swz / 64; C = (st & 1) * 32 + (swz % 64) / 2; }
__host__ __device__ __forceinline__ int perm32(int rho) { const int n = rho >> 4, i = rho & 15; return 8 * (i >> 2) + 4 * n + (i & 3); }
struct Unit { int pm, pn; };
struct Gemm { const bf16_t* A; const bf16_t* Bt; int M, N, K, lda, ldb, a_shift, a_step; };
struct StaticOrder {
    int nM, nN, nwg, G, c;
    __device__ __forceinline__ void init(int M, int N, int G_, int c_) { nM = M / BM; nN = N / BM; nwg = nM * nN; G = G_; c = c_; }
    __device__ __forceinline__ bool next(int i, Unit& u) const {
        const long L = (long)i * G + c; if (L >= nwg) return false;
        int wgid = (int)L; { const int q = nwg / NXCD, r = nwg % NXCD, xcd = wgid % NXCD, off = wgid / NXCD; wgid = (xcd < r ? xcd * (q + 1) : r * (q + 1) + (xcd - r) * q) + off; }
        const int nig = WGM * nN, gid = wgid / nig, fm = gid * WGM, gsz = (nM - fm) < WGM ? (nM - fm) : WGM;
        u.pm = fm + ((wgid % nig) % gsz); u.pn = (wgid % nig) / gsz; return true;
    }
};
template <class Epi>
__device__ __forceinline__ void gemm_phase(LAS unsigned char* lds, const Gemm g, const StaticOrder& S, const Epi& E) {
    int tid_ = threadIdx.x; asm volatile("" : "+v"(tid_));
    const int tid = tid_, wid = __builtin_amdgcn_readfirstlane(tid >> 6), lane = tid & 63, wr = wid >> 2, wc = wid & 3, fr = lane & 15, fq = lane >> 4;
    const int K = g.K, nt = K / BK;
    unsigned voffA[2], voffB[2];
#pragma unroll
    for (int i = 0; i < 2; ++i) { int R, C; stage_rc(tid * 16 + i * 8192, R, C); const int Rb = Epi::PERM ? ((R & ~31) + perm32(R & 31)) : R;
        const int Ra = Epi::ROWPERM ? ((R & ~63) + 4 * (R & 15) + ((R >> 4) & 3)) : R;
        voffA[i] = (unsigned)(Ra * g.lda + C) * 2u; voffB[i] = (unsigned)(Rb * g.ldb + C) * 2u; }
    const size_t kstep = (size_t)(BK * 2);
    const size_t hstepA = (size_t)HALF * g.lda * 2, hstepB = (size_t)HALF * g.ldb * 2;
    const size_t tstepA = 2 * hstepA, tstepB = 2 * hstepB;
    const unsigned ldsw = (unsigned)wid * 1024u;
    const int aoff = lds_byte(wr * 64 + fr, fq * 8), boff = lds_byte(wc * 32 + fr, fq * 8);
#define PG8_SA(b, h) (((b) * 2 + (h)) * HTB)
#define PG8_SB(b, h) ((4 + (b) * 2 + (h)) * HTB)
#define PG8_STAGE(bufoff, gbase, voff) do { _Pragma("unroll") for (int _i = 0; _i < 2; ++_i) \
        __builtin_amdgcn_global_load_lds((const unsigned*)((const char*)(gbase) + (voff)[_i]), (LAS unsigned*)(lds + (bufoff) + ldsw + _i * 8192), 16, 0, 0); } while (0)
#define PG8_LDA(dst, b, h) do { _Pragma("unroll") for (int m = 0; m < 4; ++m) _Pragma("unroll") for (int k = 0; k < 2; ++k) dst[m][k] = *(const LAS bf16x8*)(lds + PG8_SA(b, h) + aoff + m * 2048 + k * 1024); } while (0)
#define PG8_LDB(dst, b, h) do { _Pragma("unroll") for (int n = 0; n < 2; ++n) _Pragma("unroll") for (int k = 0; k < 2; ++k) dst[n][k] = *(const LAS bf16x8*)(lds + PG8_SB(b, h) + boff + n * 2048 + k * 1024); } while (0)
#define PG8_MMA(ai, bj, At, Bt) do { __builtin_amdgcn_s_setprio(1); _Pragma("unroll") for (int m = 0; m < 4; ++m) _Pragma("unroll") for (int n = 0; n < 2; ++n) _Pragma("unroll") for (int k = 0; k < 2; ++k) \
        acc[ai][bj][m][n] = __builtin_amdgcn_mfma_f32_16x16x32_bf16(Bt[n][k], At[m][k], acc[ai][bj][m][n], 0, 0, 0); __builtin_amdgcn_s_setprio(0); } while (0)
#define PG8_WAIT_V(n) asm volatile("s_waitcnt vmcnt(" #n ")" ::: "memory")
#define PG8_WAIT_L(n) asm volatile("s_waitcnt lgkmcnt(" #n ")" ::: "memory")
#define PG8_BAR __builtin_amdgcn_s_barrier()
#define PG8_SCHED __builtin_amdgcn_sched_barrier(0)
    Unit cur, nxt; int ui = 0;
    if (!S.next(0, cur)) return;
    f32x4 acc[2][2][4][2];
    {
#pragma unroll
    for (int a = 0; a < 2; ++a)
#pragma unroll
        for (int b = 0; b < 2; ++b)
#pragma unroll
            for (int m = 0; m < 4; ++m)
#pragma unroll
                for (int n = 0; n < 2; ++n) acc[a][b][m][n] = (f32x4){0.f, 0.f, 0.f, 0.f};
    }
    bf16x8 At[4][2], B0[2][2], B1[2][2];
    const char* cA = (const char*)g.A + (size_t)cur.pm * tstepA + (size_t)(cur.pn >> g.a_shift) * g.a_step; const char* cB = (const char*)g.Bt + (size_t)cur.pn * tstepB;
    PG8_STAGE(PG8_SB(0, 0), cB, voffB); PG8_STAGE(PG8_SA(0, 0), cA, voffA); PG8_STAGE(PG8_SB(0, 1), cB + hstepB, voffB); PG8_STAGE(PG8_SA(0, 1), cA + hstepA, voffA);
    if (wr == 1) PG8_BAR;
    PG8_WAIT_V(4); PG8_BAR;
    PG8_STAGE(PG8_SB(1, 0), cB + kstep, voffB); PG8_STAGE(PG8_SA(1, 0), cA + kstep, voffA); PG8_STAGE(PG8_SB(1, 1), cB + hstepB + kstep, voffB);
    PG8_WAIT_V(6); PG8_BAR;
    for (;;) {
        const bool has_next = S.next(ui + 1, nxt);
        const char* nA = has_next ? (const char*)g.A + (size_t)nxt.pm * tstepA + (size_t)(nxt.pn >> g.a_shift) * g.a_step : cA; const char* nB = has_next ? (const char*)g.Bt + (size_t)nxt.pn * tstepB : cB;
        for (int t = 0; t < nt; t += 2) {
            const bool last = (t == nt - 2);
            const char* a1 = cA + (size_t)(t + 1) * kstep;
            const char* a2 = last ? nA : cA + (size_t)(t + 2) * kstep; const char* b2 = last ? nB : cB + (size_t)(t + 2) * kstep;
            const char* a3 = a2 + kstep; const char* b3 = b2 + kstep;
            PG8_LDB(B0, 0, 0); PG8_SCHED; PG8_LDA(At, 0, 0); PG8_STAGE(PG8_SA(1, 1), a1 + hstepA, voffA);
            PG8_WAIT_L(8); PG8_BAR; PG8_WAIT_L(0); PG8_MMA(0, 0, At, B0); PG8_BAR; PG8_SCHED;
            PG8_LDB(B1, 0, 1); PG8_STAGE(PG8_SB(0, 0), b2, voffB);
            PG8_BAR; PG8_WAIT_L(0); PG8_MMA(0, 1, At, B1); PG8_BAR;
            PG8_LDA(At, 0, 1); PG8_STAGE(PG8_SA(0, 0), a2, voffA);
            PG8_BAR; PG8_WAIT_L(0); PG8_MMA(1, 0, At, B0); PG8_BAR; PG8_SCHED;
            PG8_STAGE(PG8_SB(0, 1), b2 + hstepB, voffB);
            PG8_WAIT_V(6); PG8_BAR; PG8_MMA(1, 1, At, B1); PG8_BAR;
            PG8_LDB(B0, 1, 0); PG8_SCHED; PG8_LDA(At, 1, 0); PG8_STAGE(PG8_SA(0, 1), a2 + hstepA, voffA);
            PG8_WAIT_L(8); PG8_BAR; PG8_WAIT_L(0); PG8_MMA(0, 0, At, B0); PG8_BAR; PG8_SCHED;
            PG8_LDB(B1, 1, 1); PG8_STAGE(PG8_SB(1, 0), b3, voffB);
            PG8_BAR; PG8_WAIT_L(0); PG8_MMA(0, 1, At, B1); PG8_BAR;
            PG8_LDA(At, 1, 1); PG8_STAGE(PG8_SA(1, 0), a3, voffA);
            PG8_BAR; PG8_WAIT_L(0); PG8_MMA(1, 0, At, B0); PG8_BAR; PG8_SCHED;
            PG8_STAGE(PG8_SB(1, 1), b3 + hstepB, voffB);
            PG8_WAIT_V(6); PG8_BAR; PG8_MMA(1, 1, At, B1); PG8_BAR;
        }
        E(acc, cur, wr, wc, fr, fq);
        if (!has_next) break;
        {
#pragma unroll
        for (int a = 0; a < 2; ++a)
#pragma unroll
            for (int b = 0; b < 2; ++b)
#pragma unroll
                for (int m = 0; m < 4; ++m)
#pragma unroll
                    for (int n = 0; n < 2; ++n) acc[a][b][m][n] = (f32x4){0.f, 0.f, 0.f, 0.f};
        }
        cur = nxt; cA = nA; cB = nB; ++ui;
    }
    PG8_WAIT_V(0);
    if (wr == 0) PG8_BAR;
    PG8_BAR;
#undef PG8_SA
#undef PG8_SB
#undef PG8_STAGE
#undef PG8_LDA
#undef PG8_LDB
#undef PG8_MMA
#undef PG8_WAIT_V
#undef PG8_WAIT_L
#undef PG8_BAR
#undef PG8_SCHED
}
}
using pg8::Unit;
typedef const f32x4 (&AccRef)[2][2][4][2];

struct EpiRes {
    static constexpr bool PERM = false, ROWPERM = false;
    const float* base; float* out; const float* scale; const float* bias;
    __device__ __forceinline__ void operator()(AccRef acc, const Unit& u, int wr, int wc, int fr, int fq) const {
        const int row0 = u.pm * 256 + wr * 64 + fr, col0 = u.pn * 256 + wc * 32 + 4 * fq;
        f32x4 sv[2][2], bv[2][2];
#pragma unroll
        for (int bj = 0; bj < 2; ++bj)
#pragma unroll
            for (int n = 0; n < 2; ++n) {
                sv[bj][n] = scale ? *(const f32x4*)(scale + col0 + bj * 128 + n * 16) : (f32x4){1.f, 1.f, 1.f, 1.f};
                bv[bj][n] = bias ? *(const f32x4*)(bias + col0 + bj * 128 + n * 16) : (f32x4){0.f, 0.f, 0.f, 0.f}; }
#pragma unroll
        for (int ai = 0; ai < 2; ++ai)
#pragma unroll
            for (int mh = 0; mh < 2; ++mh) {
                f32x4 bs[2][2][2];
#pragma unroll
                for (int m = 0; m < 2; ++m)
#pragma unroll
                    for (int bj = 0; bj < 2; ++bj)
#pragma unroll
                        for (int n = 0; n < 2; ++n) bs[m][bj][n] = *(const f32x4*)(base + (size_t)(row0 + ai * 128 + (2 * mh + m) * 16) * D + col0 + bj * 128 + n * 16);
#pragma unroll
                for (int m = 0; m < 2; ++m)
#pragma unroll
                    for (int bj = 0; bj < 2; ++bj)
#pragma unroll
                        for (int n = 0; n < 2; ++n) *(f32x4*)(out + (size_t)(row0 + ai * 128 + (2 * mh + m) * 16) * D + col0 + bj * 128 + n * 16) = bs[m][bj][n] + sv[bj][n] * (acc[ai][bj][2 * mh + m][n] + bv[bj][n]);
                asm volatile("" ::: "memory"); }
    }
};
struct EpiGateRes {
    static constexpr bool PERM = true, ROWPERM = false;
    float* x; const float* bias;
    __device__ __forceinline__ void operator()(AccRef acc, const Unit& u, int wr, int wc, int fr, int fq) const {
        const int row0 = u.pm * 256 + wr * 64 + fr, col0 = u.pn * 128 + wc * 32 + 8 * fq;
        f32x4 bv[2], bg[2];
#pragma unroll
        for (int n = 0; n < 2; ++n) { bv[n] = *(const f32x4*)(bias + col0 + 4 * n); bg[n] = *(const f32x4*)(bias + D + col0 + 4 * n); }
#pragma unroll
        for (int ai = 0; ai < 2; ++ai) {
            f32x4 xs[4][2];
#pragma unroll
            for (int m = 0; m < 4; ++m)
#pragma unroll
                for (int n = 0; n < 2; ++n) xs[m][n] = *(const f32x4*)(x + (size_t)(row0 + ai * 128 + m * 16) * D + col0 + 4 * n);
#pragma unroll
            for (int m = 0; m < 4; ++m)
#pragma unroll
                for (int n = 0; n < 2; ++n) { f32x4 xv = xs[m][n]; const f32x4 v = acc[ai][0][m][n] + bv[n], gt = acc[ai][1][m][n] + bg[n];
#pragma unroll
                    for (int j = 0; j < 4; ++j) xv[j] += v[j] * sigmoidf_(gt[j]);
                    *(f32x4*)(x + (size_t)(row0 + ai * 128 + m * 16) * D + col0 + 4 * n) = xv; }
            asm volatile("" ::: "memory"); }
    }
};
struct EpiLruIn {
    static constexpr bool PERM = true, ROWPERM = true;
    bf16_t* GG; bf16_t* REC; const float* cw; const float* cb; float* rawl; LAS float* xch;
    __device__ __forceinline__ void operator()(AccRef acc, const Unit& u, int wr, int wc, int fr, int fq) const {
        const int row0 = u.pm * 256 + wr * 64 + 4 * fr, clb = wc * 32 + 8 * fq, col0 = (u.pn & 3) * 256 + clb;
        if (u.pn < 4) {
#pragma unroll
            for (int ai = 0; ai < 2; ++ai)
#pragma unroll
                for (int m = 0; m < 4; ++m) { bf16_t* rp = GG + (size_t)(row0 + ai * 128 + m) * D + col0;
#pragma unroll
                    for (int bj = 0; bj < 2; ++bj) { f32x4 v0 = acc[ai][bj][m][0], v1 = acc[ai][bj][m][1];
#pragma unroll
                        for (int j = 0; j < 4; ++j) { v0[j] = gelu_tanh(v0[j]); v1[j] = gelu_tanh(v1[j]); }
                        u32x4 w; w.x = cvt_pk_bf16(v0[0], v0[1]); w.y = cvt_pk_bf16(v0[2], v0[3]); w.z = cvt_pk_bf16(v1[0], v1[1]); w.w = cvt_pk_bf16(v1[2], v1[3]);
                        *(u32x4*)(rp + bj * 128) = w; } }
            return;
        }
        if (fr == 15) {
#pragma unroll
            for (int ai = 0; ai < 2; ++ai)
#pragma unroll
                for (int bj = 0; bj < 2; ++bj)
#pragma unroll
                    for (int n = 0; n < 2; ++n)
#pragma unroll
                        for (int q = 0; q < 3; ++q) *(LAS f32x4*)(xch + ((ai * 2 + wr) * 3 + q) * 256 + bj * 128 + clb + 4 * n) = acc[ai][bj][1 + q][n];
        }
        float* rawu = rawl + (size_t)(u.pm * 4 + (u.pn - 4)) * 6 * 256;
        if (wr == 0 && fr == 0) {
#pragma unroll
            for (int bj = 0; bj < 2; ++bj)
#pragma unroll
                for (int n = 0; n < 2; ++n)
#pragma unroll
                    for (int q = 0; q < 3; ++q) *(f32x4*)(rawu + q * 256 + bj * 128 + clb + 4 * n) = acc[0][bj][q][n];
        }
        if (wr == 1 && fr == 15) {
#pragma unroll
            for (int bj = 0; bj < 2; ++bj)
#pragma unroll
                for (int n = 0; n < 2; ++n)
#pragma unroll
                    for (int q = 0; q < 3; ++q) *(f32x4*)(rawu + (3 + q) * 256 + bj * 128 + clb + 4 * n) = acc[1][bj][1 + q][n];
        }
        asm volatile("s_waitcnt lgkmcnt(0)" ::: "memory"); __builtin_amdgcn_s_barrier(); __builtin_amdgcn_s_barrier(); asm volatile("" ::: "memory");
#pragma unroll
        for (int bj = 0; bj < 2; ++bj)
#pragma unroll
            for (int n = 0; n < 2; ++n) {
                const int c0 = col0 + bj * 128 + 4 * n;
                const f32x4 w0 = *(const f32x4*)(cw + c0), w1 = *(const f32x4*)(cw + D + c0), w2 = *(const f32x4*)(cw + 2 * D + c0), w3 = *(const f32x4*)(cw + 3 * D + c0), bb = *(const f32x4*)(cb + c0);
#pragma unroll
                for (int ai = 0; ai < 2; ++ai) {
                    f32x4 h1 = (f32x4){0.f, 0.f, 0.f, 0.f}, h2 = h1, h3 = h1;
                    const int pb = ai * 2 + wr - 1;
                    if (pb >= 0 && fr == 0) { const LAS float* xp = xch + (pb * 3) * 256 + bj * 128 + clb + 4 * n; h1 = *(const LAS f32x4*)(xp); h2 = *(const LAS f32x4*)(xp + 256); h3 = *(const LAS f32x4*)(xp + 512); }
                    float o[4][4];
#pragma unroll
                    for (int j = 0; j < 4; ++j) {
                        const float v0 = acc[ai][bj][0][n][j], v1 = acc[ai][bj][1][n][j], v2 = acc[ai][bj][2][n][j], v3 = acc[ai][bj][3][n][j];
                        const float p3 = dpp_upd<0x111>(h3[j], v3), p2 = dpp_upd<0x111>(h2[j], v2), p1 = dpp_upd<0x111>(h1[j], v1);
                        o[0][j] = bb[j] + w3[j] * v0 + w2[j] * p3 + w1[j] * p2 + w0[j] * p1;
                        o[1][j] = bb[j] + w3[j] * v1 + w2[j] * v0 + w1[j] * p3 + w0[j] * p2;
                        o[2][j] = bb[j] + w3[j] * v2 + w2[j] * v1 + w1[j] * v0 + w0[j] * p3;
                        o[3][j] = bb[j] + w3[j] * v3 + w2[j] * v2 + w1[j] * v1 + w0[j] * v0; }
#pragma unroll
                    for (int m = 0; m < 4; ++m) *(u32x2*)(REC + (size_t)(row0 + ai * 128 + m) * D + c0) = (u32x2){cvt_pk_bf16(o[m][0], o[m][1]), cvt_pk_bf16(o[m][2], o[m][3])};
                }
            }
    }
};
struct EpiGates {
    static constexpr bool PERM = true, ROWPERM = false;
    const bf16_t* REC; bf16_t* LA; bf16_t* BV; const float* b_a; const float* b_x; const float* lam;
    __device__ __forceinline__ void operator()(AccRef acc, const Unit& u, int wr, int wc, int fr, int fq) const {
        const int row0 = u.pm * 256 + wr * 64 + fr, col0 = u.pn * 128 + wc * 32 + 8 * fq;
        u32x4 rws[2][4];
#pragma unroll
        for (int ai = 0; ai < 2; ++ai)
#pragma unroll
            for (int m = 0; m < 4; ++m) rws[ai][m] = *(const u32x4*)(REC + (size_t)(row0 + ai * 128 + m * 16) * D + col0);
#pragma unroll
        for (int n = 0; n < 2; ++n) {
            const f32x4 ba = *(const f32x4*)(b_a + col0 + 4 * n), bx = *(const f32x4*)(b_x + col0 + 4 * n), l = *(const f32x4*)(lam + col0 + 4 * n);
            f32x4 k8;
#pragma unroll
            for (int j = 0; j < 4; ++j) k8[j] = -8.0f * __logf(1.0f + __expf(-l[j]));
#pragma unroll
            for (int ai = 0; ai < 2; ++ai)
#pragma unroll
                for (int m = 0; m < 4; ++m) { const size_t off = (size_t)(row0 + ai * 128 + m * 16) * D + col0 + 4 * n;
                    float lo[4], bo[4];
#pragma unroll
                    for (int j = 0; j < 4; ++j) { const unsigned w = rws[ai][m][2 * n + (j >> 1)]; const float rec = (j & 1) ? bfhi(w) : bflo(w);
                        const float r = sigmoidf_(acc[ai][0][m][n][j] + ba[j]), ig = sigmoidf_(acc[ai][1][m][n][j] + bx[j]);
                        const float la = k8[j] * r; const float mult = __builtin_sqrtf(1.0f - __expf(2.0f * la));
                        lo[j] = la; bo[j] = mult * ig * rec; }
                    *(u32x2*)(LA + off) = (u32x2){cvt_pk_bf16(lo[0], lo[1]), cvt_pk_bf16(lo[2], lo[3])}; *(u32x2*)(BV + off) = (u32x2){cvt_pk_bf16(bo[0], bo[1]), cvt_pk_bf16(bo[2], bo[3])}; }
        }
    }
};
struct EpiQKV {
    static constexpr bool PERM = true, ROWPERM = false;
    bf16_t* QKV; const float* qg; const float* kg;
    __device__ __forceinline__ void operator()(AccRef acc, const Unit& u, int wr, int wc, int fr, int fq) const {
        const int which = u.pn >> 2, row0 = u.pm * 256 + wr * 64 + fr, col0 = (u.pn & 3) * 256 + wc * 64 + 8 * fq;
        bf16_t* dst = QKV + (size_t)which * ((size_t)T * D);
        f32x4 gv[2][2];
#pragma unroll
        for (int bj = 0; bj < 2; ++bj)
#pragma unroll
            for (int n = 0; n < 2; ++n) { const f32x4 a = *(const f32x4*)(qg + 32 * bj + 8 * fq + 4 * n), b = *(const f32x4*)(kg + 32 * bj + 8 * fq + 4 * n);
                gv[bj][n] = which == 0 ? a : (which == 1 ? b : (f32x4){1.f, 1.f, 1.f, 1.f}); }
#pragma unroll
        for (int ai = 0; ai < 2; ++ai)
#pragma unroll
            for (int m = 0; m < 4; ++m) {
                float sc = 1.0f;
                if (which < 2) { float ss = 0.f;
#pragma unroll
                    for (int bj = 0; bj < 2; ++bj)
#pragma unroll
                        for (int n = 0; n < 2; ++n) { const f32x4 v = acc[ai][bj][m][n]; ss += (v[0] * v[0] + v[1] * v[1]) + (v[2] * v[2] + v[3] * v[3]); }
                    ss += __shfl_xor(ss, 16); ss += __shfl_xor(ss, 32);
                    sc = rsqrtf(ss * (1.0f / 64.0f) + 1e-6f) * (which == 0 ? 0.18033688011112042f : 1.0f); }
                bf16_t* rp = dst + (size_t)(row0 + ai * 128 + m * 16) * D + col0;
#pragma unroll
                for (int bj = 0; bj < 2; ++bj) { const f32x4 v0 = acc[ai][bj][m][0] * gv[bj][0] * sc, v1 = acc[ai][bj][m][1] * gv[bj][1] * sc;
                    u32x4 w; w.x = cvt_pk_bf16(v0[0], v0[1]); w.y = cvt_pk_bf16(v0[2], v0[3]); w.z = cvt_pk_bf16(v1[0], v1[1]); w.w = cvt_pk_bf16(v1[2], v1[3]);
                    *(u32x4*)(rp + bj * 32) = w; } }
    }
};
struct EpiFfn1 {
    static constexpr bool PERM = true, ROWPERM = true;
    bf16_t* Aout; const float* cw; const float* cb; float* raw; LAS float* xch;
    __device__ __forceinline__ void operator()(AccRef acc, const Unit& u, int wr, int wc, int fr, int fq) const {
        const int clb = 32 * wc + 8 * fq;
        f32x4 cwv[2][8];
        { const float* cv = cw + 128 * u.pn + clb; const float* cg = cv + FH; const float* bp = cb + 128 * u.pn + clb;
          cwv[0][0] = *(const f32x4*)(cv); cwv[0][1] = *(const f32x4*)(cv + F2); cwv[0][2] = *(const f32x4*)(cv + 2 * F2); cwv[0][3] = *(const f32x4*)(bp);
          cwv[0][4] = *(const f32x4*)(cg); cwv[0][5] = *(const f32x4*)(cg + F2); cwv[0][6] = *(const f32x4*)(cg + 2 * F2); cwv[0][7] = *(const f32x4*)(bp + FH); }
        if (fr == 15) {
#pragma unroll
            for (int ai = 0; ai < 2; ++ai)
#pragma unroll
                for (int bj = 0; bj < 2; ++bj)
#pragma unroll
                    for (int n = 0; n < 2; ++n) { *(LAS f32x4*)(xch + ((ai * 2 + wr) * 2 + 0) * 256 + bj * 128 + clb + 4 * n) = acc[ai][bj][2][n]; *(LAS f32x4*)(xch + ((ai * 2 + wr) * 2 + 1) * 256 + bj * 128 + clb + 4 * n) = acc[ai][bj][3][n]; }
        }
        float* rawu = raw + (size_t)(u.pm * 22 + u.pn) * 1024;
        if (wr == 0 && fr == 0) {
#pragma unroll
            for (int bj = 0; bj < 2; ++bj)
#pragma unroll
                for (int n = 0; n < 2; ++n) { *(f32x4*)(rawu + 0 * 256 + bj * 128 + clb + 4 * n) = acc[0][bj][0][n]; *(f32x4*)(rawu + 1 * 256 + bj * 128 + clb + 4 * n) = acc[0][bj][1][n]; }
        }
        if (wr == 1 && fr == 15) {
#pragma unroll
            for (int bj = 0; bj < 2; ++bj)
#pragma unroll
                for (int n = 0; n < 2; ++n) { *(f32x4*)(rawu + 2 * 256 + bj * 128 + clb + 4 * n) = acc[1][bj][2][n]; *(f32x4*)(rawu + 3 * 256 + bj * 128 + clb + 4 * n) = acc[1][bj][3][n]; }
        }
        asm volatile("s_waitcnt lgkmcnt(0)" ::: "memory"); __builtin_amdgcn_s_barrier(); __builtin_amdgcn_s_barrier(); asm volatile("" ::: "memory");
        const int hc0 = 128 * u.pn + clb, row0 = u.pm * 256 + wr * 64 + 4 * fr;
#pragma unroll
        for (int n = 0; n < 2; ++n) {
            const f32x4 w0v = cwv[n][0], w1v = cwv[n][1], w2v = cwv[n][2], bvv = cwv[n][3], w0g = cwv[n][4], w1g = cwv[n][5], w2g = cwv[n][6], bvg = cwv[n][7];
#pragma unroll
            for (int ai = 0; ai < 2; ++ai) {
                if (n == 0 && ai == 0) {
                    asm volatile("" ::: "memory");
                    const float* cv = cw + hc0 + 4; const float* cg = cv + FH; const float* bp = cb + hc0 + 4;
                    cwv[1][0] = *(const f32x4*)(cv); cwv[1][1] = *(const f32x4*)(cv + F2); cwv[1][2] = *(const f32x4*)(cv + 2 * F2); cwv[1][3] = *(const f32x4*)(bp);
                    cwv[1][4] = *(const f32x4*)(cg); cwv[1][5] = *(const f32x4*)(cg + F2); cwv[1][6] = *(const f32x4*)(cg + 2 * F2); cwv[1][7] = *(const f32x4*)(bp + FH);
                    asm volatile("" ::: "memory"); }
                f32x4 h2v = (f32x4){0.f, 0.f, 0.f, 0.f}, h3v = h2v, h2g = h2v, h3g = h2v;
                const int pb = ai * 2 + wr - 1;
                if (pb >= 0 && fr == 0) { const LAS float* xp = xch + (pb * 2) * 256 + clb + 4 * n;
                    h2v = *(const LAS f32x4*)(xp); h3v = *(const LAS f32x4*)(xp + 256); h2g = *(const LAS f32x4*)(xp + 128); h3g = *(const LAS f32x4*)(xp + 256 + 128); }
                float o[4][4];
#pragma unroll
                for (int j = 0; j < 4; ++j) {
                    const float v0 = acc[ai][0][0][n][j], v1 = acc[ai][0][1][n][j], v2 = acc[ai][0][2][n][j], v3 = acc[ai][0][3][n][j];
                    const float g0 = acc[ai][1][0][n][j], g1 = acc[ai][1][1][n][j], g2 = acc[ai][1][2][n][j], g3 = acc[ai][1][3][n][j];
                    const float pv3 = dpp_upd<0x111>(h3v[j], v3), pv2 = dpp_upd<0x111>(h2v[j], v2), pg3 = dpp_upd<0x111>(h3g[j], g3), pg2 = dpp_upd<0x111>(h2g[j], g2);
                    const float hv0 = bvv[j] + w2v[j] * v0 + w1v[j] * pv3 + w0v[j] * pv2, hv1 = bvv[j] + w2v[j] * v1 + w1v[j] * v0 + w0v[j] * pv3;
                    const float hv2 = bvv[j] + w2v[j] * v2 + w1v[j] * v1 + w0v[j] * v0, hv3 = bvv[j] + w2v[j] * v3 + w1v[j] * v2 + w0v[j] * v1;
                    const float hg0 = bvg[j] + w2g[j] * g0 + w1g[j] * pg3 + w0g[j] * pg2, hg1 = bvg[j] + w2g[j] * g1 + w1g[j] * g0 + w0g[j] * pg3;
                    const float hg2 = bvg[j] + w2g[j] * g2 + w1g[j] * g1 + w0g[j] * g0, hg3 = bvg[j] + w2g[j] * g3 + w1g[j] * g2 + w0g[j] * g1;
                    o[0][j] = hg0 * sigmoidf_(hg0) * hv0; o[1][j] = hg1 * sigmoidf_(hg1) * hv1; o[2][j] = hg2 * sigmoidf_(hg2) * hv2; o[3][j] = hg3 * sigmoidf_(hg3) * hv3; }
#pragma unroll
                for (int m = 0; m < 4; ++m) { u32x2 w; w.x = cvt_pk_bf16(o[m][0], o[m][1]); w.y = cvt_pk_bf16(o[m][2], o[m][3]);
                    *(u32x2*)(Aout + (size_t)(row0 + ai * 128 + m) * FH + hc0 + 4 * n) = w; } } }
    }
};

#define XB_TMO      128
#define XB_XCNT(j)  (256  + 64 * (j))
#define XB_XSUB(j)  (1280 + 64 * (j))
#define XB_XGEN(j)  (2304 + 64 * (j))
#define XB_TOP      3328
#define XB_TOPGEN   3392
#define XCD_BAR_WORDS 3456
#define XB_SPIN_CAP (1u << 24)
__device__ __forceinline__ unsigned xb_ld(unsigned* p)              { return __hip_atomic_load(p, __ATOMIC_RELAXED, __HIP_MEMORY_SCOPE_AGENT); }
__device__ __forceinline__ unsigned xb_add(unsigned* p, unsigned v) { return __hip_atomic_fetch_add(p, v, __ATOMIC_RELAXED, __HIP_MEMORY_SCOPE_AGENT); }
__device__ __forceinline__ unsigned xb_xcc_id() { return (unsigned)__builtin_amdgcn_s_getreg((3 << 11) | 20) & 0xFu; }
#define XB_SPIN(cond, bar) do { unsigned _sp = 0; while (cond) { __builtin_amdgcn_s_sleep(1); \
    if ((++_sp & 255u) == 0u) { if (xb_ld(&(bar)[XB_TMO])) break; if (_sp > XB_SPIN_CAP) { atomicAdd(&(bar)[XB_TMO], 1u); break; } } } } while (0)
struct XcdBarrier { unsigned* bar; unsigned x; volatile LAS unsigned* st; };
__device__ __forceinline__ XcdBarrier xcd_barrier_post(unsigned* bar, volatile LAS unsigned* st) {
    XcdBarrier b; b.bar = bar; b.x = xb_xcc_id(); b.st = st;
    if (threadIdx.x == 0) (void)xb_add(&bar[XB_XCNT(b.x)], 1u);
    return b;
}
__device__ __forceinline__ void xcd_barrier_complete(unsigned* bar, unsigned x, unsigned& nloc, unsigned& nx) {
    const unsigned G = gridDim.x * gridDim.y * gridDim.z;
    unsigned sum, cnt, mine, sp = 0u;
    for (;;) {
        sum = 0u; cnt = 0u; mine = 0u;
#pragma unroll
        for (unsigned j = 0; j < 16; ++j) { const unsigned c = xb_ld(&bar[XB_XCNT(j)]); sum += c; cnt += (c > 0u) ? 1u : 0u; mine = (j == x) ? c : mine; }
        if (sum == G) break;
        __builtin_amdgcn_s_sleep(1);
        if ((++sp & 255u) == 0u) { if (xb_ld(&bar[XB_TMO])) break; if (sp > XB_SPIN_CAP) { atomicAdd(&bar[XB_TMO], 1u); break; } }
    }
    nloc = mine > 0u ? mine : 1u; nx = cnt > 0u ? cnt : 1u;
}
__device__ __forceinline__ void xcd_barrier(const XcdBarrier& b) {
    asm volatile("s_waitcnt vmcnt(0) lgkmcnt(0)" ::: "memory");
    __syncthreads();
    if (threadIdx.x == 0) {
        unsigned* bar = b.bar;
        __builtin_amdgcn_s_waitcnt(0);
        unsigned nloc = b.st[0], nx = b.st[1];
        if (nloc == 0u) { xcd_barrier_complete(bar, b.x, nloc, nx); b.st[0] = nloc; b.st[1] = nx; }
        const unsigned old = xb_add(&bar[XB_XSUB(b.x)], 1u);
        const unsigned gen = old / nloc;
        if (old + 1u == (gen + 1u) * nloc) {
            __builtin_amdgcn_fence(__ATOMIC_RELEASE, "agent");
            asm volatile("s_waitcnt vmcnt(0)" ::: "memory");
            const unsigned og = xb_add(&bar[XB_TOP], 1u);
            const unsigned tg = og / nx;
            if (og + 1u == (tg + 1u) * nx) xb_add(&bar[XB_TOPGEN], 1u);
            else XB_SPIN(xb_ld(&bar[XB_TOPGEN]) == tg, bar);
            __builtin_amdgcn_fence(__ATOMIC_ACQUIRE, "agent");
            xb_add(&bar[XB_XGEN(b.x)], 1u);
            asm volatile("s_waitcnt vmcnt(0)" ::: "memory");
        } else {
            XB_SPIN(xb_ld(&bar[XB_XGEN(b.x)]) == gen, bar);
            __builtin_amdgcn_fence(__ATOMIC_ACQUIRE, "agent");
            asm volatile("s_waitcnt vmcnt(0)" ::: "memory");
        }
    }
    __syncthreads();
}

struct Job { const float* src; bf16_t* dst; int K, ld, nrows, map, hh, item0; };
constexpr int NJOBS = 33;
struct Params {
    const float* in[33]; float* out; unsigned char* ws;
    Job jobs[NJOBS]; int nitems; int nitems_a;
};

__device__ __forceinline__ int map_col(int map, int hh, int j) {
    if (map == 0) return j;
    if (map == 1) { const int pn = j >> 8, bj = (j >> 7) & 1, i = j & 127; return bj * hh + 128 * pn + i; }
    const int pn = j >> 8, cl = j & 255, bj = cl >> 7, h4 = (cl & 127) >> 5, i = cl & 31; return 256 * pn + 64 * h4 + 32 * bj + i;
}

__device__ __forceinline__ void weights_phase(const Params& P, LAS float* scr, int lane, int it0, int it1, int w, int nw) {
    for (int it = it0 + w; it < it1; it += nw) {
        int ji = 0;
#pragma unroll 1
        for (int q = 1; q < NJOBS; ++q) if (it >= P.jobs[q].item0) ji = q;
        const Job jb = P.jobs[ji];
        const int r = it - jb.item0, nblk = jb.nrows / 32, kb = r / nblk, nb = r % nblk, k0 = 64 * kb, n0 = 32 * nb, c0 = map_col(jb.map, jb.hh, n0);
#pragma unroll 8
        for (int i = 0; i < 32; ++i) { const int kk = 2 * i + (lane >> 5); scr[kk * 33 + (lane & 31)] = jb.src[(size_t)(k0 + kk) * jb.ld + c0 + (lane & 31)]; }
        asm volatile("s_waitcnt lgkmcnt(0)" ::: "memory");
        const int c = lane & 7;
#pragma unroll
        for (int j = 0; j < 4; ++j) { const int n = (lane >> 3) + 8 * j; const LAS float* s = scr + (8 * c) * 33 + n;
            u32x4 o; o.x = cvt_pk_bf16(s[0 * 33], s[1 * 33]); o.y = cvt_pk_bf16(s[2 * 33], s[3 * 33]); o.z = cvt_pk_bf16(s[4 * 33], s[5 * 33]); o.w = cvt_pk_bf16(s[6 * 33], s[7 * 33]);
            *(u32x4*)(jb.dst + (size_t)(n0 + n) * jb.K + k0 + 8 * c) = o; }
        asm volatile("s_waitcnt lgkmcnt(0)" ::: "memory");
    }
}
__device__ __forceinline__ void rmsnorm_phase(const float* x, const float* g, bf16_t* hn) {
    const int tid__ = otid(); const int lane = tid__ & 63, wave = tid__ >> 6;
    const int gw = blockIdx.x * 8 + wave, ngw = gridDim.x * 8;
    f32x4 gv[4];
#pragma unroll
    for (int j = 0; j < 4; ++j) gv[j] = *((const f32x4*)g + lane + 64 * j);
    f32x4 v[4];
    if (gw < T) {
#pragma unroll
        for (int j = 0; j < 4; ++j) v[j] = ((const f32x4*)(x + (size_t)gw * D) + lane)[64 * j]; }
    for (int m = gw; m < T; m += ngw) {
        f32x4 vn[4];
        const int mn = (m + ngw < T) ? m + ngw : m;
#pragma unroll
        for (int j = 0; j < 4; ++j) vn[j] = ((const f32x4*)(x + (size_t)mn * D) + lane)[64 * j];
        float s = 0.f;
#pragma unroll
        for (int j = 0; j < 4; ++j) s += (v[j][0] * v[j][0] + v[j][1] * v[j][1]) + (v[j][2] * v[j][2] + v[j][3] * v[j][3]);
        const float rstd = rsqrtf(wave_sum(s) * (1.0f / D) + 1e-6f);
        u32x2* o = (u32x2*)(hn + (size_t)m * D) + lane;
#pragma unroll
        for (int j = 0; j < 4; ++j) { const f32x4 y = v[j] * rstd * gv[j]; u32x2 w; w.x = cvt_pk_bf16(y[0], y[1]); w.y = cvt_pk_bf16(y[2], y[3]); o[64 * j] = w; }
#pragma unroll
        for (int j = 0; j < 4; ++j) v[j] = vn[j];
    }
}
__device__ __forceinline__ void ld8(const bf16_t* p, float (&v)[8]) {
    const u32x4 w = *(const u32x4*)p;
#pragma unroll
    for (int i = 0; i < 4; ++i) { v[2 * i] = bflo(w[i]); v[2 * i + 1] = bfhi(w[i]); }
}
__device__ __forceinline__ void st8(bf16_t* p, const float (&v)[8]) {
    u32x4 w; w.x = cvt_pk_bf16(v[0], v[1]); w.y = cvt_pk_bf16(v[2], v[3]); w.z = cvt_pk_bf16(v[4], v[5]); w.w = cvt_pk_bf16(v[6], v[7]);
    *(u32x4*)p = w;
}
__device__ __forceinline__ void pool_phase(const bf16_t* hn, bf16_t* dd) {
    for (int gid = blockIdx.x * NTHREADS + otid(); gid < (T / 32) * 128; gid += gridDim.x * NTHREADS) {
        const int col8 = gid & 127, chunk = gid >> 7, w = 2 << (col8 >> 5), t0 = chunk * 32, pos0 = t0 & (SEQ - 1);
        const bf16_t* hp = hn + (size_t)t0 * D + col8 * 8; bf16_t* dp = dd + (size_t)t0 * D + col8 * 8;
        float s[8];
#pragma unroll
        for (int i = 0; i < 8; ++i) s[i] = 0.f;
        if (pos0) for (int k = 1; k <= w; ++k) { float v[8]; ld8(hp - (size_t)k * D, v);
#pragma unroll
            for (int i = 0; i < 8; ++i) s[i] += v[i]; }
        for (int i = 0; i < 32; ++i) {
            float cur[8]; ld8(hp + (size_t)i * D, cur); const int pos = pos0 + i;
#pragma unroll
            for (int q = 0; q < 8; ++q) s[q] += cur[q];
            if (pos >= w) { float v[8]; ld8(hp + (size_t)(i - w) * D, v);
#pragma unroll
                for (int q = 0; q < 8; ++q) s[q] -= v[q]; }
            const float inv = 1.0f / (float)(pos + 1 < w ? pos + 1 : w);
            float o[8];
#pragma unroll
            for (int q = 0; q < 8; ++q) o[q] = s[q] * inv - cur[q];
            st8(dp + (size_t)i * D, o);
        }
    }
}
__device__ __forceinline__ void lru_fix_panel(const float* rawl, const float* cw, const float* cb, bf16_t* REC, int pm) {
    if ((pm & 7) == 0) return;
    const int tid = otid();
    float x[6][4], w[6][4], bb[6];
#pragma unroll
    for (int k = 0; k < 6; ++k) {
        const int idx = tid + k * NTHREADS, c = idx & 1023, rr = idx >> 10, pnl = c >> 8, cl = c & 255;
        const float* cur = rawl + (size_t)(pm * 4 + pnl) * 6 * 256 + cl; const float* prv = rawl + (size_t)((pm - 1) * 4 + pnl) * 6 * 256 + cl;
#pragma unroll
        for (int d = 0; d < 4; ++d) { const int q = rr - d; x[k][d] = q >= 0 ? cur[q * 256] : prv[(6 + q) * 256]; w[k][d] = cw[(3 - d) * D + c]; }
        bb[k] = cb[c];
    }
#pragma unroll
    for (int k = 0; k < 6; ++k) {
        const int idx = tid + k * NTHREADS, c = idx & 1023, rr = idx >> 10;
        const float o = bb[k] + w[k][0] * x[k][0] + w[k][1] * x[k][1] + w[k][2] * x[k][2] + w[k][3] * x[k][3];
        REC[(size_t)(pm * 256 + rr) * D + c] = (bf16_t)(cvt_pk_bf16(o, 0.f) & 0xffffu);
    }
}
__device__ __forceinline__ void lruscan_phase(const bf16_t* LA, const bf16_t* BV, bf16_t* GG, LAS unsigned char* lds) {
    LAS float* sA = (LAS float*)lds; LAS float* sB = sA + 64 * 64;
    const int tid__ = otid(); const int c8 = tid__ & 7, tc = tid__ >> 3;
    for (int unit = blockIdx.x; unit < 256; unit += gridDim.x) {
        const int b = unit >> 4, cgp = unit & 15;
        const size_t base = ((size_t)b * SEQ + tc * 32) * D + cgp * 64 + c8 * 8;
        float sl[8], Bv[8], h[8];
#pragma unroll
        for (int q = 0; q < 8; ++q) { sl[q] = 0.f; Bv[q] = 0.f; h[q] = 0.f; }
#pragma unroll 4
        for (int i = 0; i < 32; ++i) { float la[8], bb[8]; ld8(LA + base + (size_t)i * D, la); ld8(BV + base + (size_t)i * D, bb);
#pragma unroll
            for (int q = 0; q < 8; ++q) { Bv[q] = __expf(la[q]) * Bv[q] + bb[q]; sl[q] += la[q]; } }
#pragma unroll
        for (int q = 0; q < 8; ++q) { sA[tc * 64 + c8 * 8 + q] = __expf(sl[q]); sB[tc * 64 + c8 * 8 + q] = Bv[q]; }
        __syncthreads();
        for (int j = 0; j < tc; ++j) {
            const f32x4 a0 = *(const LAS f32x4*)(sA + j * 64 + c8 * 8), a1 = *(const LAS f32x4*)(sA + j * 64 + c8 * 8 + 4), b0 = *(const LAS f32x4*)(sB + j * 64 + c8 * 8), b1 = *(const LAS f32x4*)(sB + j * 64 + c8 * 8 + 4);
#pragma unroll
            for (int q = 0; q < 4; ++q) { h[q] = a0[q] * h[q] + b0[q]; h[4 + q] = a1[q] * h[4 + q] + b1[q]; } }
#pragma unroll 4
        for (int i = 0; i < 32; ++i) { float la[8], bb[8], gg[8], y[8]; ld8(LA + base + (size_t)i * D, la); ld8(BV + base + (size_t)i * D, bb); ld8(GG + base + (size_t)i * D, gg);
#pragma unroll
            for (int q = 0; q < 8; ++q) { h[q] = __expf(la[q]) * h[q] + bb[q]; y[q] = gg[q] * h[q]; }
            st8(GG + base + (size_t)i * D, y); }
        __syncthreads();
    }
}
__device__ __forceinline__ void ffn_fix_panel(const float* raw, const float* cw, const float* cb, bf16_t* Aout, int pm) {
    if ((pm & 7) == 0) return;
    const int tid = otid();
    float x0[11][2], x1[11][2], x2[11][2], w0[11][2], w1[11][2], w2[11][2], bb[11][2];
#pragma unroll
    for (int k = 0; k < 11; ++k) {
        const int idx = tid + k * NTHREADS, hc = idx % FH, rr = idx / FH, pn = hc >> 7, cl = hc & 127;
        const float* cur = raw + (size_t)(pm * 22 + pn) * 1024; const float* prv = raw + (size_t)((pm - 1) * 22 + pn) * 1024;
#pragma unroll
        for (int part = 0; part < 2; ++part) { const int off = part * 128 + cl, col = part * FH + hc;
            x0[k][part] = cur[rr * 256 + off]; x1[k][part] = rr ? cur[off] : prv[3 * 256 + off]; x2[k][part] = rr ? prv[3 * 256 + off] : prv[2 * 256 + off];
            bb[k][part] = cb[col]; w2[k][part] = cw[2 * F2 + col]; w1[k][part] = cw[F2 + col]; w0[k][part] = cw[col]; }
    }
#pragma unroll
    for (int k = 0; k < 11; ++k) {
        const int idx = tid + k * NTHREADS, hc = idx % FH, rr = idx / FH;
        const float hv = bb[k][0] + w2[k][0] * x0[k][0] + w1[k][0] * x1[k][0] + w0[k][0] * x2[k][0];
        const float hg = bb[k][1] + w2[k][1] * x0[k][1] + w1[k][1] * x1[k][1] + w0[k][1] * x2[k][1];
        const float o = hg * sigmoidf_(hg) * hv;
        Aout[(size_t)(pm * 256 + rr) * FH + hc] = (bf16_t)(cvt_pk_bf16(o, 0.f) & 0xffffu);
    }
}

__device__ __forceinline__ void s5_phase(const Params& P, const bf16_t* hn, bf16_t* ys, LAS unsigned char* lds) {
    const int tid__ = otid(); const int lane = tid__ & 63, wave = tid__ >> 6;
    if (wave >= 4) { weights_phase(P, (LAS float*)(lds + 65536 + (wave - 4) * 8448), lane, P.nitems_a, P.nitems, blockIdx.x * 4 + (wave - 4), gridDim.x * 4); return; }
    LAS unsigned* S = (LAS unsigned*)(lds + wave * 8704);
    const float* lam_re = P.in[6]; const float* lam_im = P.in[7]; const float* log_dt = P.in[8]; const float* b_re = P.in[9]; const float* b_im = P.in[10];
    const float* c_re = P.in[11]; const float* c_im = P.in[12]; const float* dsk = P.in[13];
    const int c32 = lane & 31, hf = lane >> 5, c16 = lane & 15, q4 = lane >> 4;
    for (int unit = blockIdx.x * 4 + wave; unit < 1024; unit += gridDim.x * 4) {
        const int b = unit >> 6, g = unit & 63;
        const float dt = expf(log_dt[g]);
        float ar, ai;
        { const float lr = fminf(lam_re[g * 64 + lane], -1e-4f), li = lam_im[g * 64 + lane]; const float er = expf(lr * dt); ar = er * cosf(li * dt); ai = er * sinf(li * dt); }
        bf16x8 Bre[2], Bim[2];
#pragma unroll
        for (int pb = 0; pb < 2; ++pb) {
            const int pp = pb * 32 + c32;
            const float lr = fminf(lam_re[g * 64 + pp], -1e-4f), li = lam_im[g * 64 + pp]; const float er = expf(lr * dt);
            const float nr = er * cosf(li * dt) - 1.0f, ni = er * sinf(li * dt), dd = lr * lr + li * li;
            const float cr = (nr * lr + ni * li) / dd, ci = (ni * lr - nr * li) / dd;
            const float* br = b_re + (size_t)(g * 64 + pp) * 16 + 8 * hf; const float* bi = b_im + (size_t)(g * 64 + pp) * 16 + 8 * hf;
            unsigned wr_[4], wi_[4];
#pragma unroll
            for (int i = 0; i < 4; ++i) { const float r0 = br[2 * i], i0 = bi[2 * i], r1 = br[2 * i + 1], i1 = bi[2 * i + 1];
                wr_[i] = cvt_pk_bf16(cr * r0 - ci * i0, cr * r1 - ci * i1); wi_[i] = cvt_pk_bf16(cr * i0 + ci * r0, cr * i1 + ci * r1); }
            Bre[pb] = __builtin_bit_cast(bf16x8, (u32x4){wr_[0], wr_[1], wr_[2], wr_[3]}); Bim[pb] = __builtin_bit_cast(bf16x8, (u32x4){wi_[0], wi_[1], wi_[2], wi_[3]});
        }
        bf16x8 Cf[4];
#pragma unroll
        for (int kb = 0; kb < 4; ++kb) { const int p0 = kb * 16 + 4 * q4; const float* cr = c_re + (size_t)(g * 16 + c16) * 64 + p0; const float* ci = c_im + (size_t)(g * 16 + c16) * 64 + p0;
            Cf[kb] = __builtin_bit_cast(bf16x8, (u32x4){cvt_pk_bf16(cr[0], -ci[0]), cvt_pk_bf16(cr[1], -ci[1]), cvt_pk_bf16(cr[2], -ci[2]), cvt_pk_bf16(cr[3], -ci[3])}); }
        float dk[4];
#pragma unroll
        for (int r = 0; r < 4; ++r) dk[r] = dsk[g * 16 + 4 * q4 + r];
        float sr = 0.f, si = 0.f;
        const bf16_t* hb = hn + (size_t)b * SEQ * D + g * 16; bf16_t* yb = ys + (size_t)b * SEQ * D + g * 16;
        bf16x8 ufn = *(const bf16x8*)(hb + (size_t)c32 * D + 8 * hf);
        u32x2 uwn[2];
#pragma unroll
        for (int tb = 0; tb < 2; ++tb) uwn[tb] = *(const u32x2*)(hb + (size_t)(tb * 16 + c16) * D + 4 * q4);
        for (int c = 0; c < SEQ / 32; ++c) {
            const int t0 = c * 32;
            const bf16x8 uf = ufn; const u32x2 uwc[2] = {uwn[0], uwn[1]};
            { const int tn = (c + 1 < SEQ / 32) ? t0 + 32 : t0;
              ufn = *(const bf16x8*)(hb + (size_t)(tn + c32) * D + 8 * hf);
#pragma unroll
              for (int tb = 0; tb < 2; ++tb) uwn[tb] = *(const u32x2*)(hb + (size_t)(tn + tb * 16 + c16) * D + 4 * q4); }
            const f32x16 z16 = {0.f, 0.f, 0.f, 0.f, 0.f, 0.f, 0.f, 0.f, 0.f, 0.f, 0.f, 0.f, 0.f, 0.f, 0.f, 0.f};
            f32x16 r0 = __builtin_amdgcn_mfma_f32_32x32x16_bf16(uf, Bre[0], z16, 0, 0, 0), r1 = __builtin_amdgcn_mfma_f32_32x32x16_bf16(uf, Bre[1], z16, 0, 0, 0);
            f32x16 i0 = __builtin_amdgcn_mfma_f32_32x32x16_bf16(uf, Bim[0], z16, 0, 0, 0), i1 = __builtin_amdgcn_mfma_f32_32x32x16_bf16(uf, Bim[1], z16, 0, 0, 0);
#pragma unroll
            for (int q = 0; q < 4; ++q) {
                float xr[8], xi[8];
#pragma unroll
                for (int i = 0; i < 4; ++i) {
                    auto pr = __builtin_amdgcn_permlane32_swap(__float_as_uint(r0[4 * q + i]), __float_as_uint(r1[4 * q + i]), false, false);
                    auto pi = __builtin_amdgcn_permlane32_swap(__float_as_uint(i0[4 * q + i]), __float_as_uint(i1[4 * q + i]), false, false);
                    xr[i] = __uint_as_float(pr[0]); xr[4 + i] = __uint_as_float(pr[1]); xi[i] = __uint_as_float(pi[0]); xi[4 + i] = __uint_as_float(pi[1]); }
#pragma unroll
                for (int i = 0; i < 8; ++i) { const float nr = ar * sr - ai * si + xr[i], ni = ar * si + ai * sr + xi[i]; sr = nr; si = ni;
                    S[(8 * q + i) * 68 + lane] = cvt_pk_bf16(sr, si); }
            }
            asm volatile("" ::: "memory");
#pragma unroll
            for (int tb = 0; tb < 2; ++tb) {
                f32x4 y = (f32x4){0.f, 0.f, 0.f, 0.f};
#pragma unroll
                for (int kb = 0; kb < 4; ++kb) { const bf16x8 sf = __builtin_bit_cast(bf16x8, *(const LAS u32x4*)(S + (tb * 16 + c16) * 68 + kb * 16 + 4 * q4));
                    y = __builtin_amdgcn_mfma_f32_16x16x32_bf16(Cf[kb], sf, y, 0, 0, 0); }
                const size_t off = (size_t)(t0 + tb * 16 + c16) * D + 4 * q4;
                const u32x2 uw = uwc[tb];
                const float u0 = bflo(uw.x), u1 = bfhi(uw.x), u2 = bflo(uw.y), u3 = bfhi(uw.y);
                u32x2 w; w.x = cvt_pk_bf16(gelu_tanh(y[0] + dk[0] * u0), gelu_tanh(y[1] + dk[1] * u1)); w.y = cvt_pk_bf16(gelu_tanh(y[2] + dk[2] * u2), gelu_tanh(y[3] + dk[3] * u3));
                *(u32x2*)(yb + off) = w;
            }
        }
    }
}

__device__ __forceinline__ void attn_phase(const bf16_t* Q, const bf16_t* Kb, const bf16_t* V, bf16_t* VT, bf16_t* KF, bf16_t* O, LAS unsigned char* lds, unsigned* ctr) {
    const int tid__ = otid(); const int lane = tid__ & 63, wave = tid__ >> 6, c32 = lane & 31, hf = lane >> 5;
    for (int bh = blockIdx.x; bh < 256; bh += gridDim.x) {
        const int b = bh >> 4, h = bh & 15;
        bf16_t* vtw = VT + (size_t)(b * 16 + h) * 64 * SEQ;
        __syncthreads();
        if (tid__ == 0) *ctr = 0u;
        bf16_t* kfw = KF + (size_t)(b * 16 + h) * 64 * SEQ;
        {
            LAS bf16_t* scr = (LAS bf16_t*)(lds + wave * 8704);
            for (int st = wave * 4; st < wave * 4 + 4; ++st) {
                const int s0 = st * 64;
#pragma unroll
                for (int j = 0; j < 8; ++j) { const int i = (lane >> 3) + 8 * j, c = lane & 7;
                    const u32x4 w = *(const u32x4*)(V + (size_t)(b * SEQ + s0 + i) * D + h * 64 + 8 * c);
                    *(LAS u32x2*)(scr + i * 68 + 8 * c) = (u32x2){w.x, w.y}; *(LAS u32x2*)(scr + i * 68 + 8 * c + 4) = (u32x2){w.z, w.w}; }
                asm volatile("s_waitcnt lgkmcnt(0)" ::: "memory");
#pragma unroll
                for (int blk = 0; blk < 8; ++blk) { const int t32 = blk >> 2, db = (blk >> 1) & 1, ks = blk & 1;
                    unsigned short e[8];
#pragma unroll
                    for (int k = 0; k < 8; ++k) e[k] = scr[(32 * t32 + 16 * ks + 8 * (k >> 2) + 4 * hf + (k & 3)) * 68 + db * 32 + c32];
                    u32x4 w; w.x = e[0] | ((unsigned)e[1] << 16); w.y = e[2] | ((unsigned)e[3] << 16); w.z = e[4] | ((unsigned)e[5] << 16); w.w = e[6] | ((unsigned)e[7] << 16);
                    *(u32x4*)(vtw + (size_t)((((st * 2 + t32) * 2 + db) * 2 + ks) * 64 + lane) * 8) = w; }
                asm volatile("s_waitcnt lgkmcnt(0)" ::: "memory");
            }
            for (int kt = wave * 8; kt < wave * 8 + 8; ++kt) {
#pragma unroll
                for (int kd = 0; kd < 4; ++kd) { const u32x4 w = *(const u32x4*)(Kb + (size_t)(b * SEQ + kt * 32 + c32) * D + h * 64 + 16 * kd + 8 * hf);
                    *(u32x4*)(kfw + (size_t)((kt * 4 + kd) * 64 + lane) * 8) = w; } }
            asm volatile("s_waitcnt vmcnt(0)" ::: "memory"); __syncthreads();
        }
        const bf16_t* vtb = vtw;
        for (;;) {
            unsigned uq = 0u;
            if (lane == 0) uq = atomicAdd(ctr, 1u);
            uq = (unsigned)__builtin_amdgcn_readfirstlane((int)uq);
            if (uq >= 64u) break;
            const int qb = 63 - (int)uq, t0 = qb * 32;
            const bf16_t* qp = Q + (size_t)(b * SEQ + t0 + c32) * D + h * 64 + 8 * hf;
            bf16x8 qf[4];
#pragma unroll
            for (int kd = 0; kd < 4; ++kd) qf[kd] = *(const bf16x8*)(qp + 16 * kd);
            f32x16 o0 = {0.f, 0.f, 0.f, 0.f, 0.f, 0.f, 0.f, 0.f, 0.f, 0.f, 0.f, 0.f, 0.f, 0.f, 0.f, 0.f}, o1 = o0;
            float Pc = 1.0f;
            bf16x8 kfn[4];
#pragma unroll
            for (int kd = 0; kd < 4; ++kd) kfn[kd] = *(const bf16x8*)(kfw + (size_t)((qb * 4 + kd) * 64 + lane) * 8);
            for (int kt = qb; kt >= 0; --kt) {
                f32x16 z = {0.f, 0.f, 0.f, 0.f, 0.f, 0.f, 0.f, 0.f, 0.f, 0.f, 0.f, 0.f, 0.f, 0.f, 0.f, 0.f};
#pragma unroll
                for (int kd = 0; kd < 4; ++kd) z = __builtin_amdgcn_mfma_f32_32x32x16_bf16(kfn[kd], qf[kd], z, 0, 0, 0);
                { const int ktn = kt > 0 ? kt - 1 : kt;
#pragma unroll
                  for (int kd = 0; kd < 4; ++kd) kfn[kd] = *(const bf16x8*)(kfw + (size_t)((ktn * 4 + kd) * 64 + lane) * 8); }
                bf16x8 vf[2][2];
#pragma unroll
                for (int db = 0; db < 2; ++db)
#pragma unroll
                    for (int ks = 0; ks < 2; ++ks) vf[db][ks] = *(const bf16x8*)(vtb + (size_t)((((kt * 2 + db) * 2 + ks) * 64) + lane) * 8);
                float be[16], om[16];
#pragma unroll
                for (int r = 0; r < 16; ++r) { const float e = __builtin_amdgcn_exp2f(-fmaxf(z[r], -80.0f)); be[r] = __builtin_amdgcn_rcpf(1.0f + e); om[r] = e * be[r]; }
                if (kt == qb) {
#pragma unroll
                    for (int r = 0; r < 16; ++r) { const int sl = 8 * (r >> 2) + 4 * hf + (r & 3); const bool valid = sl < c32; be[r] = valid ? be[r] : 0.f; om[r] = valid ? om[r] : 1.0f; } }
                float bp[4], pbp[4];
#pragma unroll
                for (int q = 0; q < 4; ++q) { bp[q] = (om[4 * q] * om[4 * q + 1]) * (om[4 * q + 2] * om[4 * q + 3]); pbp[q] = __shfl_xor(bp[q], 32); }
                float after = Pc; float att[16];
#pragma unroll
                for (int q = 3; q >= 0; --q) {
                    const float off = hf == 0 ? after * pbp[q] : after;
                    const float e3 = off, e2 = e3 * om[4 * q + 3], e1 = e2 * om[4 * q + 2], e0 = e1 * om[4 * q + 1];
                    att[4 * q + 3] = be[4 * q + 3] * e3; att[4 * q + 2] = be[4 * q + 2] * e2; att[4 * q + 1] = be[4 * q + 1] * e1; att[4 * q] = be[4 * q] * e0;
                    after *= bp[q] * pbp[q];
                }
                Pc = after;
#pragma unroll
                for (int ks = 0; ks < 2; ++ks) {
                    const bf16x8 pf = __builtin_bit_cast(bf16x8, (u32x4){cvt_pk_bf16(att[8 * ks], att[8 * ks + 1]), cvt_pk_bf16(att[8 * ks + 2], att[8 * ks + 3]), cvt_pk_bf16(att[8 * ks + 4], att[8 * ks + 5]), cvt_pk_bf16(att[8 * ks + 6], att[8 * ks + 7])});
                    o0 = __builtin_amdgcn_mfma_f32_32x32x16_bf16(vf[0][ks], pf, o0, 0, 0, 0); o1 = __builtin_amdgcn_mfma_f32_32x32x16_bf16(vf[1][ks], pf, o1, 0, 0, 0); }
                if (__all(Pc == 0.0f)) break;
            }
            bf16_t* op = O + (size_t)(b * SEQ + t0 + c32) * D + h * 64 + 4 * hf;
#pragma unroll
            for (int q = 0; q < 4; ++q) {
                u32x2 w0; w0.x = cvt_pk_bf16(o0[4 * q], o0[4 * q + 1]); w0.y = cvt_pk_bf16(o0[4 * q + 2], o0[4 * q + 3]); *(u32x2*)(op + 8 * q) = w0;
                u32x2 w1; w1.x = cvt_pk_bf16(o1[4 * q], o1[4 * q + 1]); w1.y = cvt_pk_bf16(o1[4 * q + 2], o1[4 * q + 3]); *(u32x2*)(op + 32 + 8 * q) = w1; }
        }
    }
}

__global__ void __launch_bounds__(NTHREADS, 2) fwd_megakernel(Params P) {
    extern __shared__ __attribute__((aligned(16))) unsigned char lds_raw[];
    LAS unsigned char* lds = (LAS unsigned char*)lds_raw;
    cg::grid_group grid = cg::this_grid();
    unsigned char* ws = P.ws;
    bf16_t* HN = (bf16_t*)(ws + WS_HN);
    bf16_t* B0 = (bf16_t*)(ws + WS_BIG); bf16_t* B1 = (bf16_t*)(ws + WS_BIG + ACT); bf16_t* B2 = (bf16_t*)(ws + WS_BIG + 2 * ACT); bf16_t* B3 = (bf16_t*)(ws + WS_BIG + 3 * ACT); bf16_t* B4 = (bf16_t*)(ws + WS_BIG + 4 * ACT);
    float* RAW = (float*)(ws + WS_RAW);
    float* X = P.out;
    const int G = gridDim.x, bx = blockIdx.x;
    pg8::StaticOrder S;
    volatile LAS unsigned* MISC = (volatile LAS unsigned*)(lds + MISC_OFF);
    if (threadIdx.x < 2) MISC[threadIdx.x] = 0u;
    __syncthreads();
    const XcdBarrier bar = xcd_barrier_post((unsigned*)ws, MISC);
    grid.sync();
#define SYNC() xcd_barrier(bar)

    { const int tid__ = otid(); const int lane = tid__ & 63, wave = tid__ >> 6;
      weights_phase(P, (LAS float*)(lds + wave * 8448), lane, 0, P.nitems_a, blockIdx.x * 8 + wave, gridDim.x * 8); }
    rmsnorm_phase(P.in[0], P.in[1], HN);
    SYNC();
#define FFN_BLOCK(layer, LASTSYNC) do { \
        rmsnorm_phase(X, P.in[2] + (layer) * D, HN); \
        SYNC(); \
        const float* cw = P.in[30] + (size_t)(layer) * 3 * F2; const float* cb = P.in[31] + (size_t)(layer) * F2; \
        { pg8::Gemm g{HN, (const bf16_t*)(ws + WS_WF1) + (size_t)(layer) * F2 * D, T, F2, 1024, D, D, 0, 0}; S.init(T, F2, G, bx); \
          EpiFfn1 E{B0, cw, cb, RAW, (LAS float*)(lds + XCH_OFF)}; pg8::gemm_phase(lds, g, S, E); } \
        SYNC(); \
        { pg8::Gemm g{B0, (const bf16_t*)(ws + WS_WF2) + (size_t)(layer) * D * FH, T, 1024, FH, FH, FH, 0, 0}; S.init(T, 1024, G, bx); \
          { Unit fu; int lastpm = -1; for (int i = 0; S.next(i, fu); ++i) if (fu.pm != lastpm) { ffn_fix_panel(RAW, cw, cb, B0, fu.pm); lastpm = fu.pm; } } \
          asm volatile("s_waitcnt vmcnt(0)" ::: "memory"); __syncthreads(); \
          EpiRes E{X, X, nullptr, nullptr}; pg8::gemm_phase(lds, g, S, E); } \
        if (LASTSYNC) SYNC(); } while (0)

    pool_phase(HN, B0);
    SYNC();
    { pg8::Gemm g{B0, (const bf16_t*)(ws + WS_WPOOL), T, 1024, 256, D, 256, 0, 512}; S.init(T, 1024, G, bx);
      EpiRes E{P.in[0], X, P.in[5], P.in[4]}; pg8::gemm_phase(lds, g, S, E); }
    SYNC();
    FFN_BLOCK(0, true);
    rmsnorm_phase(X, P.in[1] + 1 * D, HN);
    SYNC();
    s5_phase(P, HN, B0, lds);
    SYNC();
    { pg8::Gemm g{B0, (const bf16_t*)(ws + WS_WS5), T, 2048, 1024, D, D, 0, 0}; S.init(T, 2048, G, bx);
      EpiGateRes E{X, P.in[15]}; pg8::gemm_phase(lds, g, S, E); }
    SYNC();
    FFN_BLOCK(1, true);
    rmsnorm_phase(X, P.in[1] + 2 * D, HN);
    SYNC();
    { pg8::Gemm g{HN, (const bf16_t*)(ws + WS_WLIN), T, 2048, 1024, D, D, 0, 0}; S.init(T, 2048, G, bx);
      EpiLruIn E{B0, B2, P.in[17], P.in[18], (float*)(ws + WS_RAWL), (LAS float*)(lds + XCH_OFF)}; pg8::gemm_phase(lds, g, S, E); }
    SYNC();
    { pg8::Gemm g{B2, (const bf16_t*)(ws + WS_WGATE), T, 2048, 256, D, 256, 1, 512}; S.init(T, 2048, G, bx);
      { Unit fu; int lastpm = -1; for (int i = 0; S.next(i, fu); ++i) if (fu.pm != lastpm) { lru_fix_panel((const float*)(ws + WS_RAWL), P.in[17], P.in[18], B2, fu.pm); lastpm = fu.pm; } }
      asm volatile("s_waitcnt vmcnt(0)" ::: "memory"); __syncthreads();
      EpiGates E{B2, B3, B4, P.in[20], P.in[22], P.in[23]}; pg8::gemm_phase(lds, g, S, E); }
    SYNC();
    lruscan_phase(B3, B4, B0, lds);
    SYNC();
    { pg8::Gemm g{B0, (const bf16_t*)(ws + WS_WLOUT), T, 1024, 1024, D, D, 0, 0}; S.init(T, 1024, G, bx);
      EpiRes E{X, X, nullptr, nullptr}; pg8::gemm_phase(lds, g, S, E); }
    SYNC();
    FFN_BLOCK(2, true);
    rmsnorm_phase(X, P.in[1] + 3 * D, HN);
    SYNC();
    { pg8::Gemm g{HN, (const bf16_t*)(ws + WS_WQKV), T, 3072, 1024, D, D, 0, 0}; S.init(T, 3072, G, bx);
      EpiQKV E{B0, P.in[26], P.in[27]}; pg8::gemm_phase(lds, g, S, E); }
    SYNC();
    attn_phase(B0, B1, B2, B3, HN, B4, lds, (unsigned*)(lds_raw + MISC_OFF + 20));
    SYNC();
    { pg8::Gemm g{B4, (const bf16_t*)(ws + WS_WWO), T, 1024, 1024, D, D, 0, 0}; S.init(T, 1024, G, bx);
      EpiRes E{X, X, nullptr, nullptr}; pg8::gemm_phase(lds, g, S, E); }
    SYNC();
    FFN_BLOCK(3, false);
}

extern "C" void kernel_launch(void* const* d_in, const int* in_sizes, int n_in, void* d_out, int out_size, void* d_ws, size_t ws_size, hipStream_t stream) {
    static int grid = 0;
    if (grid == 0) {
        if (n_in != 33 || out_size != T * D || ws_size < WS_END) { fprintf(stderr, "kernel_launch: unexpected shapes (n_in %d out %d ws %zu)\n", n_in, out_size, ws_size); grid = -1; return; }
        int dev = 0, cus = 0, per_cu = 0;
        (void)hipGetDevice(&dev); (void)hipDeviceGetAttribute(&cus, hipDeviceAttributeMultiprocessorCount, dev);
        if (hipFuncSetAttribute((const void*)fwd_megakernel, hipFuncAttributeMaxDynamicSharedMemorySize, LDS_BYTES) != hipSuccess) { fprintf(stderr, "kernel_launch: hipFuncSetAttribute failed\n"); grid = -1; return; }
        (void)hipOccupancyMaxActiveBlocksPerMultiprocessor(&per_cu, (const void*)fwd_megakernel, NTHREADS, LDS_BYTES);
        (void)hipGetLastError();
        if (per_cu < 1) per_cu = 1;
        grid = cus * per_cu;
        if (grid > 256) grid = 256;
    }
    if (grid < 0) return;
    Params p; memset(&p, 0, sizeof(p));
    for (int i = 0; i < 33; ++i) p.in[i] = (const float*)d_in[i];
    p.out = (float*)d_out; p.ws = (unsigned char*)d_ws;
    unsigned char* ws = (unsigned char*)d_ws;
    int nj = 0, items = 0;
    auto add = [&](const float* src, bf16_t* dst, int K, int ld, int nrows, int map, int hh) {
        Job& j = p.jobs[nj++]; j.src = src; j.dst = dst; j.K = K; j.ld = ld; j.nrows = nrows; j.map = map; j.hh = hh; j.item0 = items; items += (K / 64) * (nrows / 32); };
    for (int l = 0; l < 2; ++l) add(p.in[29] + (size_t)l * D * F2, (bf16_t*)(ws + WS_WF1) + (size_t)l * F2 * D, 1024, F2, F2, 1, FH);
    for (int l = 0; l < 2; ++l) add(p.in[32] + (size_t)l * FH * D, (bf16_t*)(ws + WS_WF2) + (size_t)l * D * FH, FH, D, D, 0, 0);
    for (int gI = 0; gI < 4; ++gI) add(p.in[3] + (size_t)gI * 65536, (bf16_t*)(ws + WS_WPOOL) + (size_t)gI * 65536, 256, 256, 256, 0, 0);
    add(p.in[14], (bf16_t*)(ws + WS_WS5), 1024, 2048, 2048, 1, 1024);
    p.nitems_a = items;
    for (int l = 2; l < 4; ++l) add(p.in[29] + (size_t)l * D * F2, (bf16_t*)(ws + WS_WF1) + (size_t)l * F2 * D, 1024, F2, F2, 1, FH);
    for (int l = 2; l < 4; ++l) add(p.in[32] + (size_t)l * FH * D, (bf16_t*)(ws + WS_WF2) + (size_t)l * D * FH, FH, D, D, 0, 0);
    add(p.in[16], (bf16_t*)(ws + WS_WLIN), 1024, 2048, 2048, 0, 0);
    for (int pn = 0; pn < 8; ++pn) for (int bj = 0; bj < 2; ++bj)
        add((bj ? p.in[21] : p.in[19]) + (size_t)(pn >> 1) * 65536 + (pn & 1) * 128, (bf16_t*)(ws + WS_WGATE) + (size_t)(pn * 256 + bj * 128) * 256, 256, 256, 128, 0, 0);
    add(p.in[24], (bf16_t*)(ws + WS_WLOUT), 1024, 1024, 1024, 0, 0);
    add(p.in[25], (bf16_t*)(ws + WS_WQKV), 1024, 3072, 3072, 2, 0);
    add(p.in[28], (bf16_t*)(ws + WS_WWO), 1024, 1024, 1024, 0, 0);
    p.nitems = items;
    if (hipMemsetAsync(d_ws, 0, 16384, stream) != hipSuccess) { fprintf(stderr, "kernel_launch: memset failed\n"); return; }
    void* args[] = {&p};
    hipError_t e = hipLaunchCooperativeKernel((const void*)fwd_megakernel, dim3(grid), dim3(NTHREADS), args, LDS_BYTES, stream);
    if (e != hipSuccess) fprintf(stderr, "cooperative launch failed: %s (grid %d)\n", hipGetErrorString(e), grid);
}
```

```cpp
#include <hip/hip_runtime.h>
#include <hip/hip_cooperative_groups.h>
#include <cstdio>
#include <cstring>
namespace cg = cooperative_groups;

#define LAS __attribute__((address_space(3)))
typedef unsigned short bf16_t;
typedef short bf16x8 __attribute__((ext_vector_type(8)));
typedef short bf16x4 __attribute__((ext_vector_type(4)));
typedef float f32x4 __attribute__((ext_vector_type(4)));
typedef float f32x16 __attribute__((ext_vector_type(16)));
typedef unsigned u32x4 __attribute__((ext_vector_type(4)));
typedef unsigned u32x2 __attribute__((ext_vector_type(2)));

constexpr int T = 32768, D = 1024, SEQ = 2048, FH = 2816, F2 = 5632;
constexpr int NTHREADS = 512;
constexpr int LDS_BYTES = 147456;
constexpr int XCH_OFF = 131072, MISC_OFF = 131072 + 12288;
constexpr size_t MiB = 1u << 20;
constexpr size_t WS_WPOOL = 1 * MiB, WS_WS5 = 2 * MiB, WS_WLIN = 6 * MiB, WS_WGATE = 10 * MiB, WS_WLOUT = 11 * MiB,
                 WS_WQKV = 13 * MiB, WS_WWO = 19 * MiB, WS_WF1 = 21 * MiB, WS_WF2 = 65 * MiB,
                 WS_HN = 96 * MiB, WS_BIG = 160 * MiB, WS_RAW = 480 * MiB, WS_RAWL = 492 * MiB, WS_END = 496 * MiB;
constexpr size_t ACT = 64 * MiB;

typedef __bf16 bf16v2_t __attribute__((ext_vector_type(2)));
__device__ __forceinline__ unsigned cvt_pk_bf16(float lo, float hi) { const bf16v2_t v = {(__bf16)lo, (__bf16)hi}; return __builtin_bit_cast(unsigned, v); }
__device__ __forceinline__ float bf2f(unsigned short b) { return __uint_as_float(((unsigned)b) << 16); }
__device__ __forceinline__ float bflo(unsigned w) { return __uint_as_float(w << 16); }
__device__ __forceinline__ float bfhi(unsigned w) { return __uint_as_float(w & 0xffff0000u); }
__device__ __forceinline__ float sigmoidf_(float x) { return __builtin_amdgcn_rcpf(1.0f + __expf(-x)); }
__device__ __forceinline__ float gelu_tanh(float x) { const float k = 1.5957691216f * (x + 0.044715f * x * x * x); return x * __builtin_amdgcn_rcpf(1.0f + __expf(-k)); }
__device__ __forceinline__ float wave_sum(float v) {
#pragma unroll
    for (int o = 1; o < 64; o <<= 1) v += __shfl_xor(v, o);
    return v;
}
__device__ __forceinline__ int otid() { int t = threadIdx.x; asm volatile("" : "+v"(t)); return t; }
template <int CTRL> __device__ __forceinline__ float dpp_upd(float old, float src) {
    return __int_as_float(__builtin_amdgcn_update_dpp(__float_as_int(old), __float_as_int(src), CTRL, 0xf, 0xf, false));
}
template <int CTRL> __device__ __forceinline__ float dpp0(float src) { return __int_as_float(__builtin_amdgcn_update_dpp(0, __float_as_int(src), CTRL, 0xf, 0xf, true)); }
__device__ __forceinline__ float prev1(float prev, float cur) { const float t = dpp_upd<0x121>(0.f, prev); return dpp_upd<0x111>(t, cur); }
__device__ __forceinline__ float prev2(float prev, float cur) { const float t = dpp_upd<0x122>(0.f, prev); return dpp_upd<0x112>(t, cur); }

namespace pg8 {
constexpr int BM = 256, BK = 64, HALF = 128, HTB = HALF * BK * 2, STAGE_BYTES = 8 * HTB, NXCD = 8, WGM = 8;
__host__ __device__ __forceinline__ int lds_byte(int r, int c) { const int st = (r >> 4) * 2 + (c >> 5), rr = r & 15, cc = c & 31, ob = rr * 64 + cc * 2; return st * 1024 + (ob ^ (((ob >> 9) & 1) << 5)); }
__host__ __device__ __forceinline__ void stage_rc(int b, int& R, int& C) { const int st = b / 1024, sb = b % 1024, swz = sb ^ (((sb >> 9) & 1) << 5); R = (st >> 1) * 16 + swz / 64; C = (st & 1) * 32 + (swz % 64) / 2; }
__host__ __device__ __forceinline__ int perm32(int rho) { const int n = rho >> 4, i = rho & 15; return 8 * (i >> 2) + 4 * n + (i & 3); }
struct Unit { int pm, pn; };
struct Gemm { const bf16_t* A; const bf16_t* Bt; int M, N, K, lda, ldb, a_shift, a_step; };
struct StaticOrder {
    int nM, nN, nwg, G, c;
    __device__ __forceinline__ void init(int M, int N, int G_, int c_) { nM = M / BM; nN = N / BM; nwg = nM * nN; G = G_; c = c_; }
    __device__ __forceinline__ bool next(int i, Unit& u) const {
        const long L = (long)i * G + c; if (L >= nwg) return false;
        int wgid = (int)L; { const int q = nwg / NXCD, r = nwg % NXCD, xcd = wgid % NXCD, off = wgid / NXCD; wgid = (xcd < r ? xcd * (q + 1) : r * (q + 1) + (xcd - r) * q) + off; }
        const int nig = WGM * nN, gid = wgid / nig, fm = gid * WGM, gsz = (nM - fm) < WGM ? (nM - fm) : WGM;
        u.pm = fm + ((wgid % nig) % gsz); u.pn = (wgid % nig) / gsz; return true;
    }
};
template <class Epi>
__device__ __forceinline__ void gemm_phase(LAS unsigned char* lds, const Gemm g, const StaticOrder& S, const Epi& E) {
    int tid_ = threadIdx.x; asm volatile("" : "+v"(tid_));
    const int tid = tid_, wid = __builtin_amdgcn_readfirstlane(tid >> 6), lane = tid & 63, wr = wid >> 2, wc = wid & 3, fr = lane & 15, fq = lane >> 4;
    const int K = g.K, nt = K / BK;
    unsigned voffA[2], voffB[2];
#pragma unroll
    for (int i = 0; i < 2; ++i) { int R, C; stage_rc(tid * 16 + i * 8192, R, C); const int Rb = Epi::PERM ? ((R & ~31) + perm32(R & 31)) : R;
        const int Ra = Epi::ROWPERM ? ((R & ~63) + 4 * (R & 15) + ((R >> 4) & 3)) : R;
        voffA[i] = (unsigned)(Ra * g.lda + C) * 2u; voffB[i] = (unsigned)(Rb * g.ldb + C) * 2u; }
    const size_t kstep = (size_t)(BK * 2);
    const size_t hstepA = (size_t)HALF * g.lda * 2, hstepB = (size_t)HALF * g.ldb * 2;
    const size_t tstepA = 2 * hstepA, tstepB = 2 * hstepB;
    const unsigned ldsw = (unsigned)wid * 1024u;
    const int aoff = lds_byte(wr * 64 + fr, fq * 8), boff = lds_byte(wc * 32 + fr, fq * 8);
#define PG8_SA(b, h) (((b) * 2 + (h)) * HTB)
#define PG8_SB(b, h) ((4 + (b) * 2 + (h)) * HTB)
#define PG8_STAGE(bufoff, gbase, voff) do { _Pragma("unroll") for (int _i = 0; _i < 2; ++_i) \
        __builtin_amdgcn_global_load_lds((const unsigned*)((const char*)(gbase) + (voff)[_i]), (LAS unsigned*)(lds + (bufoff) + ldsw + _i * 8192), 16, 0, 0); } while (0)
#define PG8_LDA(dst, b, h) do { _Pragma("unroll") for (int m = 0; m < 4; ++m) _Pragma("unroll") for (int k = 0; k < 2; ++k) dst[m][k] = *(const LAS bf16x8*)(lds + PG8_SA(b, h) + aoff + m * 2048 + k * 1024); } while (0)
#define PG8_LDB(dst, b, h) do { _Pragma("unroll") for (int n = 0; n < 2; ++n) _Pragma("unroll") for (int k = 0; k < 2; ++k) dst[n][k] = *(const LAS bf16x8*)(lds + PG8_SB(b, h) + boff + n * 2048 + k * 1024); } while (0)
#define PG8_MMA(ai, bj, At, Bt) do { __builtin_amdgcn_s_setprio(1); _Pragma("unroll") for (int m = 0; m < 4; ++m) _Pragma("unroll") for (int n = 0; n < 2; ++n) _Pragma("unroll") for (int k = 0; k < 2; ++k) \
        acc[ai][bj][m][n] = __builtin_amdgcn_mfma_f32_16x16x32_bf16(Bt[n][k], At[m][k], acc[ai][bj][m][n], 0, 0, 0); __builtin_amdgcn_s_setprio(0); } while (0)
#define PG8_WAIT_V(n) asm volatile("s_waitcnt vmcnt(" #n ")" ::: "memory")
#define PG8_WAIT_L(n) asm volatile("s_waitcnt lgkmcnt(" #n ")" ::: "memory")
#define PG8_BAR __builtin_amdgcn_s_barrier()
#define PG8_SCHED __builtin_amdgcn_sched_barrier(0)
    Unit cur, nxt; int ui = 0;
    if (!S.next(0, cur)) return;
    f32x4 acc[2][2][4][2];
    {
#pragma unroll
    for (int a = 0; a < 2; ++a)
#pragma unroll
        for (int b = 0; b < 2; ++b)
#pragma unroll
            for (int m = 0; m < 4; ++m)
#pragma unroll
                for (int n = 0; n < 2; ++n) acc[a][b][m][n] = (f32x4){0.f, 0.f, 0.f, 0.f};
    }
    bf16x8 At[4][2], B0[2][2], B1[2][2];
    const char* cA = (const char*)g.A + (size_t)cur.pm * tstepA + (size_t)(cur.pn >> g.a_shift) * g.a_step; const char* cB = (const char*)g.Bt + (size_t)cur.pn * tstepB;
    PG8_STAGE(PG8_SB(0, 0), cB, voffB); PG8_STAGE(PG8_SA(0, 0), cA, voffA); PG8_STAGE(PG8_SB(0, 1), cB + hstepB, voffB); PG8_STAGE(PG8_SA(0, 1), cA + hstepA, voffA);
    if (wr == 1) PG8_BAR;
    PG8_WAIT_V(4); PG8_BAR;
    PG8_STAGE(PG8_SB(1, 0), cB + kstep, voffB); PG8_STAGE(PG8_SA(1, 0), cA + kstep, voffA); PG8_STAGE(PG8_SB(1, 1), cB + hstepB + kstep, voffB);
    PG8_WAIT_V(6); PG8_BAR;
    for (;;) {
        const bool has_next = S.next(ui + 1, nxt);
        const char* nA = has_next ? (const char*)g.A + (size_t)nxt.pm * tstepA + (size_t)(nxt.pn >> g.a_shift) * g.a_step : cA; const char* nB = has_next ? (const char*)g.Bt + (size_t)nxt.pn * tstepB : cB;
        for (int t = 0; t < nt; t += 2) {
            const bool last = (t == nt - 2);
            const char* a1 = cA + (size_t)(t + 1) * kstep;
            const char* a2 = last ? nA : cA + (size_t)(t + 2) * kstep; const char* b2 = last ? nB : cB + (size_t)(t + 2) * kstep;
            const char* a3 = a2 + kstep; const char* b3 = b2 + kstep;
            PG8_LDB(B0, 0, 0); PG8_SCHED; PG8_LDA(At, 0, 0); PG8_STAGE(PG8_SA(1, 1), a1 + hstepA, voffA);
            PG8_WAIT_L(8); PG8_BAR; PG8_WAIT_L(0); PG8_MMA(0, 0, At, B0); PG8_BAR; PG8_SCHED;
            PG8_LDB(B1, 0, 1); PG8_STAGE(PG8_SB(0, 0), b2, voffB);
            PG8_BAR; PG8_WAIT_L(0); PG8_MMA(0, 1, At, B1); PG8_BAR;
            PG8_LDA(At, 0, 1); PG8_STAGE(PG8_SA(0, 0), a2, voffA);
            PG8_BAR; PG8_WAIT_L(0); PG8_MMA(1, 0, At, B0); PG8_BAR; PG8_SCHED;
            PG8_STAGE(PG8_SB(0, 1), b2 + hstepB, voffB);
            PG8_WAIT_V(6); PG8_BAR; PG8_MMA(1, 1, At, B1); PG8_BAR;
            PG8_LDB(B0, 1, 0); PG8_SCHED; PG8_LDA(At, 1, 0); PG8_STAGE(PG8_SA(0, 1), a2 + hstepA, voffA);
            PG8_WAIT_L(8); PG8_BAR; PG8_WAIT_L(0); PG8_MMA(0, 0, At, B0); PG8_BAR; PG8_SCHED;
            PG8_LDB(B1, 1, 1); PG8_STAGE(PG8_SB(1, 0), b3, voffB);
            PG8_BAR; PG8_WAIT_L(0); PG8_MMA(0, 1, At, B1); PG8_BAR;
            PG8_LDA(At, 1, 1); PG8_STAGE(PG8_SA(1, 0), a3, voffA);
            PG8_BAR; PG8_WAIT_L(0); PG8_MMA(1, 0, At, B0); PG8_BAR; PG8_SCHED;
            PG8_STAGE(PG8_SB(1, 1), b3 + hstepB, voffB);
            PG8_WAIT_V(6); PG8_BAR; PG8_MMA(1, 1, At, B1); PG8_BAR;
        }
        E(acc, cur, wr, wc, fr, fq);
        if (!has_next) break;
        {
#pragma unroll
        for (int a = 0; a < 2; ++a)
#pragma unroll
            for (int b = 0; b < 2; ++b)
#pragma unroll
                for (int m = 0; m < 4; ++m)
#pragma unroll
                    for (int n = 0; n < 2; ++n) acc[a][b][m][n] = (f32x4){0.f, 0.f, 0.f, 0.f};
        }
        cur = nxt; cA = nA; cB = nB; ++ui;
    }
    PG8_WAIT_V(0);
    if (wr == 0) PG8_BAR;
    PG8_BAR;
#undef PG8_SA
#undef PG8_SB
#undef PG8_STAGE
#undef PG8_LDA
#undef PG8_LDB
#undef PG8_MMA
#undef PG8_WAIT_V
#undef PG8_WAIT_L
#undef PG8_BAR
#undef PG8_SCHED
}
}
using pg8::Unit;
typedef const f32x4 (&AccRef)[2][2][4][2];

struct EpiRes {
    static constexpr bool PERM = false, ROWPERM = false;
    const float* base; float* out; const float* scale; const float* bias;
    __device__ __forceinline__ void operator()(AccRef acc, const Unit& u, int wr, int wc, int fr, int fq) const {
        const int row0 = u.pm * 256 + wr * 64 + fr, col0 = u.pn * 256 + wc * 32 + 4 * fq;
        f32x4 sv[2][2], bv[2][2];
#pragma unroll
        for (int bj = 0; bj < 2; ++bj)
#pragma unroll
            for (int n = 0; n < 2; ++n) {
                sv[bj][n] = scale ? *(const f32x4*)(scale + col0 + bj * 128 + n * 16) : (f32x4){1.f, 1.f, 1.f, 1.f};
                bv[bj][n] = bias ? *(const f32x4*)(bias + col0 + bj * 128 + n * 16) : (f32x4){0.f, 0.f, 0.f, 0.f}; }
#pragma unroll
        for (int ai = 0; ai < 2; ++ai)
#pragma unroll
            for (int mh = 0; mh < 2; ++mh) {
                f32x4 bs[2][2][2];
#pragma unroll
                for (int m = 0; m < 2; ++m)
#pragma unroll
                    for (int bj = 0; bj < 2; ++bj)
#pragma unroll
                        for (int n = 0; n < 2; ++n) bs[m][bj][n] = *(const f32x4*)(base + (size_t)(row0 + ai * 128 + (2 * mh + m) * 16) * D + col0 + bj * 128 + n * 16);
#pragma unroll
                for (int m = 0; m < 2; ++m)
#pragma unroll
                    for (int bj = 0; bj < 2; ++bj)
#pragma unroll
                        for (int n = 0; n < 2; ++n) *(f32x4*)(out + (size_t)(row0 + ai * 128 + (2 * mh + m) * 16) * D + col0 + bj * 128 + n * 16) = bs[m][bj][n] + sv[bj][n] * (acc[ai][bj][2 * mh + m][n] + bv[bj][n]);
                asm volatile("" ::: "memory"); }
    }
};
struct EpiGateRes {
    static constexpr bool PERM = true, ROWPERM = false;
    float* x; const float* bias;
    __device__ __forceinline__ void operator()(AccRef acc, const Unit& u, int wr, int wc, int fr, int fq) const {
        const int row0 = u.pm * 256 + wr * 64 + fr, col0 = u.pn * 128 + wc * 32 + 8 * fq;
        f32x4 bv[2], bg[2];
#pragma unroll
        for (int n = 0; n < 2; ++n) { bv[n] = *(const f32x4*)(bias + col0 + 4 * n); bg[n] = *(const f32x4*)(bias + D + col0 + 4 * n); }
#pragma unroll
        for (int ai = 0; ai < 2; ++ai) {
            f32x4 xs[4][2];
#pragma unroll
            for (int m = 0; m < 4; ++m)
#pragma unroll
                for (int n = 0; n < 2; ++n) xs[m][n] = *(const f32x4*)(x + (size_t)(row0 + ai * 128 + m * 16) * D + col0 + 4 * n);
#pragma unroll
            for (int m = 0; m < 4; ++m)
#pragma unroll
                for (int n = 0; n < 2; ++n) { f32x4 xv = xs[m][n]; const f32x4 v = acc[ai][0][m][n] + bv[n], gt = acc[ai][1][m][n] + bg[n];
#pragma unroll
                    for (int j = 0; j < 4; ++j) xv[j] += v[j] * sigmoidf_(gt[j]);
                    *(f32x4*)(x + (size_t)(row0 + ai * 128 + m * 16) * D + col0 + 4 * n) = xv; }
            asm volatile("" ::: "memory"); }
    }
};
struct EpiLruIn {
    static constexpr bool PERM = true, ROWPERM = true;
    bf16_t* GG; bf16_t* REC; const float* cw; const float* cb; float* rawl; LAS float* xch;
    __device__ __forceinline__ void operator()(AccRef acc, const Unit& u, int wr, int wc, int fr, int fq) const {
        const int row0 = u.pm * 256 + wr * 64 + 4 * fr, clb = wc * 32 + 8 * fq, col0 = (u.pn & 3) * 256 + clb;
        if (u.pn < 4) {
#pragma unroll
            for (int ai = 0; ai < 2; ++ai)
#pragma unroll
                for (int m = 0; m < 4; ++m) { bf16_t* rp = GG + (size_t)(row0 + ai * 128 + m) * D + col0;
#pragma unroll
                    for (int bj = 0; bj < 2; ++bj) { f32x4 v0 = acc[ai][bj][m][0], v1 = acc[ai][bj][m][1];
#pragma unroll
                        for (int j = 0; j < 4; ++j) { v0[j] = gelu_tanh(v0[j]); v1[j] = gelu_tanh(v1[j]); }
                        u32x4 w; w.x = cvt_pk_bf16(v0[0], v0[1]); w.y = cvt_pk_bf16(v0[2], v0[3]); w.z = cvt_pk_bf16(v1[0], v1[1]); w.w = cvt_pk_bf16(v1[2], v1[3]);
                        *(u32x4*)(rp + bj * 128) = w; } }
            return;
        }
        if (fr == 15) {
#pragma unroll
            for (int ai = 0; ai < 2; ++ai)
#pragma unroll
                for (int bj = 0; bj < 2; ++bj)
#pragma unroll
                    for (int n = 0; n < 2; ++n)
#pragma unroll
                        for (int q = 0; q < 3; ++q) *(LAS f32x4*)(xch + ((ai * 2 + wr) * 3 + q) * 256 + bj * 128 + clb + 4 * n) = acc[ai][bj][1 + q][n];
        }
        float* rawu = rawl + (size_t)(u.pm * 4 + (u.pn - 4)) * 6 * 256;
        if (wr == 0 && fr == 0) {
#pragma unroll
            for (int bj = 0; bj < 2; ++bj)
#pragma unroll
                for (int n = 0; n < 2; ++n)
#pragma unroll
                    for (int q = 0; q < 3; ++q) *(f32x4*)(rawu + q * 256 + bj * 128 + clb + 4 * n) = acc[0][bj][q][n];
        }
        if (wr == 1 && fr == 15) {
#pragma unroll
            for (int bj = 0; bj < 2; ++bj)
#pragma unroll
                for (int n = 0; n < 2; ++n)
#pragma unroll
                    for (int q = 0; q < 3; ++q) *(f32x4*)(rawu + (3 + q) * 256 + bj * 128 + clb + 4 * n) = acc[1][bj][1 + q][n];
        }
        asm volatile("s_waitcnt lgkmcnt(0)" ::: "memory"); __builtin_amdgcn_s_barrier(); __builtin_amdgcn_s_barrier(); asm volatile("" ::: "memory");
#pragma unroll
        for (int bj = 0; bj < 2; ++bj)
#pragma unroll
            for (int n = 0; n < 2; ++n) {
                const int c0 = col0 + bj * 128 + 4 * n;
                const f32x4 w0 = *(const f32x4*)(cw + c0), w1 = *(const f32x4*)(cw + D + c0), w2 = *(const f32x4*)(cw + 2 * D + c0), w3 = *(const f32x4*)(cw + 3 * D + c0), bb = *(const f32x4*)(cb + c0);
#pragma unroll
                for (int ai = 0; ai < 2; ++ai) {
                    f32x4 h1 = (f32x4){0.f, 0.f, 0.f, 0.f}, h2 = h1, h3 = h1;
                    const int pb = ai * 2 + wr - 1;
                    if (pb >= 0 && fr == 0) { const LAS float* xp = xch + (pb * 3) * 256 + bj * 128 + clb + 4 * n; h1 = *(const LAS f32x4*)(xp); h2 = *(const LAS f32x4*)(xp + 256); h3 = *(const LAS f32x4*)(xp + 512); }
                    float o[4][4];
#pragma unroll
                    for (int j = 0; j < 4; ++j) {
                        const float v0 = acc[ai][bj][0][n][j], v1 = acc[ai][bj][1][n][j], v2 = acc[ai][bj][2][n][j], v3 = acc[ai][bj][3][n][j];
                        const float p3 = dpp_upd<0x111>(h3[j], v3), p2 = dpp_upd<0x111>(h2[j], v2), p1 = dpp_upd<0x111>(h1[j], v1);
                        o[0][j] = bb[j] + w3[j] * v0 + w2[j] * p3 + w1[j] * p2 + w0[j] * p1;
                        o[1][j] = bb[j] + w3[j] * v1 + w2[j] * v0 + w1[j] * p3 + w0[j] * p2;
                        o[2][j] = bb[j] + w3[j] * v2 + w2[j] * v1 + w1[j] * v0 + w0[j] * p3;
                        o[3][j] = bb[j] + w3[j] * v3 + w2[j] * v2 + w1[j] * v1 + w0[j] * v0; }
#pragma unroll
                    for (int m = 0; m < 4; ++m) *(u32x2*)(REC + (size_t)(row0 + ai * 128 + m) * D + c0) = (u32x2){cvt_pk_bf16(o[m][0], o[m][1]), cvt_pk_bf16(o[m][2], o[m][3])};
                }
            }
    }
};
struct EpiGates {
    static constexpr bool PERM = true, ROWPERM = false;
    const bf16_t* REC; bf16_t* LA; bf16_t* BV; const float* b_a; const float* b_x; const float* lam;
    __device__ __forceinline__ void operator()(AccRef acc, const Unit& u, int wr, int wc, int fr, int fq) const {
        const int row0 = u.pm * 256 + wr * 64 + fr, col0 = u.pn * 128 + wc * 32 + 8 * fq;
        u32x4 rws[2][4];
#pragma unroll
        for (int ai = 0; ai < 2; ++ai)
#pragma unroll
            for (int m = 0; m < 4; ++m) rws[ai][m] = *(const u32x4*)(REC + (size_t)(row0 + ai * 128 + m * 16) * D + col0);
#pragma unroll
        for (int n = 0; n < 2; ++n) {
            const f32x4 ba = *(const f32x4*)(b_a + col0 + 4 * n), bx = *(const f32x4*)(b_x + col0 + 4 * n), l = *(const f32x4*)(lam + col0 + 4 * n);
            f32x4 k8;
#pragma unroll
            for (int j = 0; j < 4; ++j) k8[j] = -8.0f * __logf(1.0f + __expf(-l[j]));
#pragma unroll
            for (int ai = 0; ai < 2; ++ai)
#pragma unroll
                for (int m = 0; m < 4; ++m) { const size_t off = (size_t)(row0 + ai * 128 + m * 16) * D + col0 + 4 * n;
                    float lo[4], bo[4];
#pragma unroll
                    for (int j = 0; j < 4; ++j) { const unsigned w = rws[ai][m][2 * n + (j >> 1)]; const float rec = (j & 1) ? bfhi(w) : bflo(w);
                        const float r = sigmoidf_(acc[ai][0][m][n][j] + ba[j]), ig = sigmoidf_(acc[ai][1][m][n][j] + bx[j]);
                        const float la = k8[j] * r; const float mult = __builtin_sqrtf(1.0f - __expf(2.0f * la));
                        lo[j] = la; bo[j] = mult * ig * rec; }
                    *(u32x2*)(LA + off) = (u32x2){cvt_pk_bf16(lo[0], lo[1]), cvt_pk_bf16(lo[2], lo[3])}; *(u32x2*)(BV + off) = (u32x2){cvt_pk_bf16(bo[0], bo[1]), cvt_pk_bf16(bo[2], bo[3])}; }
        }
    }
};
struct EpiQKV {
    static constexpr bool PERM = true, ROWPERM = false;
    bf16_t* QKV; const float* qg; const float* kg;
    __device__ __forceinline__ void operator()(AccRef acc, const Unit& u, int wr, int wc, int fr, int fq) const {
        const int which = u.pn >> 2, row0 = u.pm * 256 + wr * 64 + fr, col0 = (u.pn & 3) * 256 + wc * 64 + 8 * fq;
        bf16_t* dst = QKV + (size_t)which * ((size_t)T * D);
        f32x4 gv[2][2];
#pragma unroll
        for (int bj = 0; bj < 2; ++bj)
#pragma unroll
            for (int n = 0; n < 2; ++n) { const f32x4 a = *(const f32x4*)(qg + 32 * bj + 8 * fq + 4 * n), b = *(const f32x4*)(kg + 32 * bj + 8 * fq + 4 * n);
                gv[bj][n] = which == 0 ? a : (which == 1 ? b : (f32x4){1.f, 1.f, 1.f, 1.f}); }
#pragma unroll
        for (int ai = 0; ai < 2; ++ai)
#pragma unroll
            for (int m = 0; m < 4; ++m) {
                float sc = 1.0f;
                if (which < 2) { float ss = 0.f;
#pragma unroll
                    for (int bj = 0; bj < 2; ++bj)
#pragma unroll
                        for (int n = 0; n < 2; ++n) { const f32x4 v = acc[ai][bj][m][n]; ss += (v[0] * v[0] + v[1] * v[1]) + (v[2] * v[2] + v[3] * v[3]); }
                    ss += __shfl_xor(ss, 16); ss += __shfl_xor(ss, 32);
                    sc = rsqrtf(ss * (1.0f / 64.0f) + 1e-6f) * (which == 0 ? 0.18033688011112042f : 1.0f); }
                const int row = row0 + ai * 128 + m * 16;
                bf16_t* rp = dst + (size_t)row * D + col0;
                bf16_t* kp = dst + ((size_t)((row >> 11) * 16 + (u.pn & 3) * 4 + wc) * 64 * SEQ) + (size_t)((((row & 2047) >> 5) * 4 + (fq >> 1)) * 64 + (row & 31) + 32 * (fq & 1)) * 8;
#pragma unroll
                for (int bj = 0; bj < 2; ++bj) { const f32x4 v0 = acc[ai][bj][m][0] * gv[bj][0] * sc, v1 = acc[ai][bj][m][1] * gv[bj][1] * sc;
                    u32x4 w; w.x = cvt_pk_bf16(v0[0], v0[1]); w.y = cvt_pk_bf16(v0[2], v0[3]); w.z = cvt_pk_bf16(v1[0], v1[1]); w.w = cvt_pk_bf16(v1[2], v1[3]);
                    if (which <= 1) *(u32x4*)(kp + (size_t)(2 * bj) * 64 * 8) = w; else *(u32x4*)(rp + bj * 32) = w; } }
    }
};
struct EpiFfn1 {
    static constexpr bool PERM = true, ROWPERM = true;
    bf16_t* Aout; const float* cw; const float* cb; float* raw; LAS float* xch;
    __device__ __forceinline__ void operator()(AccRef acc, const Unit& u, int wr, int wc, int fr, int fq) const {
        const int clb = 32 * wc + 8 * fq;
        f32x4 cwv[2][8];
        { const float* cv = cw + 128 * u.pn + clb; const float* cg = cv + FH; const float* bp = cb + 128 * u.pn + clb;
          cwv[0][0] = *(const f32x4*)(cv); cwv[0][1] = *(const f32x4*)(cv + F2); cwv[0][2] = *(const f32x4*)(cv + 2 * F2); cwv[0][3] = *(const f32x4*)(bp);
          cwv[0][4] = *(const f32x4*)(cg); cwv[0][5] = *(const f32x4*)(cg + F2); cwv[0][6] = *(const f32x4*)(cg + 2 * F2); cwv[0][7] = *(const f32x4*)(bp + FH); }
        if (fr == 15) {
#pragma unroll
            for (int ai = 0; ai < 2; ++ai)
#pragma unroll
                for (int bj = 0; bj < 2; ++bj)
#pragma unroll
                    for (int n = 0; n < 2; ++n) { *(LAS f32x4*)(xch + ((ai * 2 + wr) * 2 + 0) * 256 + bj * 128 + clb + 4 * n) = acc[ai][bj][2][n]; *(LAS f32x4*)(xch + ((ai * 2 + wr) * 2 + 1) * 256 + bj * 128 + clb + 4 * n) = acc[ai][bj][3][n]; }
        }
        float* rawu = raw + (size_t)(u.pm * 22 + u.pn) * 1024;
        if (wr == 0 && fr == 0) {
#pragma unroll
            for (int bj = 0; bj < 2; ++bj)
#pragma unroll
                for (int n = 0; n < 2; ++n) { *(f32x4*)(rawu + 0 * 256 + bj * 128 + clb + 4 * n) = acc[0][bj][0][n]; *(f32x4*)(rawu + 1 * 256 + bj * 128 + clb + 4 * n) = acc[0][bj][1][n]; }
        }
        if (wr == 1 && fr == 15) {
#pragma unroll
            for (int bj = 0; bj < 2; ++bj)
#pragma unroll
                for (int n = 0; n < 2; ++n) { *(f32x4*)(rawu + 2 * 256 + bj * 128 + clb + 4 * n) = acc[1][bj][2][n]; *(f32x4*)(rawu + 3 * 256 + bj * 128 + clb + 4 * n) = acc[1][bj][3][n]; }
        }
        asm volatile("s_waitcnt lgkmcnt(0)" ::: "memory"); __builtin_amdgcn_s_barrier(); __builtin_amdgcn_s_barrier(); asm volatile("" ::: "memory");
        const int hc0 = 128 * u.pn + clb, row0 = u.pm * 256 + wr * 64 + 4 * fr;
#pragma unroll
        for (int n = 0; n < 2; ++n) {
            const f32x4 w0v = cwv[n][0], w1v = cwv[n][1], w2v = cwv[n][2], bvv = cwv[n][3], w0g = cwv[n][4], w1g = cwv[n][5], w2g = cwv[n][6], bvg = cwv[n][7];
#pragma unroll
            for (int ai = 0; ai < 2; ++ai) {
                if (n == 0 && ai == 0) {
                    asm volatile("" ::: "memory");
                    const float* cv = cw + hc0 + 4; const float* cg = cv + FH; const float* bp = cb + hc0 + 4;
                    cwv[1][0] = *(const f32x4*)(cv); cwv[1][1] = *(const f32x4*)(cv + F2); cwv[1][2] = *(const f32x4*)(cv + 2 * F2); cwv[1][3] = *(const f32x4*)(bp);
                    cwv[1][4] = *(const f32x4*)(cg); cwv[1][5] = *(const f32x4*)(cg + F2); cwv[1][6] = *(const f32x4*)(cg + 2 * F2); cwv[1][7] = *(const f32x4*)(bp + FH);
                    asm volatile("" ::: "memory"); }
                f32x4 h2v = (f32x4){0.f, 0.f, 0.f, 0.f}, h3v = h2v, h2g = h2v, h3g = h2v;
                const int pb = ai * 2 + wr - 1;
                if (pb >= 0 && fr == 0) { const LAS float* xp = xch + (pb * 2) * 256 + clb + 4 * n;
                    h2v = *(const LAS f32x4*)(xp); h3v = *(const LAS f32x4*)(xp + 256); h2g = *(const LAS f32x4*)(xp + 128); h3g = *(const LAS f32x4*)(xp + 256 + 128); }
                float o[4][4];
#pragma unroll
                for (int j = 0; j < 4; ++j) {
                    const float v0 = acc[ai][0][0][n][j], v1 = acc[ai][0][1][n][j], v2 = acc[ai][0][2][n][j], v3 = acc[ai][0][3][n][j];
                    const float g0 = acc[ai][1][0][n][j], g1 = acc[ai][1][1][n][j], g2 = acc[ai][1][2][n][j], g3 = acc[ai][1][3][n][j];
                    const float pv3 = dpp_upd<0x111>(h3v[j], v3), pv2 = dpp_upd<0x111>(h2v[j], v2), pg3 = dpp_upd<0x111>(h3g[j], g3), pg2 = dpp_upd<0x111>(h2g[j], g2);
                    const float hv0 = bvv[j] + w2v[j] * v0 + w1v[j] * pv3 + w0v[j] * pv2, hv1 = bvv[j] + w2v[j] * v1 + w1v[j] * v0 + w0v[j] * pv3;
                    const float hv2 = bvv[j] + w2v[j] * v2 + w1v[j] * v1 + w0v[j] * v0, hv3 = bvv[j] + w2v[j] * v3 + w1v[j] * v2 + w0v[j] * v1;
                    const float hg0 = bvg[j] + w2g[j] * g0 + w1g[j] * pg3 + w0g[j] * pg2, hg1 = bvg[j] + w2g[j] * g1 + w1g[j] * g0 + w0g[j] * pg3;
                    const float hg2 = bvg[j] + w2g[j] * g2 + w1g[j] * g1 + w0g[j] * g0, hg3 = bvg[j] + w2g[j] * g3 + w1g[j] * g2 + w0g[j] * g1;
                    o[0][j] = hg0 * sigmoidf_(hg0) * hv0; o[1][j] = hg1 * sigmoidf_(hg1) * hv1; o[2][j] = hg2 * sigmoidf_(hg2) * hv2; o[3][j] = hg3 * sigmoidf_(hg3) * hv3; }
#pragma unroll
                for (int m = 0; m < 4; ++m) { u32x2 w; w.x = cvt_pk_bf16(o[m][0], o[m][1]); w.y = cvt_pk_bf16(o[m][2], o[m][3]);
                    *(u32x2*)(Aout + (size_t)(row0 + ai * 128 + m) * FH + hc0 + 4 * n) = w; } } }
    }
};

#define XB_TMO      128
#define XB_XCNT(j)  (256  + 64 * (j))
#define XB_XSUB(j)  (1280 + 64 * (j))
#define XB_XGEN(j)  (2304 + 64 * (j))
#define XB_TOP      3328
#define XB_TOPGEN   3392
#define XCD_BAR_WORDS 3456
#define XB_SPIN_CAP (1u << 24)
__device__ __forceinline__ unsigned xb_ld(unsigned* p)              { return __hip_atomic_load(p, __ATOMIC_RELAXED, __HIP_MEMORY_SCOPE_AGENT); }
__device__ __forceinline__ unsigned xb_add(unsigned* p, unsigned v) { return __hip_atomic_fetch_add(p, v, __ATOMIC_RELAXED, __HIP_MEMORY_SCOPE_AGENT); }
__device__ __forceinline__ unsigned xb_xcc_id() { return (unsigned)__builtin_amdgcn_s_getreg((3 << 11) | 20) & 0xFu; }
#define XB_SPIN(cond, bar) do { unsigned _sp = 0; while (cond) { __builtin_amdgcn_s_sleep(1); \
    if ((++_sp & 255u) == 0u) { if (xb_ld(&(bar)[XB_TMO])) break; if (_sp > XB_SPIN_CAP) { atomicAdd(&(bar)[XB_TMO], 1u); break; } } } } while (0)
struct XcdBarrier { unsigned* bar; unsigned x; volatile LAS unsigned* st; };
__device__ __forceinline__ XcdBarrier xcd_barrier_post(unsigned* bar, volatile LAS unsigned* st) {
    XcdBarrier b; b.bar = bar; b.x = xb_xcc_id(); b.st = st;
    if (threadIdx.x == 0) (void)xb_add(&bar[XB_XCNT(b.x)], 1u);
    return b;
}
__device__ __forceinline__ void xcd_barrier_complete(unsigned* bar, unsigned x, unsigned& nloc, unsigned& nx) {
    const unsigned G = gridDim.x * gridDim.y * gridDim.z;
    unsigned sum, cnt, mine, sp = 0u;
    for (;;) {
        sum = 0u; cnt = 0u; mine = 0u;
#pragma unroll
        for (unsigned j = 0; j < 16; ++j) { const unsigned c = xb_ld(&bar[XB_XCNT(j)]); sum += c; cnt += (c > 0u) ? 1u : 0u; mine = (j == x) ? c : mine; }
        if (sum == G) break;
        __builtin_amdgcn_s_sleep(1);
        if ((++sp & 255u) == 0u) { if (xb_ld(&bar[XB_TMO])) break; if (sp > XB_SPIN_CAP) { atomicAdd(&bar[XB_TMO], 1u); break; } }
    }
    nloc = mine > 0u ? mine : 1u; nx = cnt > 0u ? cnt : 1u;
}
__device__ __forceinline__ void xcd_barrier(const XcdBarrier& b) {
    asm volatile("s_waitcnt vmcnt(0) lgkmcnt(0)" ::: "memory");
    __syncthreads();
    if (threadIdx.x == 0) {
        unsigned* bar = b.bar;
        __builtin_amdgcn_s_waitcnt(0);
        unsigned nloc = b.st[0], nx = b.st[1];
        if (nloc == 0u) { xcd_barrier_complete(bar, b.x, nloc, nx); b.st[0] = nloc; b.st[1] = nx; }
        const unsigned old = xb_add(&bar[XB_XSUB(b.x)], 1u);
        const unsigned gen = old / nloc;
        if (old + 1u == (gen + 1u) * nloc) {
            __builtin_amdgcn_fence(__ATOMIC_RELEASE, "agent");
            asm volatile("s_waitcnt vmcnt(0)" ::: "memory");
            const unsigned og = xb_add(&bar[XB_TOP], 1u);
            const unsigned tg = og / nx;
            if (og + 1u == (tg + 1u) * nx) xb_add(&bar[XB_TOPGEN], 1u);
            else XB_SPIN(xb_ld(&bar[XB_TOPGEN]) == tg, bar);
            __builtin_amdgcn_fence(__ATOMIC_ACQUIRE, "agent");
            xb_add(&bar[XB_XGEN(b.x)], 1u);
            asm volatile("s_waitcnt vmcnt(0)" ::: "memory");
        } else {
            XB_SPIN(xb_ld(&bar[XB_XGEN(b.x)]) == gen, bar);
            __builtin_amdgcn_fence(__ATOMIC_ACQUIRE, "agent");
            asm volatile("s_waitcnt vmcnt(0)" ::: "memory");
        }
    }
    __syncthreads();
}

struct Job { const float* src; bf16_t* dst; int K, ld, nrows, map, hh, item0; };
constexpr int NJOBS = 33;
struct Params {
    const float* in[33]; float* out; unsigned char* ws;
    Job jobs[NJOBS]; int nitems; int nitems_a;
};

__device__ __forceinline__ int map_col(int map, int hh, int j) {
    if (map == 0) return j;
    if (map == 1) { const int pn = j >> 8, bj = (j >> 7) & 1, i = j & 127; return bj * hh + 128 * pn + i; }
    const int pn = j >> 8, cl = j & 255, bj = cl >> 7, h4 = (cl & 127) >> 5, i = cl & 31; return 256 * pn + 64 * h4 + 32 * bj + i;
}

__device__ __forceinline__ void weights_phase(const Params& P, LAS float* scr, int lane, int it0, int it1, int w, int nw) {
    for (int it = it0 + w; it < it1; it += nw) {
        int ji = 0;
#pragma unroll 1
        for (int q = 1; q < NJOBS; ++q) if (it >= P.jobs[q].item0) ji = q;
        const Job jb = P.jobs[ji];
        const int r = it - jb.item0, nblk = jb.nrows / 32, kb = r / nblk, nb = r % nblk, k0 = 64 * kb, n0 = 32 * nb, c0 = map_col(jb.map, jb.hh, n0);
#pragma unroll 8
        for (int i = 0; i < 32; ++i) { const int kk = 2 * i + (lane >> 5); scr[kk * 33 + (lane & 31)] = jb.src[(size_t)(k0 + kk) * jb.ld + c0 + (lane & 31)]; }
        asm volatile("s_waitcnt lgkmcnt(0)" ::: "memory");
        const int c = lane & 7;
#pragma unroll
        for (int j = 0; j < 4; ++j) { const int n = (lane >> 3) + 8 * j; const LAS float* s = scr + (8 * c) * 33 + n;
            u32x4 o; o.x = cvt_pk_bf16(s[0 * 33], s[1 * 33]); o.y = cvt_pk_bf16(s[2 * 33], s[3 * 33]); o.z = cvt_pk_bf16(s[4 * 33], s[5 * 33]); o.w = cvt_pk_bf16(s[6 * 33], s[7 * 33]);
            *(u32x4*)(jb.dst + (size_t)(n0 + n) * jb.K + k0 + 8 * c) = o; }
        asm volatile("s_waitcnt lgkmcnt(0)" ::: "memory");
    }
}
__device__ __forceinline__ void rmsnorm_phase(const float* x, const float* g, bf16_t* hn) {
    const int tid__ = otid(); const int lane = tid__ & 63, wave = tid__ >> 6;
    const int gw = blockIdx.x * 8 + wave, ngw = gridDim.x * 8;
    f32x4 gv[4];
#pragma unroll
    for (int j = 0; j < 4; ++j) gv[j] = *((const f32x4*)g + lane + 64 * j);
    f32x4 v[4];
    if (gw < T) {
#pragma unroll
        for (int j = 0; j < 4; ++j) v[j] = ((const f32x4*)(x + (size_t)gw * D) + lane)[64 * j]; }
    for (int m = gw; m < T; m += ngw) {
        f32x4 vn[4];
        const int mn = (m + ngw < T) ? m + ngw : m;
#pragma unroll
        for (int j = 0; j < 4; ++j) vn[j] = ((const f32x4*)(x + (size_t)mn * D) + lane)[64 * j];
        float s = 0.f;
#pragma unroll
        for (int j = 0; j < 4; ++j) s += (v[j][0] * v[j][0] + v[j][1] * v[j][1]) + (v[j][2] * v[j][2] + v[j][3] * v[j][3]);
        const float rstd = rsqrtf(wave_sum(s) * (1.0f / D) + 1e-6f);
        u32x2* o = (u32x2*)(hn + (size_t)m * D) + lane;
#pragma unroll
        for (int j = 0; j < 4; ++j) { const f32x4 y = v[j] * rstd * gv[j]; u32x2 w; w.x = cvt_pk_bf16(y[0], y[1]); w.y = cvt_pk_bf16(y[2], y[3]); o[64 * j] = w; }
#pragma unroll
        for (int j = 0; j < 4; ++j) v[j] = vn[j];
    }
}
__device__ __forceinline__ void ld8(const bf16_t* p, float (&v)[8]) {
    const u32x4 w = *(const u32x4*)p;
#pragma unroll
    for (int i = 0; i < 4; ++i) { v[2 * i] = bflo(w[i]); v[2 * i + 1] = bfhi(w[i]); }
}
__device__ __forceinline__ void st8(bf16_t* p, const float (&v)[8]) {
    u32x4 w; w.x = cvt_pk_bf16(v[0], v[1]); w.y = cvt_pk_bf16(v[2], v[3]); w.z = cvt_pk_bf16(v[4], v[5]); w.w = cvt_pk_bf16(v[6], v[7]);
    *(u32x4*)p = w;
}
__device__ __forceinline__ void pool_phase(const bf16_t* hn, bf16_t* dd) {
    for (int gid = blockIdx.x * NTHREADS + otid(); gid < (T / 32) * 128; gid += gridDim.x * NTHREADS) {
        const int col8 = gid & 127, chunk = gid >> 7, w = 2 << (col8 >> 5), t0 = chunk * 32, pos0 = t0 & (SEQ - 1);
        const bf16_t* hp = hn + (size_t)t0 * D + col8 * 8; bf16_t* dp = dd + (size_t)t0 * D + col8 * 8;
        float s[8];
#pragma unroll
        for (int i = 0; i < 8; ++i) s[i] = 0.f;
        if (pos0) for (int k = 1; k <= w; ++k) { float v[8]; ld8(hp - (size_t)k * D, v);
#pragma unroll
            for (int i = 0; i < 8; ++i) s[i] += v[i]; }
        for (int i = 0; i < 32; ++i) {
            float cur[8]; ld8(hp + (size_t)i * D, cur); const int pos = pos0 + i;
#pragma unroll
            for (int q = 0; q < 8; ++q) s[q] += cur[q];
            if (pos >= w) { float v[8]; ld8(hp + (size_t)(i - w) * D, v);
#pragma unroll
                for (int q = 0; q < 8; ++q) s[q] -= v[q]; }
            const float inv = 1.0f / (float)(pos + 1 < w ? pos + 1 : w);
            float o[8];
#pragma unroll
            for (int q = 0; q < 8; ++q) o[q] = s[q] * inv - cur[q];
            st8(dp + (size_t)i * D, o);
        }
    }
}
__device__ __forceinline__ void lru_fix_panel(const float* rawl, const float* cw, const float* cb, bf16_t* REC, int pm) {
    if ((pm & 7) == 0) return;
    const int tid = otid();
    float x[6][4], w[6][4], bb[6];
#pragma unroll
    for (int k = 0; k < 6; ++k) {
        const int idx = tid + k * NTHREADS, c = idx & 1023, rr = idx >> 10, pnl = c >> 8, cl = c & 255;
        const float* cur = rawl + (size_t)(pm * 4 + pnl) * 6 * 256 + cl; const float* prv = rawl + (size_t)((pm - 1) * 4 + pnl) * 6 * 256 + cl;
#pragma unroll
        for (int d = 0; d < 4; ++d) { const int q = rr - d; x[k][d] = q >= 0 ? cur[q * 256] : prv[(6 + q) * 256]; w[k][d] = cw[(3 - d) * D + c]; }
        bb[k] = cb[c];
    }
#pragma unroll
    for (int k = 0; k < 6; ++k) {
        const int idx = tid + k * NTHREADS, c = idx & 1023, rr = idx >> 10;
        const float o = bb[k] + w[k][0] * x[k][0] + w[k][1] * x[k][1] + w[k][2] * x[k][2] + w[k][3] * x[k][3];
        REC[(size_t)(pm * 256 + rr) * D + c] = (bf16_t)(cvt_pk_bf16(o, 0.f) & 0xffffu);
    }
}
__device__ __forceinline__ void lruscan_phase(const bf16_t* LA, const bf16_t* BV, bf16_t* GG, LAS unsigned char* lds) {
    LAS float* sA = (LAS float*)lds; LAS float* sB = sA + 64 * 64;
    const int tid__ = otid(); const int c8 = tid__ & 7, tc = tid__ >> 3;
    for (int unit = blockIdx.x; unit < 256; unit += gridDim.x) {
        const int b = unit >> 4, cgp = unit & 15;
        const size_t base = ((size_t)b * SEQ + tc * 32) * D + cgp * 64 + c8 * 8;
        float sl[8], Bv[8], h[8];
#pragma unroll
        for (int q = 0; q < 8; ++q) { sl[q] = 0.f; Bv[q] = 0.f; h[q] = 0.f; }
#pragma unroll 4
        for (int i = 0; i < 32; ++i) { float la[8], bb[8]; ld8(LA + base + (size_t)i * D, la); ld8(BV + base + (size_t)i * D, bb);
#pragma unroll
            for (int q = 0; q < 8; ++q) { Bv[q] = __expf(la[q]) * Bv[q] + bb[q]; sl[q] += la[q]; } }
#pragma unroll
        for (int q = 0; q < 8; ++q) { sA[tc * 64 + c8 * 8 + q] = __expf(sl[q]); sB[tc * 64 + c8 * 8 + q] = Bv[q]; }
        __syncthreads();
        for (int j = 0; j < tc; ++j) {
            const f32x4 a0 = *(const LAS f32x4*)(sA + j * 64 + c8 * 8), a1 = *(const LAS f32x4*)(sA + j * 64 + c8 * 8 + 4), b0 = *(const LAS f32x4*)(sB + j * 64 + c8 * 8), b1 = *(const LAS f32x4*)(sB + j * 64 + c8 * 8 + 4);
#pragma unroll
            for (int q = 0; q < 4; ++q) { h[q] = a0[q] * h[q] + b0[q]; h[4 + q] = a1[q] * h[4 + q] + b1[q]; } }
#pragma unroll 4
        for (int i = 0; i < 32; ++i) { float la[8], bb[8], gg[8], y[8]; ld8(LA + base + (size_t)i * D, la); ld8(BV + base + (size_t)i * D, bb); ld8(GG + base + (size_t)i * D, gg);
#pragma unroll
            for (int q = 0; q < 8; ++q) { h[q] = __expf(la[q]) * h[q] + bb[q]; y[q] = gg[q] * h[q]; }
            st8(GG + base + (size_t)i * D, y); }
        __syncthreads();
    }
}
__device__ __forceinline__ void ffn_fix_panel(const float* raw, const float* cw, const float* cb, bf16_t* Aout, int pm) {
    if ((pm & 7) == 0) return;
    const int tid = otid();
    float x0[11][2], x1[11][2], x2[11][2], w0[11][2], w1[11][2], w2[11][2], bb[11][2];
#pragma unroll
    for (int k = 0; k < 11; ++k) {
        const int idx = tid + k * NTHREADS, hc = idx % FH, rr = idx / FH, pn = hc >> 7, cl = hc & 127;
        const float* cur = raw + (size_t)(pm * 22 + pn) * 1024; const float* prv = raw + (size_t)((pm - 1) * 22 + pn) * 1024;
#pragma unroll
        for (int part = 0; part < 2; ++part) { const int off = part * 128 + cl, col = part * FH + hc;
            x0[k][part] = cur[rr * 256 + off]; x1[k][part] = rr ? cur[off] : prv[3 * 256 + off]; x2[k][part] = rr ? prv[3 * 256 + off] : prv[2 * 256 + off];
            bb[k][part] = cb[col]; w2[k][part] = cw[2 * F2 + col]; w1[k][part] = cw[F2 + col]; w0[k][part] = cw[col]; }
    }
#pragma unroll
    for (int k = 0; k < 11; ++k) {
        const int idx = tid + k * NTHREADS, hc = idx % FH, rr = idx / FH;
        const float hv = bb[k][0] + w2[k][0] * x0[k][0] + w1[k][0] * x1[k][0] + w0[k][0] * x2[k][0];
        const float hg = bb[k][1] + w2[k][1] * x0[k][1] + w1[k][1] * x1[k][1] + w0[k][1] * x2[k][1];
        const float o = hg * sigmoidf_(hg) * hv;
        Aout[(size_t)(pm * 256 + rr) * FH + hc] = (bf16_t)(cvt_pk_bf16(o, 0.f) & 0xffffu);
    }
}

__device__ __forceinline__ void s5_phase(const Params& P, const bf16_t* hn, bf16_t* ys, LAS unsigned char* lds) {
    const int tid__ = otid(); const int lane = tid__ & 63, wave = tid__ >> 6;
    if (wave >= 4) { weights_phase(P, (LAS float*)(lds + 65536 + (wave - 4) * 8448), lane, P.nitems_a, P.nitems, blockIdx.x * 4 + (wave - 4), gridDim.x * 4); return; }
    LAS unsigned* S = (LAS unsigned*)(lds + wave * 8704);
    const float* lam_re = P.in[6]; const float* lam_im = P.in[7]; const float* log_dt = P.in[8]; const float* b_re = P.in[9]; const float* b_im = P.in[10];
    const float* c_re = P.in[11]; const float* c_im = P.in[12]; const float* dsk = P.in[13];
    const int c32 = lane & 31, hf = lane >> 5, c16 = lane & 15, q4 = lane >> 4;
    for (int unit = blockIdx.x * 4 + wave; unit < 1024; unit += gridDim.x * 4) {
        const int b = unit >> 6, g = unit & 63;
        const float dt = expf(log_dt[g]);
        float ar, ai;
        { const float lr = fminf(lam_re[g * 64 + lane], -1e-4f), li = lam_im[g * 64 + lane]; const float er = expf(lr * dt); ar = er * cosf(li * dt); ai = er * sinf(li * dt); }
        bf16x8 Bre[2], Bim[2];
#pragma unroll
        for (int pb = 0; pb < 2; ++pb) {
            const int pp = pb * 32 + c32;
            const float lr = fminf(lam_re[g * 64 + pp], -1e-4f), li = lam_im[g * 64 + pp]; const float er = expf(lr * dt);
            const float nr = er * cosf(li * dt) - 1.0f, ni = er * sinf(li * dt), dd = lr * lr + li * li;
            const float cr = (nr * lr + ni * li) / dd, ci = (ni * lr - nr * li) / dd;
            const float* br = b_re + (size_t)(g * 64 + pp) * 16 + 8 * hf; const float* bi = b_im + (size_t)(g * 64 + pp) * 16 + 8 * hf;
            unsigned wr_[4], wi_[4];
#pragma unroll
            for (int i = 0; i < 4; ++i) { const float r0 = br[2 * i], i0 = bi[2 * i], r1 = br[2 * i + 1], i1 = bi[2 * i + 1];
                wr_[i] = cvt_pk_bf16(cr * r0 - ci * i0, cr * r1 - ci * i1); wi_[i] = cvt_pk_bf16(cr * i0 + ci * r0, cr * i1 + ci * r1); }
            Bre[pb] = __builtin_bit_cast(bf16x8, (u32x4){wr_[0], wr_[1], wr_[2], wr_[3]}); Bim[pb] = __builtin_bit_cast(bf16x8, (u32x4){wi_[0], wi_[1], wi_[2], wi_[3]});
        }
        bf16x8 Cf[4];
#pragma unroll
        for (int kb = 0; kb < 4; ++kb) { const int p0 = kb * 16 + 4 * q4; const float* cr = c_re + (size_t)(g * 16 + c16) * 64 + p0; const float* ci = c_im + (size_t)(g * 16 + c16) * 64 + p0;
            Cf[kb] = __builtin_bit_cast(bf16x8, (u32x4){cvt_pk_bf16(cr[0], -ci[0]), cvt_pk_bf16(cr[1], -ci[1]), cvt_pk_bf16(cr[2], -ci[2]), cvt_pk_bf16(cr[3], -ci[3])}); }
        float dk[4];
#pragma unroll
        for (int r = 0; r < 4; ++r) dk[r] = dsk[g * 16 + 4 * q4 + r];
        float sr = 0.f, si = 0.f;
        const bf16_t* hb = hn + (size_t)b * SEQ * D + g * 16; bf16_t* yb = ys + (size_t)b * SEQ * D + g * 16;
        bf16x8 ufn = *(const bf16x8*)(hb + (size_t)c32 * D + 8 * hf);
        u32x2 uwn[2];
#pragma unroll
        for (int tb = 0; tb < 2; ++tb) uwn[tb] = *(const u32x2*)(hb + (size_t)(tb * 16 + c16) * D + 4 * q4);
        for (int c = 0; c < SEQ / 32; ++c) {
            const int t0 = c * 32;
            const bf16x8 uf = ufn; const u32x2 uwc[2] = {uwn[0], uwn[1]};
            { const int tn = (c + 1 < SEQ / 32) ? t0 + 32 : t0;
              ufn = *(const bf16x8*)(hb + (size_t)(tn + c32) * D + 8 * hf);
#pragma unroll
              for (int tb = 0; tb < 2; ++tb) uwn[tb] = *(const u32x2*)(hb + (size_t)(tn + tb * 16 + c16) * D + 4 * q4); }
            const f32x16 z16 = {0.f, 0.f, 0.f, 0.f, 0.f, 0.f, 0.f, 0.f, 0.f, 0.f, 0.f, 0.f, 0.f, 0.f, 0.f, 0.f};
            f32x16 r0 = __builtin_amdgcn_mfma_f32_32x32x16_bf16(uf, Bre[0], z16, 0, 0, 0), r1 = __builtin_amdgcn_mfma_f32_32x32x16_bf16(uf, Bre[1], z16, 0, 0, 0);
            f32x16 i0 = __builtin_amdgcn_mfma_f32_32x32x16_bf16(uf, Bim[0], z16, 0, 0, 0), i1 = __builtin_amdgcn_mfma_f32_32x32x16_bf16(uf, Bim[1], z16, 0, 0, 0);
#pragma unroll
            for (int q = 0; q < 4; ++q) {
                float xr[8], xi[8];
#pragma unroll
                for (int i = 0; i < 4; ++i) {
                    auto pr = __builtin_amdgcn_permlane32_swap(__float_as_uint(r0[4 * q + i]), __float_as_uint(r1[4 * q + i]), false, false);
                    auto pi = __builtin_amdgcn_permlane32_swap(__float_as_uint(i0[4 * q + i]), __float_as_uint(i1[4 * q + i]), false, false);
                    xr[i] = __uint_as_float(pr[0]); xr[4 + i] = __uint_as_float(pr[1]); xi[i] = __uint_as_float(pi[0]); xi[4 + i] = __uint_as_float(pi[1]); }
#pragma unroll
                for (int i = 0; i < 8; ++i) { const float nr = ar * sr - ai * si + xr[i], ni = ar * si + ai * sr + xi[i]; sr = nr; si = ni;
                    S[(8 * q + i) * 68 + lane] = cvt_pk_bf16(sr, si); }
            }
            asm volatile("" ::: "memory");
#pragma unroll
            for (int tb = 0; tb < 2; ++tb) {
                f32x4 y = (f32x4){0.f, 0.f, 0.f, 0.f};
#pragma unroll
                for (int kb = 0; kb < 4; ++kb) { const bf16x8 sf = __builtin_bit_cast(bf16x8, *(const LAS u32x4*)(S + (tb * 16 + c16) * 68 + kb * 16 + 4 * q4));
                    y = __builtin_amdgcn_mfma_f32_16x16x32_bf16(Cf[kb], sf, y, 0, 0, 0); }
                const size_t off = (size_t)(t0 + tb * 16 + c16) * D + 4 * q4;
                const u32x2 uw = uwc[tb];
                const float u0 = bflo(uw.x), u1 = bfhi(uw.x), u2 = bflo(uw.y), u3 = bfhi(uw.y);
                u32x2 w; w.x = cvt_pk_bf16(gelu_tanh(y[0] + dk[0] * u0), gelu_tanh(y[1] + dk[1] * u1)); w.y = cvt_pk_bf16(gelu_tanh(y[2] + dk[2] * u2), gelu_tanh(y[3] + dk[3] * u3));
                *(u32x2*)(yb + off) = w;
            }
        }
    }
}

__device__ __forceinline__ void attn_phase(const bf16_t* Q, const bf16_t* KF, const bf16_t* V, bf16_t* VT, bf16_t* O, LAS unsigned char* lds, unsigned* ctr) {
    const int tid__ = otid(); const int lane = tid__ & 63, wave = tid__ >> 6, c32 = lane & 31, hf = lane >> 5;
    for (int bh = blockIdx.x; bh < 256; bh += gridDim.x) {
        const int b = bh >> 4, h = bh & 15;
        bf16_t* vtw = VT + (size_t)(b * 16 + h) * 64 * SEQ;
        __syncthreads();
        if (tid__ == 0) *ctr = 0u;
        const bf16_t* kfw = KF + (size_t)(b * 16 + h) * 64 * SEQ;
        {
            LAS bf16_t* scr = (LAS bf16_t*)(lds + wave * 8704);
            for (int st = wave * 4; st < wave * 4 + 4; ++st) {
                const int s0 = st * 64;
#pragma unroll
                for (int j = 0; j < 8; ++j) { const int i = (lane >> 3) + 8 * j, c = lane & 7;
                    const u32x4 w = *(const u32x4*)(V + (size_t)(b * SEQ + s0 + i) * D + h * 64 + 8 * c);
                    *(LAS u32x2*)(scr + i * 68 + 8 * c) = (u32x2){w.x, w.y}; *(LAS u32x2*)(scr + i * 68 + 8 * c + 4) = (u32x2){w.z, w.w}; }
                asm volatile("s_waitcnt lgkmcnt(0)" ::: "memory");
#pragma unroll
                for (int blk = 0; blk < 8; ++blk) { const int t32 = blk >> 2, db = (blk >> 1) & 1, ks = blk & 1;
                    unsigned short e[8];
#pragma unroll
                    for (int k = 0; k < 8; ++k) e[k] = scr[(32 * t32 + 16 * ks + 8 * (k >> 2) + 4 * hf + (k & 3)) * 68 + db * 32 + c32];
                    u32x4 w; w.x = e[0] | ((unsigned)e[1] << 16); w.y = e[2] | ((unsigned)e[3] << 16); w.z = e[4] | ((unsigned)e[5] << 16); w.w = e[6] | ((unsigned)e[7] << 16);
                    *(u32x4*)(vtw + (size_t)((((st * 2 + t32) * 2 + db) * 2 + ks) * 64 + lane) * 8) = w; }
                asm volatile("s_waitcnt lgkmcnt(0)" ::: "memory");
            }
            asm volatile("s_waitcnt vmcnt(0)" ::: "memory"); __syncthreads();
        }
        const bf16_t* vtb = vtw;
        for (;;) {
            unsigned uq = 0u;
            if (lane == 0) uq = atomicAdd(ctr, 1u);
            uq = (unsigned)__builtin_amdgcn_readfirstlane((int)uq);
            if (uq >= 64u) break;
            const int qb = 63 - (int)uq, t0 = qb * 32;
            bf16x8 qf[4];
#pragma unroll
            for (int kd = 0; kd < 4; ++kd) qf[kd] = *(const bf16x8*)(Q + (size_t)(b * 16 + h) * 64 * SEQ + (size_t)((qb * 4 + kd) * 64 + lane) * 8);
            f32x16 o0 = {0.f, 0.f, 0.f, 0.f, 0.f, 0.f, 0.f, 0.f, 0.f, 0.f, 0.f, 0.f, 0.f, 0.f, 0.f, 0.f}, o1 = o0;
            float Pc = 1.0f;
            bf16x8 kfn[4];
#pragma unroll
            for (int kd = 0; kd < 4; ++kd) kfn[kd] = *(const bf16x8*)(kfw + (size_t)((qb * 4 + kd) * 64 + lane) * 8);
            for (int kt = qb; kt >= 0; --kt) {
                f32x16 z = {0.f, 0.f, 0.f, 0.f, 0.f, 0.f, 0.f, 0.f, 0.f, 0.f, 0.f, 0.f, 0.f, 0.f, 0.f, 0.f};
#pragma unroll
                for (int kd = 0; kd < 4; ++kd) z = __builtin_amdgcn_mfma_f32_32x32x16_bf16(kfn[kd], qf[kd], z, 0, 0, 0);
                { const int ktn = kt > 0 ? kt - 1 : kt;
#pragma unroll
                  for (int kd = 0; kd < 4; ++kd) kfn[kd] = *(const bf16x8*)(kfw + (size_t)((ktn * 4 + kd) * 64 + lane) * 8); }
                bf16x8 vf[2][2];
#pragma unroll
                for (int db = 0; db < 2; ++db)
#pragma unroll
                    for (int ks = 0; ks < 2; ++ks) vf[db][ks] = *(const bf16x8*)(vtb + (size_t)((((kt * 2 + db) * 2 + ks) * 64) + lane) * 8);
                float be[16], om[16];
#pragma unroll
                for (int r = 0; r < 16; ++r) { const float e = __builtin_amdgcn_exp2f(-fmaxf(z[r], -80.0f)); be[r] = __builtin_amdgcn_rcpf(1.0f + e); om[r] = e * be[r]; }
                if (kt == qb) {
#pragma unroll
                    for (int r = 0; r < 16; ++r) { const int sl = 8 * (r >> 2) + 4 * hf + (r & 3); const bool valid = sl < c32; be[r] = valid ? be[r] : 0.f; om[r] = valid ? om[r] : 1.0f; } }
                float bp[4], pbp[4];
#pragma unroll
                for (int q = 0; q < 4; ++q) { bp[q] = (om[4 * q] * om[4 * q + 1]) * (om[4 * q + 2] * om[4 * q + 3]); pbp[q] = __shfl_xor(bp[q], 32); }
                float after = Pc; float att[16];
#pragma unroll
                for (int q = 3; q >= 0; --q) {
                    const float off = hf == 0 ? after * pbp[q] : after;
                    const float e3 = off, e2 = e3 * om[4 * q + 3], e1 = e2 * om[4 * q + 2], e0 = e1 * om[4 * q + 1];
                    att[4 * q + 3] = be[4 * q + 3] * e3; att[4 * q + 2] = be[4 * q + 2] * e2; att[4 * q + 1] = be[4 * q + 1] * e1; att[4 * q] = be[4 * q] * e0;
                    after *= bp[q] * pbp[q];
                }
                Pc = after;
#pragma unroll
                for (int ks = 0; ks < 2; ++ks) {
                    const bf16x8 pf = __builtin_bit_cast(bf16x8, (u32x4){cvt_pk_bf16(att[8 * ks], att[8 * ks + 1]), cvt_pk_bf16(att[8 * ks + 2], att[8 * ks + 3]), cvt_pk_bf16(att[8 * ks + 4], att[8 * ks + 5]), cvt_pk_bf16(att[8 * ks + 6], att[8 * ks + 7])});
                    o0 = __builtin_amdgcn_mfma_f32_32x32x16_bf16(vf[0][ks], pf, o0, 0, 0, 0); o1 = __builtin_amdgcn_mfma_f32_32x32x16_bf16(vf[1][ks], pf, o1, 0, 0, 0); }
                if (__all(Pc == 0.0f)) break;
            }
            bf16_t* op = O + (size_t)(b * SEQ + t0 + c32) * D + h * 64 + 4 * hf;
#pragma unroll
            for (int q = 0; q < 4; ++q) {
                u32x2 w0; w0.x = cvt_pk_bf16(o0[4 * q], o0[4 * q + 1]); w0.y = cvt_pk_bf16(o0[4 * q + 2], o0[4 * q + 3]); *(u32x2*)(op + 8 * q) = w0;
                u32x2 w1; w1.x = cvt_pk_bf16(o1[4 * q], o1[4 * q + 1]); w1.y = cvt_pk_bf16(o1[4 * q + 2], o1[4 * q + 3]); *(u32x2*)(op + 32 + 8 * q) = w1; }
        }
    }
}

__global__ void __launch_bounds__(NTHREADS, 2) fwd_megakernel(Params P) {
    extern __shared__ __attribute__((aligned(16))) unsigned char lds_raw[];
    LAS unsigned char* lds = (LAS unsigned char*)lds_raw;
    cg::grid_group grid = cg::this_grid();
    unsigned char* ws = P.ws;
    bf16_t* HN = (bf16_t*)(ws + WS_HN);
    bf16_t* B0 = (bf16_t*)(ws + WS_BIG); bf16_t* B1 = (bf16_t*)(ws + WS_BIG + ACT); bf16_t* B2 = (bf16_t*)(ws + WS_BIG + 2 * ACT); bf16_t* B3 = (bf16_t*)(ws + WS_BIG + 3 * ACT); bf16_t* B4 = (bf16_t*)(ws + WS_BIG + 4 * ACT);
    float* RAW = (float*)(ws + WS_RAW);
    float* X = P.out;
    const int G = gridDim.x, bx = blockIdx.x;
    pg8::StaticOrder S;
    volatile LAS unsigned* MISC = (volatile LAS unsigned*)(lds + MISC_OFF);
    if (threadIdx.x < 2) MISC[threadIdx.x] = 0u;
    __syncthreads();
    const XcdBarrier bar = xcd_barrier_post((unsigned*)ws, MISC);
    grid.sync();
#define SYNC() xcd_barrier(bar)

    { const int tid__ = otid(); const int lane = tid__ & 63, wave = tid__ >> 6;
      weights_phase(P, (LAS float*)(lds + wave * 8448), lane, 0, P.nitems_a, blockIdx.x * 8 + wave, gridDim.x * 8); }
    rmsnorm_phase(P.in[0], P.in[1], HN);
    SYNC();
#define FFN_BLOCK(layer, LASTSYNC) do { \
        rmsnorm_phase(X, P.in[2] + (layer) * D, HN); \
        SYNC(); \
        const float* cw = P.in[30] + (size_t)(layer) * 3 * F2; const float* cb = P.in[31] + (size_t)(layer) * F2; \
        { pg8::Gemm g{HN, (const bf16_t*)(ws + WS_WF1) + (size_t)(layer) * F2 * D, T, F2, 1024, D, D, 0, 0}; S.init(T, F2, G, bx); \
          EpiFfn1 E{B0, cw, cb, RAW, (LAS float*)(lds + XCH_OFF)}; pg8::gemm_phase(lds, g, S, E); } \
        SYNC(); \
        { pg8::Gemm g{B0, (const bf16_t*)(ws + WS_WF2) + (size_t)(layer) * D * FH, T, 1024, FH, FH, FH, 0, 0}; S.init(T, 1024, G, bx); \
          { Unit fu; int lastpm = -1; for (int i = 0; S.next(i, fu); ++i) if (fu.pm != lastpm) { ffn_fix_panel(RAW, cw, cb, B0, fu.pm); lastpm = fu.pm; } } \
          asm volatile("s_waitcnt vmcnt(0)" ::: "memory"); __syncthreads(); \
          EpiRes E{X, X, nullptr, nullptr}; pg8::gemm_phase(lds, g, S, E); } \
        if (LASTSYNC) SYNC(); } while (0)

    pool_phase(HN, B0);
    SYNC();
    { pg8::Gemm g{B0, (const bf16_t*)(ws + WS_WPOOL), T, 1024, 256, D, 256, 0, 512}; S.init(T, 1024, G, bx);
      EpiRes E{P.in[0], X, P.in[5], P.in[4]}; pg8::gemm_phase(lds, g, S, E); }
    SYNC();
    FFN_BLOCK(0, true);
    rmsnorm_phase(X, P.in[1] + 1 * D, HN);
    SYNC();
    s5_phase(P, HN, B0, lds);
    SYNC();
    { pg8::Gemm g{B0, (const bf16_t*)(ws + WS_WS5), T, 2048, 1024, D, D, 0, 0}; S.init(T, 2048, G, bx);
      EpiGateRes E{X, P.in[15]}; pg8::gemm_phase(lds, g, S, E); }
    SYNC();
    FFN_BLOCK(1, true);
    rmsnorm_phase(X, P.in[1] + 2 * D, HN);
    SYNC();
    { pg8::Gemm g{HN, (const bf16_t*)(ws + WS_WLIN), T, 2048, 1024, D, D, 0, 0}; S.init(T, 2048, G, bx);
      EpiLruIn E{B0, B2, P.in[17], P.in[18], (float*)(ws + WS_RAWL), (LAS float*)(lds + XCH_OFF)}; pg8::gemm_phase(lds, g, S, E); }
    SYNC();
    { pg8::Gemm g{B2, (const bf16_t*)(ws + WS_WGATE), T, 2048, 256, D, 256, 1, 512}; S.init(T, 2048, G, bx);
      { Unit fu; int lastpm = -1; for (int i = 0; S.next(i, fu); ++i) if (fu.pm != lastpm) { lru_fix_panel((const float*)(ws + WS_RAWL), P.in[17], P.in[18], B2, fu.pm); lastpm = fu.pm; } }
      asm volatile("s_waitcnt vmcnt(0)" ::: "memory"); __syncthreads();
      EpiGates E{B2, B3, B4, P.in[20], P.in[22], P.in[23]}; pg8::gemm_phase(lds, g, S, E); }
    SYNC();
    lruscan_phase(B3, B4, B0, lds);
    SYNC();
    { pg8::Gemm g{B0, (const bf16_t*)(ws + WS_WLOUT), T, 1024, 1024, D, D, 0, 0}; S.init(T, 1024, G, bx);
      EpiRes E{X, X, nullptr, nullptr}; pg8::gemm_phase(lds, g, S, E); }
    SYNC();
    FFN_BLOCK(2, true);
    rmsnorm_phase(X, P.in[1] + 3 * D, HN);
    SYNC();
    { pg8::Gemm g{HN, (const bf16_t*)(ws + WS_WQKV), T, 3072, 1024, D, D, 0, 0}; S.init(T, 3072, G, bx);
      EpiQKV E{B0, P.in[26], P.in[27]}; pg8::gemm_phase(lds, g, S, E); }
    SYNC();
    attn_phase(B0, B1, B2, B3, B4, lds, (unsigned*)(lds_raw + MISC_OFF + 20));
    SYNC();
    { pg8::Gemm g{B4, (const bf16_t*)(ws + WS_WWO), T, 1024, 1024, D, D, 0, 0}; S.init(T, 1024, G, bx);
      EpiRes E{X, X, nullptr, nullptr}; pg8::gemm_phase(lds, g, S, E); }
    SYNC();
    FFN_BLOCK(3, false);
}

extern "C" void kernel_launch(void* const* d_in, const int* in_sizes, int n_in, void* d_out, int out_size, void* d_ws, size_t ws_size, hipStream_t stream) {
    static int grid = 0;
    if (grid == 0) {
        if (n_in != 33 || out_size != T * D || ws_size < WS_END) { fprintf(stderr, "kernel_launch: unexpected shapes (n_in %d out %d ws %zu)\n", n_in, out_size, ws_size); grid = -1; return; }
        int dev = 0, cus = 0, per_cu = 0;
        (void)hipGetDevice(&dev); (void)hipDeviceGetAttribute(&cus, hipDeviceAttributeMultiprocessorCount, dev);
        if (hipFuncSetAttribute((const void*)fwd_megakernel, hipFuncAttributeMaxDynamicSharedMemorySize, LDS_BYTES) != hipSuccess) { fprintf(stderr, "kernel_launch: hipFuncSetAttribute failed\n"); grid = -1; return; }
        (void)hipOccupancyMaxActiveBlocksPerMultiprocessor(&per_cu, (const void*)fwd_megakernel, NTHREADS, LDS_BYTES);
        (void)hipGetLastError();
        if (per_cu < 1) per_cu = 1;
        grid = cus * per_cu;
        if (grid > 256) grid = 256;
    }
    if (grid < 0) return;
    Params p; memset(&p, 0, sizeof(p));
    for (int i = 0; i < 33; ++i) p.in[i] = (const float*)d_in[i];
    p.out = (float*)d_out; p.ws = (unsigned char*)d_ws;
    unsigned char* ws = (unsigned char*)d_ws;
    int nj = 0, items = 0;
    auto add = [&](const float* src, bf16_t* dst, int K, int ld, int nrows, int map, int hh) {
        Job& j = p.jobs[nj++]; j.src = src; j.dst = dst; j.K = K; j.ld = ld; j.nrows = nrows; j.map = map; j.hh = hh; j.item0 = items; items += (K / 64) * (nrows / 32); };
    for (int l = 0; l < 2; ++l) add(p.in[29] + (size_t)l * D * F2, (bf16_t*)(ws + WS_WF1) + (size_t)l * F2 * D, 1024, F2, F2, 1, FH);
    for (int l = 0; l < 2; ++l) add(p.in[32] + (size_t)l * FH * D, (bf16_t*)(ws + WS_WF2) + (size_t)l * D * FH, FH, D, D, 0, 0);
    for (int gI = 0; gI < 4; ++gI) add(p.in[3] + (size_t)gI * 65536, (bf16_t*)(ws + WS_WPOOL) + (size_t)gI * 65536, 256, 256, 256, 0, 0);
    add(p.in[14], (bf16_t*)(ws + WS_WS5), 1024, 2048, 2048, 1, 1024);
    p.nitems_a = items;
    for (int l = 2; l < 4; ++l) add(p.in[29] + (size_t)l * D * F2, (bf16_t*)(ws + WS_WF1) + (size_t)l * F2 * D, 1024, F2, F2, 1, FH);
    for (int l = 2; l < 4; ++l) add(p.in[32] + (size_t)l * FH * D, (bf16_t*)(ws + WS_WF2) + (size_t)l * D * FH, FH, D, D, 0, 0);
    add(p.in[16], (bf16_t*)(ws + WS_WLIN), 1024, 2048, 2048, 0, 0);
    for (int pn = 0; pn < 8; ++pn) for (int bj = 0; bj < 2; ++bj)
        add((bj ? p.in[21] : p.in[19]) + (size_t)(pn >> 1) * 65536 + (pn & 1) * 128, (bf16_t*)(ws + WS_WGATE) + (size_t)(pn * 256 + bj * 128) * 256, 256, 256, 128, 0, 0);
    add(p.in[24], (bf16_t*)(ws + WS_WLOUT), 1024, 1024, 1024, 0, 0);
    add(p.in[25], (bf16_t*)(ws + WS_WQKV), 1024, 3072, 3072, 2, 0);
    add(p.in[28], (bf16_t*)(ws + WS_WWO), 1024, 1024, 1024, 0, 0);
    p.nitems = items;
    if (hipMemsetAsync(d_ws, 0, 16384, stream) != hipSuccess) { fprintf(stderr, "kernel_launch: memset failed\n"); return; }
    void* args[] = {&p};
    hipError_t e = hipLaunchCooperativeKernel((const void*)fwd_megakernel, dim3(grid), dim3(NTHREADS), args, LDS_BYTES, stream);
    if (e != hipSuccess) fprintf(stderr, "cooperative launch failed: %s (grid %d)\n", hipGetErrorString(e), grid);
}
```
